# Optimizing an MI355X kernel written in HIP

```python
import math
import jax, jax.numpy as jnp
from jax import lax
import numpy as np

D_MODEL = 1024
BATCH = 8
SEQ = 8192
DEPTH = 1

N_META = 16
ATT_HEADS = 8
ATT_KV_HEADS = 2
ATT_GROUP = ATT_HEADS // ATT_KV_HEADS
HEAD_DIM = 64
WINDOW = 128
BLOCK = 128
RWKV_HEADS = 8
RWKV_HEAD_DIM = 64
RWKV_DIM = RWKV_HEADS * RWKV_HEAD_DIM
DECAY_LORA = 64
AAA_LORA = 64
GATE_LORA = 128
LN_X_EPS = 64e-5
N_BRANCH = 2
ATT_Q = ATT_HEADS * HEAD_DIM
ATT_KV = ATT_KV_HEADS * HEAD_DIM
ATT_COLS = ATT_Q + 2 * ATT_KV
RWKV_COLS = 3 * RWKV_DIM + DECAY_LORA + AAA_LORA + GATE_LORA
GATE_COLS = N_BRANCH * D_MODEL
IN_COLS = ATT_COLS + RWKV_COLS + GATE_COLS
N_GROUPS = 4
EXPERTS_PER_GROUP = 8
N_EXPERTS = N_GROUPS * EXPERTS_PER_GROUP
TOP_K = 2
D_EXPERT = 256
MOE_BLOCK = 128
NORM_EPS = 1e-6

kernel_name = "hybrid_swa_rwkv7_hiermoe_block"


def rmsnorm(x, g):
    x32 = x.astype(jnp.float32)
    y = x32 * lax.rsqrt(jnp.mean(x32 * x32, axis=-1, keepdims=True) + NORM_EPS)
    return y.astype(x.dtype) * g


def alibi_slopes(n_heads):
    return jnp.asarray(np.array([2.0 ** (-8.0 * (i + 1) / n_heads) for i in range(n_heads)], dtype=np.float32))


def sliding_window_attention(q, k, v, sinks):
    B, T = q.shape[0], q.shape[1]
    pad_front = (-N_META) % BLOCK
    pad_tail = (-(T + pad_front)) % BLOCK
    Tp = T + pad_front + pad_tail
    nb = Tp // BLOCK
    pw = ((0, 0), (pad_front, pad_tail), (0, 0), (0, 0))
    qb = jnp.pad(q, pw).reshape(B, nb, BLOCK, ATT_KV_HEADS, ATT_GROUP, HEAD_DIM)
    kb = jnp.pad(k, pw).reshape(B, nb, BLOCK, ATT_KV_HEADS, HEAD_DIM)
    vb = jnp.pad(v, pw).reshape(B, nb, BLOCK, ATT_KV_HEADS, HEAD_DIM)
    zero_blk = jnp.zeros_like(kb[:, :1])
    k_band = jnp.concatenate([jnp.concatenate([zero_blk, kb[:, :-1]], axis=1), kb], axis=2)
    v_band = jnp.concatenate([jnp.concatenate([zero_blk, vb[:, :-1]], axis=1), vb], axis=2)
    k_meta = k[:, :N_META]
    v_meta = jnp.broadcast_to(v[:, None, :N_META], (B, nb, N_META, ATT_KV_HEADS, HEAD_DIM))

    meta_start = pad_front
    real_start = pad_front + N_META
    qpos = jnp.arange(Tp, dtype=jnp.int32).reshape(nb, BLOCK)
    kpos = (jnp.arange(nb, dtype=jnp.int32)[:, None] - 1) * BLOCK + jnp.arange(2 * BLOCK, dtype=jnp.int32)[None, :]
    diff = qpos[:, :, None] - kpos[:, None, :]
    band_mask = (diff >= 0) & (diff < WINDOW) & (kpos >= real_start)[:, None, :]
    mpos = meta_start + jnp.arange(N_META, dtype=jnp.int32)
    diff_m = qpos[:, :, None] - mpos[None, None, :]
    meta_mask = diff_m >= 0
    dist_m = jnp.minimum(diff_m, WINDOW)

    slopes = alibi_slopes(ATT_HEADS).reshape(1, ATT_KV_HEADS, ATT_GROUP, 1, 1)
    neg_inf = jnp.float32(-jnp.inf)
    bias_band = jnp.where(band_mask[:, None, None], -slopes * diff[:, None, None].astype(jnp.float32), neg_inf)
    bias_meta = jnp.where(meta_mask[:, None, None], -slopes * dist_m[:, None, None].astype(jnp.float32), neg_inf)

    scale = HEAD_DIM ** -0.5
    s_band = jnp.einsum('bnqhgd,bnkhd->bnhgqk', qb, k_band).astype(jnp.float32) * scale + bias_band[None]
    s_meta = jnp.einsum('bnqhgd,bmhd->bnhgqm', qb, k_meta).astype(jnp.float32) * scale + bias_meta[None]
    logits = jnp.concatenate([s_band, s_meta], axis=-1)
    sink = sinks.astype(jnp.float32).reshape(1, 1, ATT_KV_HEADS, ATT_GROUP, 1, 1)
    m = jnp.maximum(jnp.max(logits, axis=-1, keepdims=True), sink)
    p = jnp.exp(logits - m)
    probs = p / (jnp.sum(p, axis=-1, keepdims=True) + jnp.exp(sink - m))
    v_all = jnp.concatenate([v_band, v_meta], axis=2)
    o = jnp.einsum('bnhgqk,bnkhd->bnqhgd', probs.astype(v.dtype), v_all)
    o = o.reshape(B, Tp, ATT_Q)
    return o[:, pad_front:pad_front + T]


def rwkv7_time_mix(c, shift_mu, w0, w_decay_up, a0, w_aaa_up, w_gate_up, k_k, k_a, r_k, ln_x_g, ln_x_b):
    B, T, _ = c.shape
    c_prev = jnp.pad(c, ((0, 0), (1, 0), (0, 0)))[:, :-1]
    c = c + shift_mu * (c_prev - c)
    r, k, v, xw, xa, xg = jnp.split(c, np.cumsum([RWKV_DIM, RWKV_DIM, RWKV_DIM, DECAY_LORA, AAA_LORA]).tolist(), axis=-1)
    r, k, v = (t.astype(jnp.float32) for t in (r, k, v))
    w = -jax.nn.softplus(-(w0 + jnp.tanh(xw) @ w_decay_up).astype(jnp.float32)) - 0.5
    decay = jnp.exp(-jnp.exp(w))
    a = jax.nn.sigmoid((a0 + xa @ w_aaa_up).astype(jnp.float32))
    g = jax.nn.sigmoid(xg) @ w_gate_up

    hs = (B, T, RWKV_HEADS, RWKV_HEAD_DIM)
    r, k, v, decay, a = (t.reshape(hs) for t in (r, k, v, decay, a))
    k_k = k_k.astype(jnp.float32).reshape(RWKV_HEADS, RWKV_HEAD_DIM)
    k_a = k_a.astype(jnp.float32).reshape(RWKV_HEADS, RWKV_HEAD_DIM)
    kk = k * k_k
    kk = kk / jnp.maximum(jnp.sqrt(jnp.sum(kk * kk, axis=-1, keepdims=True)), 1e-12)
    k = k * (1.0 + (a - 1.0) * k_a)

    def step(S, inp):
        r_t, w_t, k_t, v_t, a_t, b_t = inp
        sa = jnp.einsum('bhij,bhj->bhi', S, a_t)
        S = S * w_t[:, :, None, :] + sa[..., None] * b_t[:, :, None, :] + v_t[..., None] * k_t[:, :, None, :]
        return S, jnp.einsum('bhij,bhj->bhi', S, r_t)

    to_t = lambda t: jnp.swapaxes(t, 0, 1)
    S0 = jnp.zeros((B, RWKV_HEADS, RWKV_HEAD_DIM, RWKV_HEAD_DIM), jnp.float32)
    _, y = lax.scan(step, S0, (to_t(r), to_t(decay), to_t(k), to_t(v), to_t(-kk), to_t(kk * a)))
    y = jnp.swapaxes(y, 0, 1)
    mu = jnp.mean(y, axis=-1, keepdims=True)
    var = jnp.mean(jnp.square(y - mu), axis=-1, keepdims=True)
    y = ((y - mu) * lax.rsqrt(var + LN_X_EPS)).reshape(B, T, RWKV_DIM)
    y = y * ln_x_g.astype(jnp.float32) + ln_x_b.astype(jnp.float32)
    bonus = jnp.sum(r * k * r_k.astype(jnp.float32), axis=-1, keepdims=True) * v
    y = y + bonus.reshape(B, T, RWKV_DIM)
    return y.astype(c.dtype) * g


def hierarchical_moe(x, w_grp, b_grp, w_exp, b_exp, e_gate, e_up, e_down):
    B, T, D = x.shape
    xf = x.reshape(-1, D)
    N = xf.shape[0]
    grp_logits = (xf @ w_grp + b_grp).astype(jnp.float32)
    p_grp = jax.nn.softmax(grp_logits, axis=-1)
    g_sel = jnp.argmax(grp_logits, axis=-1).astype(jnp.int32)
    exp_logits = (xf @ w_exp + b_exp).astype(jnp.float32).reshape(N, N_GROUPS, EXPERTS_PER_GROUP)
    in_grp = jnp.take_along_axis(exp_logits, g_sel[:, None, None], axis=1)[:, 0]
    top_v, top_i = lax.top_k(in_grp, TOP_K)
    gate = jax.nn.softmax(top_v, axis=-1) * jnp.take_along_axis(p_grp, g_sel[:, None], axis=1)
    expert_id = g_sel[:, None] * EXPERTS_PER_GROUP + top_i.astype(jnp.int32)

    A = N * TOP_K
    eid = expert_id.reshape(-1)
    tok = jnp.repeat(jnp.arange(N, dtype=jnp.int32), TOP_K)
    wt = gate.reshape(-1)
    order = jnp.argsort(eid)
    s_eid, s_tok, s_wt = eid[order], tok[order], wt[order]
    counts = jax.ops.segment_sum(jnp.ones_like(eid), eid, num_segments=N_EXPERTS)
    starts = jnp.cumsum(counts) - counts
    padded = ((counts + MOE_BLOCK - 1) // MOE_BLOCK) * MOE_BLOCK
    pends = jnp.cumsum(padded)
    pstarts = pends - padded
    dest = pstarts[s_eid] + jnp.arange(A, dtype=jnp.int32) - starts[s_eid]
    n_blocks = -(-(A + N_EXPERTS * (MOE_BLOCK - 1)) // MOE_BLOCK)
    cap = n_blocks * MOE_BLOCK
    slot_tok = jnp.full((cap,), N, dtype=jnp.int32).at[dest].set(s_tok)
    slot_wt = jnp.zeros((cap,), jnp.float32).at[dest].set(s_wt)
    block_start = jnp.arange(n_blocks, dtype=jnp.int32) * MOE_BLOCK
    block_expert = jnp.minimum(jnp.sum(block_start[:, None] >= pends[None, :], axis=1), N_EXPERTS - 1)

    x_pad = jnp.concatenate([xf, jnp.zeros((1, D), xf.dtype)], axis=0)
    xb = x_pad[slot_tok].reshape(n_blocks, MOE_BLOCK, D)

    def expert_block(args):
        xblk, e = args
        hmid = jax.nn.silu(xblk @ e_gate[e]) * (xblk @ e_up[e])
        return hmid @ e_down[e]

    yb = lax.map(expert_block, (xb, block_expert)).reshape(cap, D)
    y = jnp.zeros((N + 1, D), jnp.float32).at[slot_tok].add(yb.astype(jnp.float32) * slot_wt[:, None])
    return y[:N].astype(x.dtype).reshape(B, T, D)


def setup_inputs(seed: int = 0) -> dict:
    key = jax.random.key(seed)
    ks = jax.random.split(key, 32)
    L, D = DEPTH, D_MODEL
    nrm = lambda k, shape, s: jax.random.normal(k, shape, jnp.float32) * s
    return {
        "x": nrm(ks[0], (BATCH, SEQ, D), 1.0),
        "meta_tokens": nrm(ks[1], (N_META, D), 1.0),
        "norm_mix_g": 1.0 + nrm(ks[2], (L, D), 0.05),
        "w_in": nrm(ks[3], (L, D, IN_COLS), D ** -0.5),
        "shift_mu": jax.random.uniform(ks[4], (L, RWKV_COLS), jnp.float32),
        "w0": jax.random.uniform(ks[5], (L, RWKV_DIM), jnp.float32, minval=-6.0, maxval=-1.0),
        "w_decay_up": nrm(ks[6], (L, DECAY_LORA, RWKV_DIM), DECAY_LORA ** -0.5),
        "a0": nrm(ks[7], (L, RWKV_DIM), 0.5),
        "w_aaa_up": nrm(ks[8], (L, AAA_LORA, RWKV_DIM), 0.5 * AAA_LORA ** -0.5),
        "w_gate_up": nrm(ks[9], (L, GATE_LORA, RWKV_DIM), GATE_LORA ** -0.5),
        "k_k": 0.85 + nrm(ks[10], (L, RWKV_DIM), 0.1),
        "k_a": 1.0 + nrm(ks[11], (L, RWKV_DIM), 0.1),
        "r_k": nrm(ks[12], (L, RWKV_HEADS, RWKV_HEAD_DIM), 0.1),
        "ln_x_g": 1.0 + nrm(ks[13], (L, RWKV_DIM), 0.1),
        "ln_x_b": nrm(ks[14], (L, RWKV_DIM), 0.01),
        "attn_sinks": nrm(ks[15], (L, ATT_HEADS), 1.0),
        "w_o_attn": nrm(ks[16], (L, ATT_Q, D), ATT_Q ** -0.5),
        "w_o_rwkv": nrm(ks[17], (L, RWKV_DIM, D), RWKV_DIM ** -0.5),
        "w_out": nrm(ks[18], (L, D, D), D ** -0.5),
        "norm_ffn_g": 1.0 + nrm(ks[19], (L, D), 0.05),
        "w_grp": nrm(ks[20], (L, D, N_GROUPS), D ** -0.5),
        "b_grp": nrm(ks[21], (L, N_GROUPS), 0.01),
        "w_exp": nrm(ks[22], (L, D, N_EXPERTS), D ** -0.5),
        "b_exp": nrm(ks[23], (L, N_EXPERTS), 0.01),
        "e_gate": nrm(ks[24], (L, N_EXPERTS, D, D_EXPERT), D ** -0.5),
        "e_up": nrm(ks[25], (L, N_EXPERTS, D, D_EXPERT), D ** -0.5),
        "e_down": nrm(ks[26], (L, N_EXPERTS, D_EXPERT, D), D_EXPERT ** -0.5),
        "norm_final_g": 1.0 + nrm(ks[27], (D,), 0.05),
    }


def reference(x, meta_tokens, norm_mix_g, w_in, shift_mu, w0, w_decay_up, a0, w_aaa_up, w_gate_up,
              k_k, k_a, r_k, ln_x_g, ln_x_b, attn_sinks, w_o_attn, w_o_rwkv, w_out, norm_ffn_g,
              w_grp, b_grp, w_exp, b_exp, e_gate, e_up, e_down, norm_final_g):
    B = x.shape[0]
    meta = jnp.broadcast_to(meta_tokens.astype(x.dtype)[None], (B, N_META, D_MODEL))
    h = jnp.concatenate([meta, x], axis=1)
    T = h.shape[1]
    for l in range(DEPTH):
        xn = rmsnorm(h, norm_mix_g[l])
        cols = xn @ w_in[l]
        att_c = cols[..., :ATT_COLS]
        rwkv_c = cols[..., ATT_COLS:ATT_COLS + RWKV_COLS]
        gate_c = cols[..., ATT_COLS + RWKV_COLS:]
        q = att_c[..., :ATT_Q].reshape(B, T, ATT_HEADS, HEAD_DIM)
        k = att_c[..., ATT_Q:ATT_Q + ATT_KV].reshape(B, T, ATT_KV_HEADS, HEAD_DIM)
        v = att_c[..., ATT_Q + ATT_KV:].reshape(B, T, ATT_KV_HEADS, HEAD_DIM)
        att_out = sliding_window_attention(q, k, v, attn_sinks[l]) @ w_o_attn[l]
        rwkv_out = rwkv7_time_mix(rwkv_c, shift_mu[l], w0[l], w_decay_up[l], a0[l], w_aaa_up[l], w_gate_up[l],
                                  k_k[l], k_a[l], r_k[l], ln_x_g[l], ln_x_b[l]) @ w_o_rwkv[l]
        gates = jax.nn.sigmoid(gate_c.reshape(B, T, N_BRANCH, D_MODEL))
        merged = gates[:, :, 0] * att_out + gates[:, :, 1] * rwkv_out
        h = h + merged @ w_out[l]
        h = h + hierarchical_moe(rmsnorm(h, norm_ffn_g[l]), w_grp[l], b_grp[l], w_exp[l], b_exp[l],
                                 e_gate[l], e_up[l], e_down[l])
    h = rmsnorm(h, norm_final_g)
    return h[:, N_META:]
```

```cpp
#include <hip/hip_runtime.h>
#include <cstdio>
#include <cstdint>
namespace pg8 {
#define PG8_LAS __attribute__((address_space(3)))
typedef unsigned short bf16_t;
typedef short bf16x8 __attribute__((ext_vector_type(8)));
typedef float f32x4 __attribute__((ext_vector_type(4)));
typedef unsigned u32x4 __attribute__((ext_vector_type(4)));
constexpr int BM = 256, BK = 64, HALF = 128, HTB = HALF * BK * 2  , STAGE_BYTES = 8 * HTB, NXCD = 8, WGM = 8;

__host__ __device__ __forceinline__ int lds_byte(int r, int c) { const int st = (r >> 4) * 2 + (c >> 5), rr = r & 15, cc = c & 31, ob = rr * 64 + cc * 2; return st * 1024 + (ob ^ (((ob >> 9) & 1) << 5)); }
__host__ __device__ __forceinline__ void stage_rc(int b, int& R, int& C) { const int st = b / 1024, sb = b % 1024, swz = sb ^ (((sb >> 9) & 1) << 5); R = (st >> 1) * 16 + swz / 64; C = (st & 1) * 32 + (swz % 64) / 2; }
__host__ __device__ __forceinline__ int perm32(int rho) { const int n = rho >> 4, i = rho & 15; return 8 * (i >> 2) + 4 * n + (i & 3); }

struct Unit { int pm, pn; };
struct Gemm { const bf16_t* A; const bf16_t* Bt; int M, N, K; };

struct StaticOrder {
    int nM, nN, nwg, G, c;
    __host__ __device__ void init(int M, int N, int G_, int c_) { nM = M / BM; nN = N / BM; nwg = nM * nN; G = G_; c = c_; }
    __host__ __device__ bool next(int i, Unit& u) const {
        const long L = (long)i * G + c; if (L >= nwg) return false;
        int wgid = (int)L; { const int q = nwg / NXCD, r = nwg % NXCD, xcd = wgid % NXCD, off = wgid / NXCD; wgid = (xcd < r ? xcd * (q + 1) : r * (q + 1) + (xcd - r) * q) + off; }
        const int nig = WGM * nN, gid = wgid / nig, fm = gid * WGM, gsz = (nM - fm) < WGM ? (nM - fm) : WGM;
        u.pm = fm + ((wgid % nig) % gsz); u.pn = (wgid % nig) / gsz; return true;
    }
    __device__ __forceinline__ void a_ready(const Unit&) const {}
    __device__ __forceinline__ void done(const Unit&) const {}
};

__device__ __forceinline__ unsigned cvt_pk_bf16(float lo, float hi) { unsigned r; asm volatile("v_cvt_pk_bf16_f32 %0, %1, %2" : "=v"(r) : "v"(lo), "v"(hi)); return r; }
typedef float f32x2 __attribute__((ext_vector_type(2)));
template <class Epi, class Sched, bool ALIGN_EPI = false, bool SP2 = false>
__device__ __forceinline__ void gemm_phase(PG8_LAS unsigned char* lds, const Gemm g, const Sched& S, const Epi& E) {
    const int tid = threadIdx.x, wid = __builtin_amdgcn_readfirstlane(tid >> 6), lane = tid & 63, wr = wid >> 2, wc = wid & 3, fr = lane & 15, fq = lane >> 4;
    const int K = g.K, nt = K / BK;
    unsigned voffA[2], voffB[2];
#pragma unroll
    for (int i = 0; i < 2; ++i) { int R, C; stage_rc(tid * 16 + i * 8192, R, C); const int Rb = Epi::PERM ? ((R & ~31) + perm32(R & 31)) : R;
        voffA[i] = (unsigned)(R * K + C) * 2u; voffB[i] = (unsigned)(Rb * K + C) * 2u; }
    const size_t kstep = (size_t)(BK * 2);
    const size_t hstep = (size_t)HALF * K * 2;
    const size_t tstep = 2 * hstep;
    const unsigned ldsw = (unsigned)wid * 1024u;
    const int aoff = lds_byte(wr * 64 + fr, fq * 8), boff = lds_byte(wc * 32 + fr, fq * 8);
#define PG8_SA(b, h) (((b) * 2 + (h)) * HTB)
#define PG8_SB(b, h) ((4 + (b) * 2 + (h)) * HTB)
#define PG8_STAGE(bufoff, gbase, voff) do { _Pragma("unroll") for (int _i = 0; _i < 2; ++_i) \
        __builtin_amdgcn_global_load_lds((const unsigned*)((const char*)(gbase) + (voff)[_i]), (PG8_LAS unsigned*)(lds + (bufoff) + ldsw + _i * 8192), 16, 0, 0); } while (0)
#define PG8_LDA(dst, b, h) do { _Pragma("unroll") for (int m = 0; m < 4; ++m) _Pragma("unroll") for (int k = 0; k < 2; ++k) dst[m][k] = *(const PG8_LAS bf16x8*)(lds + PG8_SA(b, h) + aoff + m * 2048 + k * 1024); } while (0)
#define PG8_LDB(dst, b, h) do { _Pragma("unroll") for (int n = 0; n < 2; ++n) _Pragma("unroll") for (int k = 0; k < 2; ++k) dst[n][k] = *(const PG8_LAS bf16x8*)(lds + PG8_SB(b, h) + boff + n * 2048 + k * 1024); } while (0)
#define PG8_MMA(ai, bj, At, Bt) do { __builtin_amdgcn_s_setprio(1); _Pragma("unroll") for (int m = 0; m < 4; ++m) _Pragma("unroll") for (int n = 0; n < 2; ++n) _Pragma("unroll") for (int k = 0; k < 2; ++k) \
        acc[ai][bj][m][n] = __builtin_amdgcn_mfma_f32_16x16x32_bf16(Bt[n][k], At[m][k], acc[ai][bj][m][n], 0, 0, 0); __builtin_amdgcn_s_setprio(0); } while (0)
#define PG8_WAIT_V(n) asm volatile("s_waitcnt vmcnt(" #n ")" ::: "memory")
#define PG8_WAIT_L(n) asm volatile("s_waitcnt lgkmcnt(" #n ")" ::: "memory")
#define PG8_BAR __builtin_amdgcn_s_barrier()
#define PG8_SCHED __builtin_amdgcn_sched_barrier(0)
    Unit cur, nxt; int ui = 0;
    if (!S.next(0, cur)) return;
    f32x4 acc[2][2][4][2];
#pragma unroll
    for (int a = 0; a < 2; ++a)
#pragma unroll
        for (int b = 0; b < 2; ++b)
#pragma unroll
            for (int m = 0; m < 4; ++m)
#pragma unroll
                for (int n = 0; n < 2; ++n) acc[a][b][m][n] = (f32x4){0.f, 0.f, 0.f, 0.f};
    bf16x8 At[4][2], B0[2][2], B1[2][2];
    const char* cA = (const char*)g.A + (size_t)cur.pm * tstep; const char* cB = (const char*)g.Bt + (size_t)cur.pn * tstep;
    S.a_ready(cur);
    if constexpr (SP2) {
        PG8_STAGE(PG8_SB(0, 0), cB, voffB); PG8_STAGE(PG8_SB(0, 1), cB + hstep, voffB); PG8_STAGE(PG8_SA(0, 0), cA, voffA); PG8_STAGE(PG8_SA(0, 1), cA + hstep, voffA);
        if (wr == 1) PG8_BAR;
        PG8_WAIT_V(2); PG8_BAR;
        PG8_STAGE(PG8_SB(1, 0), cB + kstep, voffB); PG8_STAGE(PG8_SA(1, 0), cA + kstep, voffA); PG8_STAGE(PG8_SB(1, 1), cB + hstep + kstep, voffB);
        PG8_WAIT_V(6); PG8_BAR;
    } else {
        PG8_STAGE(PG8_SB(0, 0), cB, voffB); PG8_STAGE(PG8_SA(0, 0), cA, voffA); PG8_STAGE(PG8_SB(0, 1), cB + hstep, voffB); PG8_STAGE(PG8_SA(0, 1), cA + hstep, voffA);
        if (wr == 1) PG8_BAR;
        PG8_WAIT_V(4); PG8_BAR;
        PG8_STAGE(PG8_SB(1, 0), cB + kstep, voffB); PG8_STAGE(PG8_SA(1, 0), cA + kstep, voffA); PG8_STAGE(PG8_SB(1, 1), cB + hstep + kstep, voffB);
        PG8_WAIT_V(6); PG8_BAR;
    }
    for (;;) {
        const bool has_next = S.next(ui + 1, nxt);
        const char* nA = has_next ? (const char*)g.A + (size_t)nxt.pm * tstep : cA; const char* nB = has_next ? (const char*)g.Bt + (size_t)nxt.pn * tstep : cB;
        for (int t = 0; t < nt; t += 2) {
            const bool last = (t == nt - 2);
            const char* a1 = cA + (size_t)(t + 1) * kstep;
            const char* a2 = last ? nA : cA + (size_t)(t + 2) * kstep; const char* b2 = last ? nB : cB + (size_t)(t + 2) * kstep;
            const char* a3 = a2 + kstep; const char* b3 = b2 + kstep;
            if (last && has_next) S.a_ready(nxt);
            if constexpr (SP2) {
            PG8_LDB(B0, 0, 0); PG8_LDB(B1, 0, 1); PG8_SCHED; PG8_LDA(At, 0, 0); PG8_STAGE(PG8_SA(1, 1), a1 + hstep, voffA);
            PG8_WAIT_V(8); PG8_WAIT_L(0); PG8_BAR; PG8_MMA(0, 0, At, B0); PG8_MMA(0, 1, At, B1); PG8_BAR; PG8_SCHED;
            PG8_LDA(At, 0, 1); PG8_STAGE(PG8_SB(0, 0), b2, voffB); PG8_STAGE(PG8_SB(0, 1), b2 + hstep, voffB); PG8_STAGE(PG8_SA(0, 0), a2, voffA);
            PG8_WAIT_V(8); PG8_WAIT_L(0); PG8_BAR; PG8_MMA(1, 0, At, B0); PG8_MMA(1, 1, At, B1); PG8_BAR; PG8_SCHED;
            PG8_LDB(B0, 1, 0); PG8_LDB(B1, 1, 1); PG8_SCHED; PG8_LDA(At, 1, 0); PG8_STAGE(PG8_SA(0, 1), a2 + hstep, voffA);
            PG8_WAIT_V(8); PG8_WAIT_L(0); PG8_BAR; PG8_MMA(0, 0, At, B0); PG8_MMA(0, 1, At, B1); PG8_BAR; PG8_SCHED;
            PG8_LDA(At, 1, 1); PG8_STAGE(PG8_SB(1, 0), b3, voffB); PG8_STAGE(PG8_SB(1, 1), b3 + hstep, voffB); PG8_STAGE(PG8_SA(1, 0), a3, voffA);
            PG8_WAIT_V(8); PG8_WAIT_L(0); PG8_BAR; PG8_MMA(1, 0, At, B0); PG8_MMA(1, 1, At, B1); PG8_BAR; PG8_SCHED;
            } else {
            PG8_LDB(B0, 0, 0); PG8_SCHED; PG8_LDA(At, 0, 0); PG8_STAGE(PG8_SA(1, 1), a1 + hstep, voffA);
            PG8_WAIT_L(8); PG8_BAR; PG8_WAIT_L(0); PG8_MMA(0, 0, At, B0); PG8_BAR; PG8_SCHED;
            PG8_LDB(B1, 0, 1); PG8_STAGE(PG8_SB(0, 0), b2, voffB);
            PG8_BAR; PG8_WAIT_L(0); PG8_MMA(0, 1, At, B1); PG8_BAR;
            PG8_LDA(At, 0, 1); PG8_STAGE(PG8_SA(0, 0), a2, voffA);
            PG8_BAR; PG8_WAIT_L(0); PG8_MMA(1, 0, At, B0); PG8_BAR; PG8_SCHED;
            PG8_STAGE(PG8_SB(0, 1), b2 + hstep, voffB);
            PG8_WAIT_V(6); PG8_BAR; PG8_MMA(1, 1, At, B1); PG8_BAR;
            PG8_LDB(B0, 1, 0); PG8_SCHED; PG8_LDA(At, 1, 0); PG8_STAGE(PG8_SA(0, 1), a2 + hstep, voffA);
            PG8_WAIT_L(8); PG8_BAR; PG8_WAIT_L(0); PG8_MMA(0, 0, At, B0); PG8_BAR; PG8_SCHED;
            PG8_LDB(B1, 1, 1); PG8_STAGE(PG8_SB(1, 0), b3, voffB);
            PG8_BAR; PG8_WAIT_L(0); PG8_MMA(0, 1, At, B1); PG8_BAR;
            PG8_LDA(At, 1, 1); PG8_STAGE(PG8_SA(1, 0), a3, voffA);
            PG8_BAR; PG8_WAIT_L(0); PG8_MMA(1, 0, At, B0); PG8_BAR; PG8_SCHED;
            PG8_STAGE(PG8_SB(1, 1), b3 + hstep, voffB);
            PG8_WAIT_V(6); PG8_BAR; PG8_MMA(1, 1, At, B1); PG8_BAR;
            }
        }
        if constexpr (ALIGN_EPI) { if (wr == 0) PG8_BAR; }
        if constexpr (!Epi::AFTER_DRAIN) { E(acc, cur, wr, wc, fr, fq); S.done(cur); }
        if (!has_next) break;
#pragma unroll
        for (int a = 0; a < 2; ++a)
#pragma unroll
            for (int b = 0; b < 2; ++b)
#pragma unroll
                for (int m = 0; m < 4; ++m)
#pragma unroll
                    for (int n = 0; n < 2; ++n) acc[a][b][m][n] = (f32x4){0.f, 0.f, 0.f, 0.f};
        cur = nxt; cA = nA; cB = nB; ++ui;
        if constexpr (ALIGN_EPI) { if (wr == 1) PG8_BAR; }
    }
    PG8_WAIT_V(0);
    if constexpr (!ALIGN_EPI) { if (wr == 0) PG8_BAR; }
    PG8_BAR;
    if constexpr (Epi::AFTER_DRAIN) { E.fused(acc, cur, wr, wc, fr, fq, lds, wid, lane); S.done(cur); }
#undef PG8_SA
#undef PG8_SB
#undef PG8_STAGE
#undef PG8_LDA
#undef PG8_LDB
#undef PG8_MMA
#undef PG8_WAIT_V
#undef PG8_WAIT_L
#undef PG8_BAR
#undef PG8_SCHED
}

__device__ __forceinline__ float sigm(float x) { return __builtin_amdgcn_rcpf(1.0f + __builtin_amdgcn_exp2f(-1.44269504089f * x)); }
__device__ __forceinline__ f32x4 up_lo(u32x4 w) { f32x4 r; r[0] = __uint_as_float(w[0] << 16); r[1] = __uint_as_float(w[0] & 0xffff0000u); r[2] = __uint_as_float(w[1] << 16); r[3] = __uint_as_float(w[1] & 0xffff0000u); return r; }
__device__ __forceinline__ f32x4 up_hi(u32x4 w) { f32x4 r; r[0] = __uint_as_float(w[2] << 16); r[1] = __uint_as_float(w[2] & 0xffff0000u); r[2] = __uint_as_float(w[3] << 16); r[3] = __uint_as_float(w[3] & 0xffff0000u); return r; }
__device__ __forceinline__ u32x4 pack8(f32x4 v0, f32x4 v1) { u32x4 w; w.x = cvt_pk_bf16(v0[0], v0[1]); w.y = cvt_pk_bf16(v0[2], v0[3]); w.z = cvt_pk_bf16(v1[0], v1[1]); w.w = cvt_pk_bf16(v1[2], v1[3]); return w; }

struct EpiIn {
    static constexpr bool PERM = true, AFTER_DRAIN = false;
    bf16_t *Q, *Kb, *Vb, *RC, *G; const float* rstd;
    __device__ __forceinline__ void operator()(const f32x4 (&acc)[2][2][4][2], const Unit& u, int wr, int wc, int fr, int fq) const {
        const int row0 = u.pm * BM + wr * 64 + fr, cl = wc * 32 + 8 * fq;
        bf16_t* b0; bf16_t* b1; int ld; const int pn = u.pn;
        if (pn < 2) { ld = 512; b0 = Q + pn * 256 + cl; b1 = b0 + 128; }
        else if (pn == 2) { ld = 128; b0 = Kb + cl; b1 = Vb + cl; }
        else if (pn < 10) { ld = 1792; b0 = RC + (pn - 3) * 256 + cl; b1 = b0 + 128; }
        else { ld = 2048; b0 = G + (pn - 10) * 256 + cl; b1 = b0 + 128; }
        const bool sg = pn >= 10;
#pragma unroll
        for (int ai = 0; ai < 2; ++ai)
#pragma unroll
            for (int m = 0; m < 4; ++m) { const int row = row0 + ai * HALF + m * 16; const float s = rstd[row];
#pragma unroll
                for (int bj = 0; bj < 2; ++bj) { f32x4 v0 = acc[ai][bj][m][0] * s, v1 = acc[ai][bj][m][1] * s;
                    if (sg) {
#pragma unroll
                        for (int j = 0; j < 4; ++j) { v0[j] = sigm(v0[j]); v1[j] = sigm(v1[j]); } }
                    *(u32x4*)((bj ? b1 : b0) + (size_t)row * ld) = pack8(v0, v1); } }
    }
};
template <int MODE> struct EpiGate {
    static constexpr bool PERM = true, AFTER_DRAIN = false;
    const bf16_t* G; const bf16_t* P1; bf16_t* O;
    __device__ __forceinline__ void operator()(const f32x4 (&acc)[2][2][4][2], const Unit& u, int wr, int wc, int fr, int fq) const {
        const int row0 = u.pm * BM + wr * 64 + fr, col0 = u.pn * BM + wc * 32 + 8 * fq;
#pragma unroll
        for (int ai = 0; ai < 2; ++ai)
#pragma unroll
            for (int m = 0; m < 4; ++m) { const size_t row = (size_t)(row0 + ai * HALF + m * 16);
#pragma unroll
                for (int bj = 0; bj < 2; ++bj) { const int col = col0 + bj * HALF;
                    const u32x4 gw = *(const u32x4*)(G + row * 2048 + MODE * 1024 + col);
                    f32x4 v0 = acc[ai][bj][m][0] * up_lo(gw), v1 = acc[ai][bj][m][1] * up_hi(gw);
                    if (MODE == 1) { const u32x4 pw = *(const u32x4*)(P1 + row * 1024 + col); v0 += up_lo(pw); v1 += up_hi(pw); }
                    *(u32x4*)(O + row * 1024 + col) = pack8(v0, v1); } }
    }
};
struct EpiRes {
    static constexpr bool PERM = false, AFTER_DRAIN = false;
    const float* X; float* O;
    __device__ __forceinline__ void operator()(const f32x4 (&acc)[2][2][4][2], const Unit& u, int wr, int wc, int fr, int fq) const {
        const int row0 = u.pm * BM + wr * 64 + fr, col0 = u.pn * BM + wc * 32 + 4 * fq;
#pragma unroll
        for (int ai = 0; ai < 2; ++ai)
#pragma unroll
            for (int m = 0; m < 4; ++m) { const size_t off = (size_t)(row0 + ai * HALF + m * 16) * 1024 + col0;
#pragma unroll
                for (int bj = 0; bj < 2; ++bj)
#pragma unroll
                    for (int n = 0; n < 2; ++n) { const f32x4 xv = *(const f32x4*)(X + off + bj * HALF + n * 16); *(f32x4*)(O + off + bj * HALF + n * 16) = xv + acc[ai][bj][m][n]; } }
    }
};
struct GroupedOrder {
    const PG8_LAS int* tile_e; int ntiles, ntn, G, c;
    __device__ __forceinline__ bool next(int i, Unit& u) const {
        const int L = i * G + c; if (L >= ntiles * ntn) return false;
        const int mt = L / ntn, nl = L - mt * ntn; const int e = __builtin_amdgcn_readfirstlane(tile_e[mt]);
        u.pm = mt; u.pn = e * ntn + nl; return true;
    }
    __device__ __forceinline__ void a_ready(const Unit&) const {}
    __device__ __forceinline__ void done(const Unit&) const {}
};
struct EpiSwiglu {
    static constexpr bool PERM = true, AFTER_DRAIN = false;
    bf16_t* H; const int* slot_dst;
    __device__ __forceinline__ void operator()(const f32x4 (&acc)[2][2][4][2], const Unit& u, int wr, int wc, int fr, int fq) const {
        const int row0 = u.pm * BM + wr * 64 + fr, col0 = (u.pn & 1) * 128 + wc * 32 + 8 * fq;
#pragma unroll
        for (int ai = 0; ai < 2; ++ai)
#pragma unroll
            for (int m = 0; m < 4; ++m) { const int row = row0 + ai * HALF + m * 16;
                if (slot_dst[row] >= 0) { f32x4 v0, v1;
#pragma unroll
                    for (int j = 0; j < 4; ++j) { const float g0 = acc[ai][0][m][0][j], g1 = acc[ai][0][m][1][j]; v0[j] = g0 * sigm(g0) * acc[ai][1][m][0][j]; v1[j] = g1 * sigm(g1) * acc[ai][1][m][1][j]; }
                    *(u32x4*)(H + (size_t)row * 256 + col0) = pack8(v0, v1); } }
    }
};
struct EpiDown {
    static constexpr bool PERM = true, AFTER_DRAIN = false;
    bf16_t* Y; const int* slot_dst; const float* slot_w;
    __device__ __forceinline__ void operator()(const f32x4 (&acc)[2][2][4][2], const Unit& u, int wr, int wc, int fr, int fq) const {
        const int row0 = u.pm * BM + wr * 64 + fr, col0 = (u.pn & 3) * 256 + wc * 32 + 8 * fq;
#pragma unroll
        for (int ai = 0; ai < 2; ++ai)
#pragma unroll
            for (int m = 0; m < 4; ++m) { const int row = row0 + ai * HALF + m * 16; const int dst = slot_dst[row];
                if (dst >= 0) { const float w = slot_w[row];
#pragma unroll
                    for (int bj = 0; bj < 2; ++bj) *(u32x4*)(Y + (size_t)dst * 1024 + col0 + bj * HALF) = pack8(acc[ai][bj][m][0] * w, acc[ai][bj][m][1] * w); } }
    }
};
}

constexpr int NWAVES = 8;
constexpr int D = 1024, NB = 8, SEQ = 8192, M = NB * SEQ, NMETA = 16, MV = M + NMETA;
constexpr int IN_COLS = 4608, RCW = 1792;
constexpr int NE = 32, TT_MAX = 544, CAP = TT_MAX * 256, LCAP = 65536;
constexpr int N_PHASES = 13;
#ifndef MK_ONE_LAUNCH
#define MK_ONE_LAUNCH 0
#endif

constexpr size_t MiB = 1u << 20;
constexpr size_t WS_CTL = 0, CTL_ZERO_BYTES = 1 * MiB;
constexpr size_t WS_RSTD = 1 * MiB, WS_METAP = 1 * MiB + 512 * 1024, WS_SLOTD = 3 * MiB, WS_SLOTW = 4 * MiB;
constexpr size_t WS_WIN = 6 * MiB, WS_WOA = 15 * MiB, WS_WOR = 16 * MiB, WS_WOUT = 17 * MiB, WS_WGU = 19 * MiB, WS_WDN = 51 * MiB;
constexpr size_t WS_LISTD = 68 * MiB, WS_LISTW = 76 * MiB;
constexpr size_t WS_XB = 96 * MiB, WS_Q = 224 * MiB, WS_K = 288 * MiB, WS_V = 305 * MiB, WS_RC = 322 * MiB, WS_AO = 547 * MiB;
constexpr size_t WS_PREP = 611 * MiB, PREP_STRIDE = 65 * MiB;
constexpr size_t WS_GB = 96 * MiB, WS_POST = 160 * MiB, WS_RY = 224 * MiB, WS_P1G = 288 * MiB, WS_MG = 416 * MiB;
constexpr size_t WS_XN2 = 96 * MiB, WS_XG = 224 * MiB, WS_HMID = 496 * MiB, WS_Y = 611 * MiB, WS_END = 1024 * MiB;
static_assert(WS_PREP + 6 * PREP_STRIDE <= WS_END && WS_Y + (size_t)2 * M * D * 2 <= WS_END && WS_HMID + (size_t)CAP * 256 * 2 <= WS_AO + 64 * MiB, "ws map");
constexpr int CW_BAR = 4096;
constexpr int CW_GCNT = 16384;

constexpr int LDS_BYTES = 163840;
constexpr int LDS_RT = 147456, LDS_TBL = 159744, LDS_MISC = 163328;

#define LAS __attribute__((address_space(3)))
typedef unsigned short bf16;
typedef unsigned v4u __attribute__((ext_vector_type(4)));
typedef unsigned v2u __attribute__((ext_vector_type(2)));
typedef float f32x4 __attribute__((ext_vector_type(4)));
#define DI __device__ __forceinline__
#define LDS_WAIT() asm volatile("s_waitcnt lgkmcnt(0)" ::: "memory")
DI unsigned f2bf(float f) { unsigned u = __builtin_bit_cast(unsigned, f); return (u + 0x7fffu + ((u >> 16) & 1u)) >> 16; }
DI unsigned pk2(float lo, float hi) { return f2bf(lo) | (f2bf(hi) << 16); }
DI float bf2f(bf16 b) { return __uint_as_float((unsigned)b << 16); }
DI float wave_sum(float v) {
#pragma unroll
    for (int o = 1; o < 64; o <<= 1) v += __shfl_xor(v, o);
    return v;
}
DI float wave_max(float v) {
#pragma unroll
    for (int o = 1; o < 64; o <<= 1) v = fmaxf(v, __shfl_xor(v, o));
    return v;
}
DI float sigmoid_f(float x) { return 1.0f / (1.0f + __expf(-x)); }

#define XB_TMO      128
#define XB_XCNT(j)  (256  + 64 * (j))
#define XB_XSUB(j)  (1280 + 64 * (j))
#define XB_XGEN(j)  (2304 + 64 * (j))
#define XB_TOP      3328
#define XB_TOPGEN   3392
#define XCD_BAR_WORDS 3456
#define XB_SPIN_CAP (1u << 20)
DI unsigned xb_ld(unsigned* p)              { return __hip_atomic_load(p, __ATOMIC_RELAXED, __HIP_MEMORY_SCOPE_AGENT); }
DI unsigned xb_add(unsigned* p, unsigned v) { return __hip_atomic_fetch_add(p, v, __ATOMIC_RELAXED, __HIP_MEMORY_SCOPE_AGENT); }
DI unsigned xb_xcc_id() { return (unsigned)__builtin_amdgcn_s_getreg((3 << 11) | 20) & 0xFu; }
#define XB_SPIN(cond, bar) do { unsigned _sp = 0; while (cond) { __builtin_amdgcn_s_sleep(1); \
    if ((++_sp & 255u) == 0u) { if (xb_ld(&(bar)[XB_TMO])) break; if (_sp > XB_SPIN_CAP) { atomicAdd(&(bar)[XB_TMO], 1u); break; } } } } while (0)
struct XcdBarrier { unsigned* bar; unsigned x; volatile LAS unsigned* st; };
DI XcdBarrier xcd_barrier_post(unsigned* bar, volatile LAS unsigned* st) {
    XcdBarrier b; b.bar = bar; b.x = xb_xcc_id(); b.st = st;
    if (threadIdx.x == 0) (void)xb_add(&bar[XB_XCNT(b.x)], 1u);
    return b;
}
DI void xcd_barrier_complete(unsigned* bar, unsigned x, unsigned& nloc, unsigned& nx) {
    const unsigned G = gridDim.x * gridDim.y * gridDim.z;
    unsigned sum, cnt, mine, sp = 0u;
    for (;;) {
        sum = 0u; cnt = 0u; mine = 0u;
#pragma unroll
        for (unsigned j = 0; j < 16; ++j) { const unsigned c = xb_ld(&bar[XB_XCNT(j)]); sum += c; cnt += (c > 0u) ? 1u : 0u; mine = (j == x) ? c : mine; }
        if (sum == G) break;
        __builtin_amdgcn_s_sleep(1);
        if ((++sp & 255u) == 0u) { if (xb_ld(&bar[XB_TMO])) break; if (sp > XB_SPIN_CAP) { atomicAdd(&bar[XB_TMO], 1u); break; } }
    }
    nloc = mine > 0u ? mine : 1u; nx = cnt > 0u ? cnt : 1u;
}
DI void xcd_barrier(const XcdBarrier& b) {
    asm volatile("s_waitcnt vmcnt(0)" ::: "memory");
    __syncthreads();
    if (threadIdx.x == 0) {
        unsigned* bar = b.bar;
        __builtin_amdgcn_s_waitcnt(0);
        unsigned nloc = b.st[0], nx = b.st[1];
        if (nloc == 0u) { xcd_barrier_complete(bar, b.x, nloc, nx); b.st[0] = nloc; b.st[1] = nx; }
        const unsigned old = xb_add(&bar[XB_XSUB(b.x)], 1u);
        const unsigned gen = old / nloc;
        if (old + 1u == (gen + 1u) * nloc) {
            __builtin_amdgcn_fence(__ATOMIC_RELEASE, "agent");
            asm volatile("s_waitcnt vmcnt(0)" ::: "memory");
            const unsigned og = xb_add(&bar[XB_TOP], 1u);
            const unsigned tg = og / nx;
            if (og + 1u == (tg + 1u) * nx) xb_add(&bar[XB_TOPGEN], 1u);
            else XB_SPIN(xb_ld(&bar[XB_TOPGEN]) == tg, bar);
            __builtin_amdgcn_fence(__ATOMIC_ACQUIRE, "agent");
            xb_add(&bar[XB_XGEN(b.x)], 1u);
            asm volatile("s_waitcnt vmcnt(0)" ::: "memory");
        } else {
            XB_SPIN(xb_ld(&bar[XB_XGEN(b.x)]) == gen, bar);
            __builtin_amdgcn_fence(__ATOMIC_ACQUIRE, "agent");
            asm volatile("s_waitcnt vmcnt(0)" ::: "memory");
        }
    }
    __syncthreads();
}

struct Args { const float* in[28]; float* out; unsigned char* ws; int ph_lo, ph_hi, li, pad; };
struct Frame {
    LAS unsigned char* lds;
    unsigned* ctl;
    int tid, lane, wave, G;
    float* out; unsigned char* ws;
};
enum { I_X = 0, I_META, I_NMG, I_WIN, I_MU, I_W0, I_WD, I_A0, I_WA, I_WG, I_KK, I_KA, I_RK, I_LNG, I_LNB, I_SINK, I_WOA, I_WOR, I_WOUT, I_NFG, I_WGRP, I_BGRP, I_WEXP, I_BEXP, I_EG, I_EU, I_ED, I_NFIN };

DI void transpose_item(const float* W, int ldw, int K, bf16* WT, int k0, int n0, int drow0, const float* kscale, float nscale, LAS float* scr, int lane) {
#pragma unroll 8
    for (int i = 0; i < 32; ++i) { const int kk = 2 * i + (lane >> 5); float v = W[(size_t)(k0 + kk) * ldw + n0 + (lane & 31)]; if (kscale) v *= kscale[k0 + kk]; scr[kk * 33 + (lane & 31)] = v * nscale; }
    LDS_WAIT(); asm volatile("" ::: "memory");
    const int c = lane & 7;
#pragma unroll
    for (int j = 0; j < 4; ++j) { const int n = (lane >> 3) + 8 * j; const LAS float* s = scr + (8 * c) * 33 + n;
        v4u o; o.x = pk2(s[0 * 33], s[1 * 33]); o.y = pk2(s[2 * 33], s[3 * 33]); o.z = pk2(s[4 * 33], s[5 * 33]); o.w = pk2(s[6 * 33], s[7 * 33]);
        *(v4u*)(WT + (size_t)(drow0 + n) * K + k0 + 8 * c) = o; }
    LDS_WAIT(); asm volatile("" ::: "memory");
}
DI void p0_prologue(Frame& F, const Args& A) {
    LAS float* scr = (LAS float*)(F.lds + F.wave * 16384);
    const int gw = blockIdx.x * NWAVES + F.wave, NGW = F.G * NWAVES;
    unsigned char* ws = F.ws;
    constexpr int I_IN = 16 * 144, I_OA = 8 * 32, I_OR = 8 * 32, I_OUT = 16 * 32, I_G = 32 * 16 * 8, I_U = I_G, I_DN = 32 * 4 * 32;
    constexpr int NITEMS = I_IN + I_OA + I_OR + I_OUT + I_G + I_U + I_DN;
    for (int it = gw; it < NITEMS; it += NGW) {
        int r = it;
        if (r < I_IN) { const int kb = r / 144, nb = r % 144; transpose_item(A.in[I_WIN], IN_COLS, 1024, (bf16*)(ws + WS_WIN), 64 * kb, 32 * nb, 32 * nb, A.in[I_NMG], nb < 16 ? 0.125f : 1.0f, scr, F.lane); continue; } r -= I_IN;
        if (r < I_OA) { const int kb = r / 32, nb = r % 32; transpose_item(A.in[I_WOA], 1024, 512, (bf16*)(ws + WS_WOA), 64 * kb, 32 * nb, 32 * nb, nullptr, 1.0f, scr, F.lane); continue; } r -= I_OA;
        if (r < I_OR) { const int kb = r / 32, nb = r % 32; transpose_item(A.in[I_WOR], 1024, 512, (bf16*)(ws + WS_WOR), 64 * kb, 32 * nb, 32 * nb, nullptr, 1.0f, scr, F.lane); continue; } r -= I_OR;
        if (r < I_OUT) { const int kb = r / 32, nb = r % 32; transpose_item(A.in[I_WOUT], 1024, 1024, (bf16*)(ws + WS_WOUT), 64 * kb, 32 * nb, 32 * nb, nullptr, 1.0f, scr, F.lane); continue; } r -= I_OUT;
        if (r < I_G + I_U) { const int up = r >= I_G; if (up) r -= I_G; const int e = r / 128, q = r % 128, kb = q / 8, nb = q % 8, n0 = 32 * nb;
            transpose_item(A.in[up ? I_EU : I_EG] + (size_t)e * 1024 * 256, 256, 1024, (bf16*)(ws + WS_WGU), 64 * kb, n0, e * 512 + (n0 >> 7) * 256 + up * 128 + (n0 & 127), nullptr, 1.0f, scr, F.lane); continue; } r -= I_G + I_U;
        { const int e = r / 128, q = r % 128, kb = q / 32, nb = q % 32; transpose_item(A.in[I_ED] + (size_t)e * 256 * 1024, 1024, 256, (bf16*)(ws + WS_WDN), 64 * kb, 32 * nb, e * 1024 + 32 * nb, nullptr, 1.0f, scr, F.lane); }
    }
    {
        bf16* XB = (bf16*)(ws + WS_XB); float* RS = (float*)(ws + WS_RSTD);
        for (int m = gw; m < M; m += NGW) {
            const f32x4* xr = (const f32x4*)(A.in[I_X] + (size_t)m * D) + F.lane;
            f32x4 v[4]; float s = 0.f;
#pragma unroll
            for (int j = 0; j < 4; ++j) { v[j] = xr[64 * j]; s += (v[j].x * v[j].x + v[j].y * v[j].y) + (v[j].z * v[j].z + v[j].w * v[j].w); }
            s = wave_sum(s);
            if (F.lane == 0) RS[m] = 1.0f / sqrtf(s * (1.0f / D) + 1e-6f);
            v2u* o8 = (v2u*)(XB + (size_t)m * D) + F.lane;
#pragma unroll
            for (int j = 0; j < 4; ++j) { v2u o; o.x = pk2(v[j].x, v[j].y); o.y = pk2(v[j].z, v[j].w); o8[64 * j] = o; }
        }
    }
    __syncthreads();
    {
        LAS float* xnm = (LAS float*)F.lds;
        LAS float* red = (LAS float*)(F.lds + 65536);
        bool have = false;
        for (int it = blockIdx.x; it < 256; it += F.G) {
            if (!have) {
                for (int rr = 0; rr < 2; ++rr) { const int row = 2 * F.wave + rr; const f32x4* xr = (const f32x4*)(A.in[I_META] + row * D) + F.lane; const f32x4* gr = (const f32x4*)(A.in[I_NMG]) + F.lane;
                    f32x4 v[4]; float s = 0.f;
#pragma unroll
                    for (int j = 0; j < 4; ++j) { v[j] = xr[64 * j]; s += (v[j].x * v[j].x + v[j].y * v[j].y) + (v[j].z * v[j].z + v[j].w * v[j].w); }
                    const float rs = 1.0f / sqrtf(wave_sum(s) * (1.0f / D) + 1e-6f);
#pragma unroll
                    for (int j = 0; j < 4; ++j) { const f32x4 g = gr[64 * j]; *(LAS f32x4*)(xnm + row * D + 256 * j + 4 * F.lane) = v[j] * rs * g; } }
                __syncthreads(); have = true;
            }
            const int cg = it >> 3, ks = it & 7, col = 512 + cg * 64 + F.lane, kbase = ks * 128 + F.wave * 16;
            float acc[16];
#pragma unroll
            for (int r = 0; r < 16; ++r) acc[r] = 0.f;
#pragma unroll 4
            for (int k = 0; k < 16; ++k) { const float w = A.in[I_WIN][(size_t)(kbase + k) * IN_COLS + col];
#pragma unroll
                for (int r = 0; r < 16; ++r) acc[r] += xnm[r * D + kbase + k] * w; }
#pragma unroll
            for (int r = 0; r < 16; ++r) red[(F.wave * 16 + r) * 64 + F.lane] = acc[r];
            __syncthreads();
            float* MP = (float*)(ws + WS_METAP);
            for (int e = F.tid; e < 16 * 64; e += NWAVES * 64) { const int r = e >> 6, c = e & 63; float s = 0.f;
#pragma unroll
                for (int w = 0; w < 8; ++w) s += red[(w * 16 + r) * 64 + c];
                MP[(size_t)(ks * 16 + r) * 2048 + cg * 64 + c] = s; }
            __syncthreads();
        }
    }
}
DI void p1_meta_finish(Frame& F, const Args& A) {
    const float* MP = (const float*)(F.ws + WS_METAP);
    bf16* Kb = (bf16*)(F.ws + WS_K); bf16* Vb = (bf16*)(F.ws + WS_V); bf16* RC = (bf16*)(F.ws + WS_RC);
    for (int e = blockIdx.x * 512 + F.tid; e < 16 * 2048; e += F.G * 512) { const int r = e >> 11, c = e & 2047; float s = 0.f;
#pragma unroll
        for (int k = 0; k < 8; ++k) s += MP[(size_t)(k * 16 + r) * 2048 + c];
        const bf16 v = (bf16)f2bf(s);
        if (c < 128) Kb[(size_t)(M + r) * 128 + c] = v; else if (c < 256) Vb[(size_t)(M + r) * 128 + c - 128] = v; else RC[(size_t)(M + r) * RCW + c - 256] = v; }
}

DI void p2_attention(Frame& F, const Args& A) {
    LAS float* qs = (LAS float*)(F.lds + F.wave * 4096); LAS float* ps = qs + 256;
    const bf16* Q = (const bf16*)(F.ws + WS_Q); const bf16* Kb = (const bf16*)(F.ws + WS_K); const bf16* Vb = (const bf16*)(F.ws + WS_V); bf16* AO = (bf16*)(F.ws + WS_AO);
    const int gw = blockIdx.x * NWAVES + F.wave, NGW = F.G * NWAVES, lane = F.lane;
    for (int item = gw; item < M * 2; item += NGW) {
        const int tok = item >> 1, kvh = item & 1, b = tok / SEQ, t = tok % SEQ;
#pragma unroll
        for (int g = 0; g < 4; ++g) qs[g * 64 + lane] = bf2f(Q[(size_t)tok * 512 + (kvh * 4 + g) * 64 + lane]);
        LDS_WAIT();
#pragma unroll 1
        for (int p = 0; p < 3; ++p) {
            bool valid; const bf16* krow; float dist;
            if (p < 2) { const int j = p * 64 + lane, tk = t - j; valid = tk >= 0; krow = Kb + (size_t)(b * SEQ + (tk > 0 ? tk : 0)) * 128 + kvh * 64; dist = (float)j; }
            else { const int m = lane & 15; valid = lane < 16; krow = Kb + (size_t)(M + m) * 128 + kvh * 64; const int dm = t + 16 - m; dist = (float)(dm < 128 ? dm : 128); }
            float acc[4] = {0.f, 0.f, 0.f, 0.f};
#pragma unroll 2
            for (int c = 0; c < 8; ++c) { const v4u kv = *(const v4u*)(krow + c * 8);
                float kf[8];
#pragma unroll
                for (int i = 0; i < 4; ++i) { kf[2 * i] = __uint_as_float(kv[i] << 16); kf[2 * i + 1] = __uint_as_float(kv[i] & 0xffff0000u); }
#pragma unroll
                for (int g = 0; g < 4; ++g) { const f32x4 qa = *(LAS f32x4*)(qs + g * 64 + c * 8), qb = *(LAS f32x4*)(qs + g * 64 + c * 8 + 4);
                    acc[g] += (kf[0] * qa.x + kf[1] * qa.y) + (kf[2] * qa.z + kf[3] * qa.w) + (kf[4] * qb.x + kf[5] * qb.y) + (kf[6] * qb.z + kf[7] * qb.w); } }
#pragma unroll
            for (int g = 0; g < 4; ++g) { const float slope = exp2f(-(float)(kvh * 4 + g + 1)); ps[g * 192 + p * 64 + lane] = valid ? acc[g] - slope * dist : -INFINITY; }
        }
        LDS_WAIT();
#pragma unroll
        for (int g = 0; g < 4; ++g) { const float sink = A.in[I_SINK][kvh * 4 + g];
            const float s0 = ps[g * 192 + lane], s1 = ps[g * 192 + 64 + lane], s2 = ps[g * 192 + 128 + lane];
            float mx = fmaxf(fmaxf(s0, s1), s2); mx = fmaxf(wave_max(mx), sink);
            const float e0 = __expf(s0 - mx), e1 = __expf(s1 - mx), e2 = __expf(s2 - mx);
            const float sum = wave_sum(e0 + e1 + e2) + __expf(sink - mx), inv = 1.0f / sum;
            ps[g * 192 + lane] = e0 * inv; ps[g * 192 + 64 + lane] = e1 * inv; ps[g * 192 + 128 + lane] = e2 * inv; }
        LDS_WAIT();
        float o[4] = {0.f, 0.f, 0.f, 0.f};
        const int nband = t + 1 < 128 ? t + 1 : 128;
#pragma unroll 2
        for (int sl = 0; sl < nband; ++sl) { const float vv = bf2f(Vb[(size_t)(b * SEQ + t - sl) * 128 + kvh * 64 + lane]);
#pragma unroll
            for (int g = 0; g < 4; ++g) o[g] += ps[g * 192 + sl] * vv; }
#pragma unroll 2
        for (int m = 0; m < 16; ++m) { const float vv = bf2f(Vb[(size_t)(M + m) * 128 + kvh * 64 + lane]);
#pragma unroll
            for (int g = 0; g < 4; ++g) o[g] += ps[g * 192 + 128 + m] * vv; }
#pragma unroll
        for (int g = 0; g < 4; ++g) AO[(size_t)tok * 512 + (kvh * 4 + g) * 64 + lane] = (bf16)f2bf(o[g]);
        LDS_WAIT();
    }
}

DI int prev_row(int vt) { if (vt < M) return (vt % SEQ) > 0 ? vt - 1 : M + 15; return vt > M ? vt - 1 : -1; }
DI void p3_rwkv_prep(Frame& F, const Args& A) {
    LAS float* xin = (LAS float*)F.lds;
    const bf16* RC = (const bf16*)(F.ws + WS_RC); const float* mu = A.in[I_MU];
    bf16* P0 = (bf16*)(F.ws + WS_PREP); bf16* GB = (bf16*)(F.ws + WS_GB); bf16* PO = (bf16*)(F.ws + WS_POST);
    const int n = F.tid;
    const float mur = mu[n], muk = mu[512 + n], muv = mu[1024 + n], w0 = A.in[I_W0][n], a0 = A.in[I_A0][n], kkw = A.in[I_KK][n], kaw = A.in[I_KA][n], rkw = A.in[I_RK][n], lnb = A.in[I_LNB][n];
    for (int pass = blockIdx.x; pass < MV / 16; pass += F.G) {
        const int vt0 = pass * 16;
#pragma unroll
        for (int i = 0; i < 8; ++i) { const int e = F.tid + 512 * i, tt = e >> 8, c = e & 255, col = 1536 + c, vt = vt0 + tt, pr = prev_row(vt);
            const float cur = bf2f(RC[(size_t)vt * RCW + col]); const float prv = pr >= 0 ? bf2f(RC[(size_t)pr * RCW + col]) : 0.f;
            float v = cur + mu[col] * (prv - cur);
            if (c < 64) v = tanhf(v); else if (c >= 128) v = sigmoid_f(v);
            xin[c * 16 + tt] = v; }
        __syncthreads();
        float aw[16], aa[16], ag[16];
#pragma unroll
        for (int t = 0; t < 16; ++t) { aw[t] = 0.f; aa[t] = 0.f; ag[t] = 0.f; }
        for (int k = 0; k < 64; ++k) { const float wd = A.in[I_WD][k * 512 + n], wa = A.in[I_WA][k * 512 + n];
#pragma unroll
            for (int q = 0; q < 4; ++q) { const f32x4 x1 = *(LAS f32x4*)(xin + k * 16 + 4 * q), x2 = *(LAS f32x4*)(xin + (64 + k) * 16 + 4 * q);
#pragma unroll
                for (int j = 0; j < 4; ++j) { aw[4 * q + j] += x1[j] * wd; aa[4 * q + j] += x2[j] * wa; } } }
        for (int k = 0; k < 128; ++k) { const float wg = A.in[I_WG][k * 512 + n];
#pragma unroll
            for (int q = 0; q < 4; ++q) { const f32x4 x1 = *(LAS f32x4*)(xin + (128 + k) * 16 + 4 * q);
#pragma unroll
                for (int j = 0; j < 4; ++j) ag[4 * q + j] += x1[j] * wg; } }
#pragma unroll
        for (int tt = 0; tt < 16; ++tt) { const int vt = vt0 + tt, pr = prev_row(vt);
            const bf16* cr = RC + (size_t)vt * RCW; const bf16* pp = RC + (size_t)(pr >= 0 ? pr : vt) * RCW; const float pm = pr >= 0 ? 1.f : 0.f;
            const float rc = bf2f(cr[n]), kc = bf2f(cr[512 + n]), vc = bf2f(cr[1024 + n]);
            const float r = rc + mur * (pm * bf2f(pp[n]) - rc), k = kc + muk * (pm * bf2f(pp[512 + n]) - kc), v = vc + muv * (pm * bf2f(pp[1024 + n]) - vc);
            const float z = -(w0 + aw[tt]);
            const float sp = z > 20.f ? z : log1pf(__expf(z));
            const float lw = -__expf(-sp - 0.5f);
            const float asg = sigmoid_f(a0 + aa[tt]);
            float kkv = k * kkw; const float nrm = sqrtf(wave_sum(kkv * kkv)); kkv = kkv / fmaxf(nrm, 1e-12f);
            const float kp = k * (1.0f + (asg - 1.0f) * kaw);
            const float bonus = wave_sum(r * kp * rkw);
            const size_t o = (size_t)vt * 512 + n;
            P0[o] = (bf16)f2bf(lw); *(bf16*)((char*)P0 + PREP_STRIDE + o * 2) = (bf16)f2bf(-kkv); *(bf16*)((char*)P0 + 2 * PREP_STRIDE + o * 2) = (bf16)f2bf(kkv * asg);
            *(bf16*)((char*)P0 + 3 * PREP_STRIDE + o * 2) = (bf16)f2bf(kp); *(bf16*)((char*)P0 + 4 * PREP_STRIDE + o * 2) = (bf16)f2bf(r); *(bf16*)((char*)P0 + 5 * PREP_STRIDE + o * 2) = (bf16)f2bf(v);
            if (vt < M) { GB[o] = (bf16)f2bf(ag[tt]); PO[o] = (bf16)f2bf(lnb + bonus * v); } }
        __syncthreads();
    }
}

DI void p4_rwkv_scan(Frame& F, const Args& A) {
    LAS float* L = (LAS float*)F.lds;
    LAS float* Lv = L + 5 * 4096; LAS float* Ly = Lv + 4096;
    const bf16* P0 = (const bf16*)(F.ws + WS_PREP); const bf16* GB = (const bf16*)(F.ws + WS_GB); const bf16* PO = (const bf16*)(F.ws + WS_POST); bf16* RY = (bf16*)(F.ws + WS_RY);
    const int lane = F.lane, wv = F.wave, rl = lane & 15, jq = lane >> 4, irow = 16 * wv + rl;
    for (int bh = blockIdx.x; bh < NB * 8; bh += F.G) {
        const int b = bh >> 3, h = bh & 7;
        const float lng = A.in[I_LNG][h * 64 + lane];
        float s[16];
#pragma unroll
        for (int j = 0; j < 16; ++j) s[j] = 0.f;
        for (int blk = -1; blk < SEQ / 64; ++blk) {
            const int nt = blk < 0 ? 16 : 64, rowbase = blk < 0 ? M : b * SEQ + 64 * blk;
            for (int e = F.tid; e < nt * 64; e += NWAVES * 64) { const int tt = e >> 6, j = e & 63; const size_t o = (size_t)(rowbase + tt) * 512 + h * 64 + j;
#pragma unroll
                for (int a = 0; a < 6; ++a) { float v = bf2f(*(const bf16*)((const char*)P0 + a * PREP_STRIDE + o * 2)); if (a == 0) v = __expf(v); L[a * 4096 + e] = v; } }
            __syncthreads();
            if (wv < 4) {
                for (int tt = 0; tt < nt; ++tt) {
                    const LAS float* base = L + tt * 64 + 16 * jq;
                    float sa = 0.f;
#pragma unroll
                    for (int q = 0; q < 4; ++q) { const f32x4 a4 = *(const LAS f32x4*)(base + 4096 + 4 * q); sa += (s[4 * q] * a4.x + s[4 * q + 1] * a4.y) + (s[4 * q + 2] * a4.z + s[4 * q + 3] * a4.w); }
                    sa += __shfl_xor(sa, 16); sa += __shfl_xor(sa, 32);
                    const float vi = Lv[tt * 64 + irow];
                    float y = 0.f;
#pragma unroll
                    for (int q = 0; q < 4; ++q) { const f32x4 d4 = *(const LAS f32x4*)(base + 4 * q), b4 = *(const LAS f32x4*)(base + 2 * 4096 + 4 * q), k4 = *(const LAS f32x4*)(base + 3 * 4096 + 4 * q), r4 = *(const LAS f32x4*)(base + 4 * 4096 + 4 * q);
#pragma unroll
                        for (int j = 0; j < 4; ++j) { const float ns = s[4 * q + j] * d4[j] + sa * b4[j] + vi * k4[j]; s[4 * q + j] = ns; y += ns * r4[j]; } }
                    y += __shfl_xor(y, 16); y += __shfl_xor(y, 32);
                    if (jq == 0) Ly[tt * 64 + irow] = y;
                }
            }
            __syncthreads();
            if (blk >= 0) {
                for (int tt = wv; tt < 64; tt += NWAVES) { const float yv = Ly[tt * 64 + lane];
                    const float mean = wave_sum(yv) * (1.0f / 64.0f), dv = yv - mean, var = wave_sum(dv * dv) * (1.0f / 64.0f);
                    const size_t o = (size_t)(rowbase + tt) * 512 + h * 64 + lane;
                    const float out = (dv * (1.0f / sqrtf(var + 64e-5f)) * lng + bf2f(PO[o])) * bf2f(GB[o]);
                    RY[o] = (bf16)f2bf(out); }
            }
            __syncthreads();
        }
    }
}

DI void p8_router(Frame& F, const Args& A) {
    LAS float* wr = (LAS float*)F.lds;
    LAS int* lcnt = (LAS int*)(F.lds + LDS_RT); LAS int* lbase = lcnt + 32; LAS int* ent_e = lcnt + 64; LAS int* ent_p = ent_e + 512; LAS int* ent_d = ent_p + 512; LAS float* ent_w = (LAS float*)(ent_d + 512);
    const float* H1 = F.out; bf16* XN = (bf16*)(F.ws + WS_XN2);
    int* LD = (int*)(F.ws + WS_LISTD); float* LW = (float*)(F.ws + WS_LISTW);
    const int lane = F.lane;
    for (int e = F.tid; e < 36 * 1024; e += NWAVES * 64) { const int ex = e >> 10, k = e & 1023; wr[e] = ex < 4 ? A.in[I_WGRP][k * 4 + ex] : A.in[I_WEXP][k * 32 + ex - 4]; }
    for (int ch = blockIdx.x; ch < M / 256; ch += F.G) {
        if (F.tid < 32) lcnt[F.tid] = 0;
        __syncthreads();
        for (int it = 0; it < 32; ++it) {
            const int tok = ch * 256 + F.wave * 32 + it; asm volatile("" ::: "memory");
            f32x4 xv[4];
            { const f32x4* hr = (const f32x4*)(H1 + (size_t)tok * D) + lane; float ss = 0.f;
#pragma unroll
                for (int j = 0; j < 4; ++j) { xv[j] = hr[64 * j]; ss += (xv[j].x * xv[j].x + xv[j].y * xv[j].y) + (xv[j].z * xv[j].z + xv[j].w * xv[j].w); }
                const float rs = 1.0f / sqrtf(wave_sum(ss) * (1.0f / D) + 1e-6f);
                v2u* o8 = (v2u*)(XN + (size_t)tok * D) + lane;
#pragma unroll
                for (int j = 0; j < 4; ++j) { const f32x4 gf = ((const f32x4*)A.in[I_NFG])[64 * j + lane]; xv[j] = xv[j] * rs * gf; v2u o; o.x = pk2(xv[j].x, xv[j].y); o.y = pk2(xv[j].z, xv[j].w); o8[64 * j] = o; } }
            float gl[4];
#pragma unroll
            for (int ex = 0; ex < 4; ++ex) { float p0 = 0.f;
#pragma unroll
                for (int j = 0; j < 4; ++j) { const f32x4 w4 = *(const LAS f32x4*)(wr + ex * 1024 + 256 * j + 4 * lane); p0 += (xv[j].x * w4.x + xv[j].y * w4.y) + (xv[j].z * w4.z + xv[j].w * w4.w); }
                gl[ex] = wave_sum(p0) + A.in[I_BGRP][ex]; }
            int gs = 0; float gm = gl[0];
#pragma unroll
            for (int g = 1; g < 4; ++g) if (gl[g] > gm) { gm = gl[g]; gs = g; }
            gs = __builtin_amdgcn_readfirstlane(gs);
            float den = 0.f;
#pragma unroll
            for (int g = 0; g < 4; ++g) den += __expf(gl[g] - gm);
            const float pg = 1.0f / den;
            float v1 = -INFINITY, v2 = -INFINITY; int i1 = 0, i2 = 0;
            const LAS float* wg8 = wr + (4 + gs * 8) * 1024;
#pragma unroll
            for (int i = 0; i < 8; ++i) { float p0 = 0.f;
#pragma unroll
                for (int j = 0; j < 4; ++j) { const f32x4 w4 = *(const LAS f32x4*)(wg8 + i * 1024 + 256 * j + 4 * lane); p0 += (xv[j].x * w4.x + xv[j].y * w4.y) + (xv[j].z * w4.z + xv[j].w * w4.w); }
                const float l = wave_sum(p0) + A.in[I_BEXP][gs * 8 + i];
                if (l > v1) { v2 = v1; i2 = i1; v1 = l; i1 = i; } else if (l > v2) { v2 = l; i2 = i; } }
            const float e2 = __expf(v2 - v1), w1 = pg / (1.0f + e2), w2 = pg * e2 / (1.0f + e2);
            if (lane < 2) { const int ex = gs * 8 + (lane == 0 ? i1 : i2); const int pos = atomicAdd((int*)&lcnt[ex], 1); const int slot = (F.wave * 32 + it) * 2 + lane;
                ent_e[slot] = ex; ent_p[slot] = pos; ent_d[slot] = tok * 2 + lane; ent_w[slot] = lane == 0 ? w1 : w2; }
        }
        __syncthreads();
        if (F.tid < 32) lbase[F.tid] = (int)__hip_atomic_fetch_add(F.ctl + CW_GCNT + 64 * F.tid, (unsigned)lcnt[F.tid], __ATOMIC_RELAXED, __HIP_MEMORY_SCOPE_AGENT);
        __syncthreads();
        { const int sl = F.tid; const int ex = ent_e[sl]; const size_t o = (size_t)ex * LCAP + lbase[ex] + ent_p[sl]; LD[o] = ent_d[sl]; LW[o] = ent_w[sl]; }
        __syncthreads();
    }
}
DI int moe_table(Frame& F) {
    LAS int* tile_e = (LAS int*)(F.lds + LDS_TBL); LAS int* tb = tile_e + TT_MAX;
    if (F.tid == 0) { int acc = 0;
        for (int e = 0; e < NE; ++e) { const int c = (int)__hip_atomic_load(F.ctl + CW_GCNT + 64 * e, __ATOMIC_RELAXED, __HIP_MEMORY_SCOPE_AGENT); const int nt = (c + 255) >> 8; tb[e] = acc; tb[33 + e] = c;
            for (int t = 0; t < nt; ++t) tile_e[acc + t] = e; acc += nt; }
        tb[32] = acc; tb[65] = acc; }
    __syncthreads();
    return tb[65];
}
DI void p9_gather(Frame& F, const Args& A) {
    const int TT = moe_table(F);
    LAS int* tile_e = (LAS int*)(F.lds + LDS_TBL); LAS int* tb = tile_e + TT_MAX;
    const bf16* XN = (const bf16*)(F.ws + WS_XN2); bf16* XG = (bf16*)(F.ws + WS_XG);
    const int* LD = (const int*)(F.ws + WS_LISTD); const float* LW = (const float*)(F.ws + WS_LISTW);
    int* SD = (int*)(F.ws + WS_SLOTD); float* SW = (float*)(F.ws + WS_SLOTW);
    const int gw = blockIdx.x * NWAVES + F.wave, NGW = F.G * NWAVES;
    for (int r = gw; r < TT * 256; r += NGW) { const int e = tile_e[r >> 8], idx = r - tb[e] * 256, cnt = tb[33 + e];
        if (idx < cnt) { const int dst = LD[(size_t)e * LCAP + idx]; const float w = LW[(size_t)e * LCAP + idx];
            const v4u* src = (const v4u*)(XN + (size_t)(dst >> 1) * D) + F.lane; v4u* d = (v4u*)(XG + (size_t)r * D) + F.lane; d[0] = src[0]; d[64] = src[64];
            if (F.lane == 0) { SD[r] = dst; SW[r] = w; } }
        else if (F.lane == 0) { SD[r] = -1; SW[r] = 0.f; } }
}
DI void p12_final(Frame& F, const Args& A) {
    const bf16* Y = (const bf16*)(F.ws + WS_Y);
    const int gw = blockIdx.x * NWAVES + F.wave, NGW = F.G * NWAVES, lane = F.lane;
    f32x4 gf[4];
#pragma unroll
    for (int j = 0; j < 4; ++j) gf[j] = ((const f32x4*)A.in[I_NFIN])[64 * j + lane];
    for (int m = gw; m < M; m += NGW) {
        f32x4* hr = (f32x4*)(F.out + (size_t)m * D) + lane; const v2u* y0 = (const v2u*)(Y + (size_t)(2 * m) * D) + lane; const v2u* y1 = (const v2u*)(Y + (size_t)(2 * m + 1) * D) + lane;
        f32x4 v[4]; float s = 0.f;
#pragma unroll
        for (int j = 0; j < 4; ++j) { v[j] = hr[64 * j]; const v2u a = y0[64 * j], c = y1[64 * j];
            v[j].x += __uint_as_float(a.x << 16) + __uint_as_float(c.x << 16); v[j].y += __uint_as_float(a.x & 0xffff0000u) + __uint_as_float(c.x & 0xffff0000u);
            v[j].z += __uint_as_float(a.y << 16) + __uint_as_float(c.y << 16); v[j].w += __uint_as_float(a.y & 0xffff0000u) + __uint_as_float(c.y & 0xffff0000u);
            s += (v[j].x * v[j].x + v[j].y * v[j].y) + (v[j].z * v[j].z + v[j].w * v[j].w); }
        const float rs = 1.0f / sqrtf(wave_sum(s) * (1.0f / D) + 1e-6f);
#pragma unroll
        for (int j = 0; j < 4; ++j) hr[64 * j] = v[j] * rs * gf[j];
    }
}

__global__ void __launch_bounds__(NWAVES * 64, 2) mk_fwd(Args args) {
    extern __shared__ __attribute__((aligned(16))) unsigned char lds[];
    Frame F;
    F.lds = (LAS unsigned char*)lds;
    F.tid = threadIdx.x; F.lane = F.tid & 63; F.wave = __builtin_amdgcn_readfirstlane(F.tid >> 6); F.G = gridDim.x;
    F.out = args.out; F.ws = args.ws; F.ctl = (unsigned*)(args.ws + WS_CTL);
    volatile LAS unsigned* MISC = (volatile LAS unsigned*)(F.lds + LDS_MISC);
    if (F.tid < 64) MISC[F.tid] = 0u;
    __syncthreads();
    const int lo = args.ph_lo, hi = args.ph_hi;
    XcdBarrier bar; bar.bar = (unsigned*)(F.ctl + CW_BAR); bar.x = 0; bar.st = nullptr;
    if (hi - lo > 1) bar = xcd_barrier_post((unsigned*)(F.ctl + CW_BAR), MISC + 8);
#ifdef ONLY_PHASE
#define IN(k) ((k) == ONLY_PHASE && lo <= (k) && (k) < hi)
#else
#define IN(k) (lo <= (k) && (k) < hi)
#endif
#define SEAM(k) do { if (IN(k) && IN((k) + 1)) xcd_barrier(bar); } while (0)
    unsigned char* ws = args.ws;
    if (IN(0)) { p0_prologue(F, args); SEAM(0); }
    if (IN(1)) {
        p1_meta_finish(F, args);
        pg8::Gemm g{(const pg8::bf16_t*)(ws + WS_XB), (const pg8::bf16_t*)(ws + WS_WIN), M, IN_COLS, D}; pg8::StaticOrder S; S.init(M, IN_COLS, F.G, (int)blockIdx.x);
        pg8::EpiIn E{(bf16*)(ws + WS_Q), (bf16*)(ws + WS_K), (bf16*)(ws + WS_V), (bf16*)(ws + WS_RC), (bf16*)F.out, (const float*)(ws + WS_RSTD)};
        pg8::gemm_phase<pg8::EpiIn, pg8::StaticOrder, true, true>(F.lds, g, S, E);
        SEAM(1);
    }
    if (IN(2)) { p2_attention(F, args); SEAM(2); }
    if (IN(3)) { p3_rwkv_prep(F, args); SEAM(3); }
    if (IN(4)) { p4_rwkv_scan(F, args); SEAM(4); }
    if (IN(5)) {
        pg8::Gemm g{(const pg8::bf16_t*)(ws + WS_AO), (const pg8::bf16_t*)(ws + WS_WOA), M, D, 512}; pg8::StaticOrder S; S.init(M, D, F.G, (int)blockIdx.x);
        pg8::EpiGate<0> E{(const bf16*)F.out, nullptr, (bf16*)(ws + WS_P1G)};
        pg8::gemm_phase<pg8::EpiGate<0>, pg8::StaticOrder, true, true>(F.lds, g, S, E);
        SEAM(5);
    }
    if (IN(6)) {
        pg8::Gemm g{(const pg8::bf16_t*)(ws + WS_RY), (const pg8::bf16_t*)(ws + WS_WOR), M, D, 512}; pg8::StaticOrder S; S.init(M, D, F.G, (int)blockIdx.x);
        pg8::EpiGate<1> E{(const bf16*)F.out, (const bf16*)(ws + WS_P1G), (bf16*)(ws + WS_MG)};
        pg8::gemm_phase<pg8::EpiGate<1>, pg8::StaticOrder, true, true>(F.lds, g, S, E);
        SEAM(6);
    }
    if (IN(7)) {
        pg8::Gemm g{(const pg8::bf16_t*)(ws + WS_MG), (const pg8::bf16_t*)(ws + WS_WOUT), M, D, D}; pg8::StaticOrder S; S.init(M, D, F.G, (int)blockIdx.x);
        pg8::EpiRes E{args.in[I_X], F.out};
        pg8::gemm_phase<pg8::EpiRes, pg8::StaticOrder, true, true>(F.lds, g, S, E);
        SEAM(7);
    }
    if (IN(8)) { p8_router(F, args); SEAM(8); }
    if (IN(9)) { p9_gather(F, args); SEAM(9); }
    if (IN(10)) {
        const int TT = moe_table(F);
        pg8::Gemm g{(const pg8::bf16_t*)(ws + WS_XG), (const pg8::bf16_t*)(ws + WS_WGU), CAP, NE * 512, D};
        pg8::GroupedOrder S{(const LAS int*)(F.lds + LDS_TBL), TT, 2, F.G, (int)blockIdx.x};
        pg8::EpiSwiglu E{(bf16*)(ws + WS_HMID), (const int*)(ws + WS_SLOTD)};
        pg8::gemm_phase<pg8::EpiSwiglu, pg8::GroupedOrder, true, true>(F.lds, g, S, E);
        SEAM(10);
    }
    if (IN(11)) {
        const int TT = moe_table(F);
        pg8::Gemm g{(const pg8::bf16_t*)(ws + WS_HMID), (const pg8::bf16_t*)(ws + WS_WDN), CAP, NE * 1024, 256};
        pg8::GroupedOrder S{(const LAS int*)(F.lds + LDS_TBL), TT, 4, F.G, (int)blockIdx.x};
        pg8::EpiDown E{(bf16*)(ws + WS_Y), (const int*)(ws + WS_SLOTD), (const float*)(ws + WS_SLOTW)};
        pg8::gemm_phase<pg8::EpiDown, pg8::GroupedOrder, true, true>(F.lds, g, S, E);
        SEAM(11);
    }
    if (IN(12)) { p12_final(F, args); }
#undef IN
#undef SEAM
}

extern "C" void kernel_launch(void* const* d_in, const int* in_sizes, int n_in, void* d_out, int out_size, void* d_ws, size_t ws_size, hipStream_t stream) {
    static int grid = 0;
    if (grid == 0) {
        if (n_in != 28 || in_sizes[0] != M * D || out_size != M * D || ws_size < WS_END) { fprintf(stderr, "kernel_launch: unexpected shapes (n_in %d, in0 %d, out %d, ws %zu)\n", n_in, n_in > 0 ? in_sizes[0] : -1, out_size, ws_size); grid = -1; return; }
        int dev = 0, cus = 0, per_cu = 0;
        if (hipGetDevice(&dev) != hipSuccess || hipDeviceGetAttribute(&cus, hipDeviceAttributeMultiprocessorCount, dev) != hipSuccess) { grid = -1; return; }
        if (hipFuncSetAttribute((const void*)mk_fwd, hipFuncAttributeMaxDynamicSharedMemorySize, LDS_BYTES) != hipSuccess) { fprintf(stderr, "kernel_launch: hipFuncSetAttribute failed\n"); grid = -1; return; }
        if (hipOccupancyMaxActiveBlocksPerMultiprocessor(&per_cu, (const void*)mk_fwd, NWAVES * 64, LDS_BYTES) != hipSuccess || per_cu < 1) fprintf(stderr, "kernel_launch: occupancy query reports %d\n", per_cu);
        (void)hipGetLastError();
        grid = cus;
    }
    if (grid < 0) return;
    if (hipMemsetAsync((char*)d_ws + WS_CTL, 0, CTL_ZERO_BYTES, stream) != hipSuccess) return;
    Args a{};
    for (int i = 0; i < 28; ++i) a.in[i] = (const float*)d_in[i];
    a.out = (float*)d_out; a.ws = (unsigned char*)d_ws;
#if MK_ONE_LAUNCH
    a.ph_lo = 0; a.ph_hi = N_PHASES; a.li = 0;
    hipLaunchKernelGGL(mk_fwd, dim3(grid), dim3(NWAVES * 64), LDS_BYTES, stream, a);
#else
    for (int p = 0; p < N_PHASES; ++p) { a.ph_lo = p; a.ph_hi = p + 1; a.li = p; hipLaunchKernelGGL(mk_fwd, dim3(grid), dim3(NWAVES * 64), LDS_BYTES, stream, a); }
#endif
}
```

```cpp
#include <hip/hip_runtime.h>
#include <cstdio>
#include <cstdint>
#define PROBE_MASK 0
namespace pg8 {
#define PG8_LAS __attribute__((address_space(3)))
typedef unsigned short bf16_t;
typedef short bf16x8 __attribute__((ext_vector_type(8)));
typedef float f32x4 __attribute__((ext_vector_type(4)));
typedef unsigned u32x4 __attribute__((ext_vector_type(4)));
constexpr int BM = 256, BK = 64, HALF = 128, HTB = HALF * BK * 2  , STAGE_BYTES = 8 * HTB, NXCD = 8, WGM = 8;

__host__ __device__ __forceinline__ int lds_byte(int r, int c) { const int st = (r >> 4) * 2 + (c >> 5), rr = r & 15, cc = c & 31, ob = rr * 64 + cc * 2; return st * 1024 + (ob ^ (((ob >> 9) & 1) << 5)); }
__host__ __device__ __forceinline__ void stage_rc(int b, int& R, int& C) { const int st = b / 1024, sb = b % 1024, swz = sb ^ (((sb >> 9) & 1) << 5); R = (st >> 1) * 16 + swz / 64; C = (st & 1) * 32 + (swz % 64) / 2; }
__host__ __device__ __forceinline__ int perm32(int rho) { const int n = rho >> 4, i = rho & 15; return 8 * (i >> 2) + 4 * n + (i & 3); }

struct Unit { int pm, pn, r0, cnt, ord; };
struct Gemm { const bf16_t* A; const bf16_t* Bt; int M, N, K, kext; };

struct StaticOrder {
    static constexpr bool GATHER = false;
    __device__ __forceinline__ unsigned a_off(const Unit&, int) const { return 0u; }
    __device__ __forceinline__ size_t koff(const Unit&) const { return 0; }
    __device__ __forceinline__ bool is_mid(const Unit&) const { return false; }
    int nM, nN, nwg, G, c;
    __host__ __device__ void init(int M, int N, int G_, int c_) { nM = M / BM; nN = N / BM; nwg = nM * nN; G = G_; c = c_; }
    __host__ __device__ bool next(int i, Unit& u) const {
        const long L = (long)i * G + c; if (L >= nwg) return false;
        int wgid = (int)L; { const int q = nwg / NXCD, r = nwg % NXCD, xcd = wgid % NXCD, off = wgid / NXCD; wgid = (xcd < r ? xcd * (q + 1) : r * (q + 1) + (xcd - r) * q) + off; }
        const int nig = WGM * nN, gid = wgid / nig, fm = gid * WGM, gsz = (nM - fm) < WGM ? (nM - fm) : WGM;
        u.pm = fm + ((wgid % nig) % gsz); u.pn = (wgid % nig) / gsz; u.r0 = 0; u.cnt = 0; u.ord = i; return true;
    }
    __device__ __forceinline__ void a_ready(const Unit&) const {}
    __device__ __forceinline__ void done(const Unit&) const {}
};

__device__ __forceinline__ unsigned cvt_pk_bf16(float lo, float hi) { unsigned r; asm volatile("v_cvt_pk_bf16_f32 %0, %1, %2" : "=v"(r) : "v"(lo), "v"(hi)); return r; }
typedef float f32x2 __attribute__((ext_vector_type(2)));

struct PanelOrder {
    static constexpr bool GATHER = false;
    int nM, nN, G, c;
    __host__ __device__ void init(int M, int N, int G_, int c_) { nM = M / BM; nN = N / BM; G = G_; c = c_; }
    __device__ __forceinline__ bool next(int i, Unit& u) const { const int p = c + (i / nN) * G; if (p >= nM) return false; u.pm = p; u.pn = i % nN; u.r0 = 0; u.cnt = 0; u.ord = i; return true; }
    __device__ __forceinline__ unsigned a_off(const Unit&, int) const { return 0u; }
    __device__ __forceinline__ size_t koff(const Unit&) const { return 0; }
    __device__ __forceinline__ bool is_mid(const Unit&) const { return false; }
    __device__ __forceinline__ void a_ready(const Unit&) const {}
    __device__ __forceinline__ void done(const Unit&) const {}
};
template <class Base> struct PairOrder {
    static constexpr bool GATHER = false;
    Base base; size_t koff_bytes;
    __device__ __forceinline__ bool next(int i, Unit& u) const { if (!base.next(i >> 1, u)) return false; u.r0 = i & 1; u.cnt = 0; u.ord = i; return true; }
    __device__ __forceinline__ unsigned a_off(const Unit&, int) const { return 0u; }
    __device__ __forceinline__ size_t koff(const Unit& u) const { return u.r0 ? koff_bytes : (size_t)0; }
    __device__ __forceinline__ bool is_mid(const Unit& u) const { return u.r0 == 0; }
    __device__ __forceinline__ void a_ready(const Unit&) const {}
    __device__ __forceinline__ void done(const Unit&) const {}
};
template <class Epi, class Sched, bool ALIGN_EPI = false, bool SP2 = false>
__device__ __forceinline__ void gemm_phase(PG8_LAS unsigned char* lds, const Gemm g, const Sched& S, const Epi& E) {
    const int tid = threadIdx.x, wid = __builtin_amdgcn_readfirstlane(tid >> 6), lane = tid & 63, wr = wid >> 2, wc = wid & 3, fr = lane & 15, fq = lane >> 4;
    const int K = g.K, nt = (g.kext ? g.kext : K) / BK;
    unsigned voffA[2], voffB[2];
#pragma unroll
    for (int i = 0; i < 2; ++i) { int R, C; stage_rc(tid * 16 + i * 8192, R, C); const int Rb = Epi::PERM ? ((R & ~31) + perm32(R & 31)) : R;
        voffA[i] = (unsigned)(R * K + C) * 2u; voffB[i] = (unsigned)(Rb * K + C) * 2u; }
    unsigned gAc[2][2], gAn[2][2]; int gR[2], gC[2];
#pragma unroll
    for (int i = 0; i < 2; ++i) { int R, C; stage_rc(tid * 16 + i * 8192, R, C); gR[i] = R; gC[i] = C * 2; gAc[0][i] = gAc[1][i] = gAn[0][i] = gAn[1][i] = 0u; }
    const size_t kstep = (size_t)(BK * 2);
    const size_t hstep = (size_t)HALF * K * 2;
    const size_t hstepA = Sched::GATHER ? (size_t)0 : hstep;
    const size_t tstep = 2 * hstep;
    const unsigned ldsw = (unsigned)wid * 1024u;
    const int aoff = lds_byte(wr * 64 + fr, fq * 8), boff = lds_byte(wc * 32 + fr, fq * 8);
#define PG8_SA(b, h) (((b) * 2 + (h)) * HTB)
#define PG8_SB(b, h) ((4 + (b) * 2 + (h)) * HTB)
#define PG8_STAGE(bufoff, gbase, voff) do { _Pragma("unroll") for (int _i = 0; _i < 2; ++_i) \
        __builtin_amdgcn_global_load_lds((const unsigned*)((const char*)(gbase) + (voff)[_i]), (PG8_LAS unsigned*)(lds + (bufoff) + ldsw + _i * 8192), 16, 0, 0); } while (0)
#define PG8_LDA(dst, b, h) do { _Pragma("unroll") for (int m = 0; m < 4; ++m) _Pragma("unroll") for (int k = 0; k < 2; ++k) dst[m][k] = *(const PG8_LAS bf16x8*)(lds + PG8_SA(b, h) + aoff + m * 2048 + k * 1024); } while (0)
#define PG8_LDB(dst, b, h) do { _Pragma("unroll") for (int n = 0; n < 2; ++n) _Pragma("unroll") for (int k = 0; k < 2; ++k) dst[n][k] = *(const PG8_LAS bf16x8*)(lds + PG8_SB(b, h) + boff + n * 2048 + k * 1024); } while (0)
#define PG8_MMA(ai, bj, At, Bt) do { __builtin_amdgcn_s_setprio(1); _Pragma("unroll") for (int m = 0; m < 4; ++m) _Pragma("unroll") for (int n = 0; n < 2; ++n) _Pragma("unroll") for (int k = 0; k < 2; ++k) \
        acc[ai][bj][m][n] = __builtin_amdgcn_mfma_f32_16x16x32_bf16(Bt[n][k], At[m][k], acc[ai][bj][m][n], 0, 0, 0); __builtin_amdgcn_s_setprio(0); } while (0)
#define PG8_WAIT_V(n) asm volatile("s_waitcnt vmcnt(" #n ")" ::: "memory")
#define PG8_WAIT_L(n) asm volatile("s_waitcnt lgkmcnt(" #n ")" ::: "memory")
#define PG8_BAR __builtin_amdgcn_s_barrier()
#define PG8_SCHED __builtin_amdgcn_sched_barrier(0)
    Unit cur, nxt; int ui = 0;
    if (!S.next(0, cur)) return;
    f32x4 acc[2][2][4][2];
#pragma unroll
    for (int a = 0; a < 2; ++a)
#pragma unroll
        for (int b = 0; b < 2; ++b)
#pragma unroll
            for (int m = 0; m < 4; ++m)
#pragma unroll
                for (int n = 0; n < 2; ++n) acc[a][b][m][n] = (f32x4){0.f, 0.f, 0.f, 0.f};
    bf16x8 At[4][2], B0[2][2], B1[2][2];
    const char* cA = (const char*)g.A + (Sched::GATHER ? (size_t)0 : (size_t)cur.pm * tstep) + S.koff(cur); const char* cB = (const char*)g.Bt + (size_t)cur.pn * tstep + S.koff(cur);
    if constexpr (Sched::GATHER) {
#pragma unroll
        for (int h = 0; h < 2; ++h)
#pragma unroll
            for (int i = 0; i < 2; ++i) gAc[h][i] = S.a_off(cur, h * HALF + gR[i]) + (unsigned)gC[i]; }
#define PG8_VA(sel, h) (Sched::GATHER ? (sel)[h] : voffA)
    S.a_ready(cur);
    if constexpr (SP2) {
        PG8_STAGE(PG8_SB(0, 0), cB, voffB); PG8_STAGE(PG8_SB(0, 1), cB + hstep, voffB); PG8_STAGE(PG8_SA(0, 0), cA, PG8_VA(gAc, 0)); PG8_STAGE(PG8_SA(0, 1), cA + hstepA, PG8_VA(gAc, 1));
        if (wr == 1) PG8_BAR;
        PG8_WAIT_V(2); PG8_BAR;
        PG8_STAGE(PG8_SB(1, 0), cB + kstep, voffB); PG8_STAGE(PG8_SA(1, 0), cA + kstep, PG8_VA(gAc, 0)); PG8_STAGE(PG8_SB(1, 1), cB + hstep + kstep, voffB);
        PG8_WAIT_V(6); PG8_BAR;
    } else {
        PG8_STAGE(PG8_SB(0, 0), cB, voffB); PG8_STAGE(PG8_SA(0, 0), cA, voffA); PG8_STAGE(PG8_SB(0, 1), cB + hstep, voffB); PG8_STAGE(PG8_SA(0, 1), cA + hstep, voffA);
        if (wr == 1) PG8_BAR;
        PG8_WAIT_V(4); PG8_BAR;
        PG8_STAGE(PG8_SB(1, 0), cB + kstep, voffB); PG8_STAGE(PG8_SA(1, 0), cA + kstep, voffA); PG8_STAGE(PG8_SB(1, 1), cB + hstep + kstep, voffB);
        PG8_WAIT_V(6); PG8_BAR;
    }
    for (;;) {
        const bool has_next = S.next(ui + 1, nxt);
        const char* nA = (has_next && !Sched::GATHER) ? (const char*)g.A + (size_t)nxt.pm * tstep + S.koff(nxt) : cA; const char* nB = has_next ? (const char*)g.Bt + (size_t)nxt.pn * tstep + S.koff(nxt) : cB;
        if constexpr (Sched::GATHER) {
#pragma unroll
            for (int h = 0; h < 2; ++h)
#pragma unroll
                for (int i = 0; i < 2; ++i) gAn[h][i] = has_next ? S.a_off(nxt, h * HALF + gR[i]) + (unsigned)gC[i] : gAc[h][i]; }
#pragma unroll 1
        for (int t = 0; t < nt; t += 2) {
            const bool last = (t == nt - 2);
            const char* a1 = cA + (size_t)(t + 1) * kstep;
            const char* a2 = last ? nA : cA + (size_t)(t + 2) * kstep; const char* b2 = last ? nB : cB + (size_t)(t + 2) * kstep;
            const char* a3 = a2 + kstep; const char* b3 = b2 + kstep;
            if (last && has_next) S.a_ready(nxt);
            unsigned g2[2][2];
#pragma unroll
            for (int h = 0; h < 2; ++h)
#pragma unroll
                for (int i = 0; i < 2; ++i) g2[h][i] = last ? gAn[h][i] : gAc[h][i];
            if constexpr (SP2) {
            PG8_LDB(B0, 0, 0); PG8_LDB(B1, 0, 1); PG8_SCHED; PG8_LDA(At, 0, 0); PG8_STAGE(PG8_SA(1, 1), a1 + hstepA, PG8_VA(gAc, 1));
            PG8_WAIT_V(8); PG8_WAIT_L(0); PG8_BAR; PG8_MMA(0, 0, At, B0); PG8_MMA(0, 1, At, B1); PG8_BAR; PG8_SCHED;
            PG8_LDA(At, 0, 1); PG8_STAGE(PG8_SB(0, 0), b2, voffB); PG8_STAGE(PG8_SB(0, 1), b2 + hstep, voffB); PG8_STAGE(PG8_SA(0, 0), a2, PG8_VA(g2, 0));
            PG8_WAIT_V(8); PG8_WAIT_L(0); PG8_BAR; PG8_MMA(1, 0, At, B0); PG8_MMA(1, 1, At, B1); PG8_BAR; PG8_SCHED;
            PG8_LDB(B0, 1, 0); PG8_LDB(B1, 1, 1); PG8_SCHED; PG8_LDA(At, 1, 0); PG8_STAGE(PG8_SA(0, 1), a2 + hstepA, PG8_VA(g2, 1));
            PG8_WAIT_V(8); PG8_WAIT_L(0); PG8_BAR; PG8_MMA(0, 0, At, B0); PG8_MMA(0, 1, At, B1); PG8_BAR; PG8_SCHED;
            PG8_LDA(At, 1, 1); PG8_STAGE(PG8_SB(1, 0), b3, voffB); PG8_STAGE(PG8_SB(1, 1), b3 + hstep, voffB); PG8_STAGE(PG8_SA(1, 0), a3, PG8_VA(g2, 0));
            PG8_WAIT_V(8); PG8_WAIT_L(0); PG8_BAR; PG8_MMA(1, 0, At, B0); PG8_MMA(1, 1, At, B1); PG8_BAR; PG8_SCHED;
            } else {
            PG8_LDB(B0, 0, 0); PG8_SCHED; PG8_LDA(At, 0, 0); PG8_STAGE(PG8_SA(1, 1), a1 + hstep, voffA);
            PG8_WAIT_L(8); PG8_BAR; PG8_WAIT_L(0); PG8_MMA(0, 0, At, B0); PG8_BAR; PG8_SCHED;
            PG8_LDB(B1, 0, 1); PG8_STAGE(PG8_SB(0, 0), b2, voffB);
            PG8_BAR; PG8_WAIT_L(0); PG8_MMA(0, 1, At, B1); PG8_BAR;
            PG8_LDA(At, 0, 1); PG8_STAGE(PG8_SA(0, 0), a2, voffA);
            PG8_BAR; PG8_WAIT_L(0); PG8_MMA(1, 0, At, B0); PG8_BAR; PG8_SCHED;
            PG8_STAGE(PG8_SB(0, 1), b2 + hstep, voffB);
            PG8_WAIT_V(6); PG8_BAR; PG8_MMA(1, 1, At, B1); PG8_BAR;
            PG8_LDB(B0, 1, 0); PG8_SCHED; PG8_LDA(At, 1, 0); PG8_STAGE(PG8_SA(0, 1), a2 + hstep, voffA);
            PG8_WAIT_L(8); PG8_BAR; PG8_WAIT_L(0); PG8_MMA(0, 0, At, B0); PG8_BAR; PG8_SCHED;
            PG8_LDB(B1, 1, 1); PG8_STAGE(PG8_SB(1, 0), b3, voffB);
            PG8_BAR; PG8_WAIT_L(0); PG8_MMA(0, 1, At, B1); PG8_BAR;
            PG8_LDA(At, 1, 1); PG8_STAGE(PG8_SA(1, 0), a3, voffA);
            PG8_BAR; PG8_WAIT_L(0); PG8_MMA(1, 0, At, B0); PG8_BAR; PG8_SCHED;
            PG8_STAGE(PG8_SB(1, 1), b3 + hstep, voffB);
            PG8_WAIT_V(6); PG8_BAR; PG8_MMA(1, 1, At, B1); PG8_BAR;
            }
        }
        if constexpr (ALIGN_EPI) { if (wr == 0) PG8_BAR; }
        bool keep_acc = false;
        if constexpr (Epi::MIDK) { if (S.is_mid(cur)) { E.mid(acc, cur, wr, wc, fr, fq); keep_acc = true; } else E(acc, cur, wr, wc, fr, fq); }
        else if constexpr (!Epi::AFTER_DRAIN) { E(acc, cur, wr, wc, fr, fq);
#ifdef PROBE_EPI2
            if constexpr (Epi::PROBE2) { asm volatile("" ::: "memory"); E(acc, cur, wr, wc, fr, fq); }
#endif
            S.done(cur); }
        if (!has_next) break;
        if (!keep_acc)
#pragma unroll
        for (int a = 0; a < 2; ++a)
#pragma unroll
            for (int b = 0; b < 2; ++b)
#pragma unroll
                for (int m = 0; m < 4; ++m)
#pragma unroll
                    for (int n = 0; n < 2; ++n) acc[a][b][m][n] = (f32x4){0.f, 0.f, 0.f, 0.f};
        cur = nxt; cA = nA; cB = nB; ++ui;
        if constexpr (Sched::GATHER) {
#pragma unroll
            for (int h = 0; h < 2; ++h)
#pragma unroll
                for (int i = 0; i < 2; ++i) gAc[h][i] = gAn[h][i]; }
        if constexpr (ALIGN_EPI) { if (wr == 1) PG8_BAR; }
    }
    PG8_WAIT_V(0);
    if constexpr (!ALIGN_EPI) { if (wr == 0) PG8_BAR; }
    PG8_BAR;
    if constexpr (Epi::AFTER_DRAIN) { E.fused(acc, cur, wr, wc, fr, fq, lds, wid, lane); S.done(cur); }
#undef PG8_SA
#undef PG8_VA
#undef PG8_SB
#undef PG8_STAGE
#undef PG8_LDA
#undef PG8_LDB
#undef PG8_MMA
#undef PG8_WAIT_V
#undef PG8_WAIT_L
#undef PG8_BAR
#undef PG8_SCHED
}

__device__ __forceinline__ float sigm(float x) { return __builtin_amdgcn_rcpf(1.0f + __builtin_amdgcn_exp2f(-1.44269504089f * x)); }
__device__ __forceinline__ f32x4 up_lo(u32x4 w) { f32x4 r; r[0] = __uint_as_float(w[0] << 16); r[1] = __uint_as_float(w[0] & 0xffff0000u); r[2] = __uint_as_float(w[1] << 16); r[3] = __uint_as_float(w[1] & 0xffff0000u); return r; }
__device__ __forceinline__ f32x4 up_hi(u32x4 w) { f32x4 r; r[0] = __uint_as_float(w[2] << 16); r[1] = __uint_as_float(w[2] & 0xffff0000u); r[2] = __uint_as_float(w[3] << 16); r[3] = __uint_as_float(w[3] & 0xffff0000u); return r; }
__device__ __forceinline__ u32x4 pack8(f32x4 v0, f32x4 v1) { u32x4 w; w.x = cvt_pk_bf16(v0[0], v0[1]); w.y = cvt_pk_bf16(v0[2], v0[3]); w.z = cvt_pk_bf16(v1[0], v1[1]); w.w = cvt_pk_bf16(v1[2], v1[3]); return w; }

struct EpiIn {
    static constexpr bool PERM = true, AFTER_DRAIN = false, MIDK = false, PROBE2 = true;
    bf16_t *Q, *Kb, *Vb, *RC, *G;
    __device__ __forceinline__ void operator()(const f32x4 (&acc)[2][2][4][2], const Unit& u, int wr, int wc, int fr, int fq) const {
        const int row0 = u.pm * BM + wr * 64 + fr, cl = wc * 32 + 8 * fq;
        bf16_t* b0; bf16_t* b1; int ld; const int pn = u.pn;
        if (pn < 2) { ld = 512; b0 = Q + pn * 256 + cl; b1 = b0 + 128; }
        else if (pn == 2) { ld = 128; b0 = Kb + cl; b1 = Vb + cl; }
        else if (pn < 10) { ld = 1792; b0 = RC + (pn - 3) * 256 + cl; b1 = b0 + 128; }
        else { ld = 2048; b0 = G + (pn - 10) * 128 + cl; b1 = b0 + 1024; }
        const bool sg = pn >= 10;
#pragma unroll
        for (int ai = 0; ai < 2; ++ai)
#pragma unroll
            for (int m = 0; m < 4; ++m) { const int row = row0 + ai * HALF + m * 16;
                f32x4 a0 = acc[ai][0][m][0], a1 = acc[ai][0][m][1], c0 = acc[ai][1][m][0], c1 = acc[ai][1][m][1];
                if (sg) {
#pragma unroll
                    for (int j = 0; j < 4; ++j) { const float ea0 = __builtin_amdgcn_exp2f(-1.44269504089f * a0[j]), ea1 = __builtin_amdgcn_exp2f(-1.44269504089f * a1[j]), eb0 = __builtin_amdgcn_exp2f(-1.44269504089f * c0[j]), eb1 = __builtin_amdgcn_exp2f(-1.44269504089f * c1[j]);
                        a0[j] = (1.0f + eb0) * __builtin_amdgcn_rcpf(1.0f + ea0); a1[j] = (1.0f + eb1) * __builtin_amdgcn_rcpf(1.0f + ea1); c0[j] = __builtin_amdgcn_rcpf(1.0f + eb0); c1[j] = __builtin_amdgcn_rcpf(1.0f + eb1); } }
                *(u32x4*)(b0 + (size_t)row * ld) = pack8(a0, a1); *(u32x4*)(b1 + (size_t)row * ld) = pack8(c0, c1); }
    }
};
struct EpiGate2 {
    static constexpr bool PERM = true, AFTER_DRAIN = false, MIDK = true;
    const bf16_t* G; bf16_t* O;
    __device__ __forceinline__ void mid(f32x4 (&acc)[2][2][4][2], const Unit& u, int wr, int wc, int fr, int fq) const {
        const int row0 = u.pm * BM + wr * 64 + fr, col0 = u.pn * BM + wc * 32 + 8 * fq;
        u32x4 g0w[2][4][2];
#pragma unroll
        for (int ai = 0; ai < 2; ++ai)
#pragma unroll
            for (int m = 0; m < 4; ++m)
#pragma unroll
                for (int bj = 0; bj < 2; ++bj) g0w[ai][m][bj] = *(const u32x4*)(G + (size_t)(row0 + ai * HALF + m * 16) * 2048 + col0 + bj * HALF);
#pragma unroll
        for (int ai = 0; ai < 2; ++ai)
#pragma unroll
            for (int m = 0; m < 4; ++m)
#pragma unroll
                for (int bj = 0; bj < 2; ++bj)
#pragma unroll
                    for (int j = 0; j < 4; ++j) { const unsigned gn = g0w[ai][m][bj][j];
                        acc[ai][bj][m][j >> 1][2 * (j & 1)] *= __uint_as_float(gn << 16); acc[ai][bj][m][j >> 1][2 * (j & 1) + 1] *= __uint_as_float(gn & 0xffff0000u); }
    }
    __device__ __forceinline__ void operator()(const f32x4 (&acc)[2][2][4][2], const Unit& u, int wr, int wc, int fr, int fq) const {
        const int row0 = u.pm * BM + wr * 64 + fr, col0 = u.pn * BM + wc * 32 + 8 * fq;
        u32x4 gw[2][4][2];
#pragma unroll
        for (int ai = 0; ai < 2; ++ai)
#pragma unroll
            for (int m = 0; m < 4; ++m)
#pragma unroll
                for (int bj = 0; bj < 2; ++bj) gw[ai][m][bj] = *(const u32x4*)(G + (size_t)(row0 + ai * HALF + m * 16) * 2048 + 1024 + col0 + bj * HALF);
#pragma unroll
        for (int ai = 0; ai < 2; ++ai)
#pragma unroll
            for (int m = 0; m < 4; ++m)
#pragma unroll
                for (int bj = 0; bj < 2; ++bj) *(u32x4*)(O + (size_t)(row0 + ai * HALF + m * 16) * 1024 + col0 + bj * HALF) = pack8(acc[ai][bj][m][0] * up_lo(gw[ai][m][bj]), acc[ai][bj][m][1] * up_hi(gw[ai][m][bj]));
    }
};
struct EpiRes {
    static constexpr bool PERM = true, AFTER_DRAIN = false, MIDK = false, PROBE2 = false;
    const float* X; bf16_t* O;
    __device__ __forceinline__ void operator()(const f32x4 (&acc)[2][2][4][2], const Unit& u, int wr, int wc, int fr, int fq) const {
        const int row0 = u.pm * BM + wr * 64 + fr, col0 = u.pn * BM + wc * 32 + 8 * fq;
#pragma unroll
        for (int ai = 0; ai < 2; ++ai) { f32x4 xv[4][2][2];
#pragma unroll
            for (int m = 0; m < 4; ++m)
#pragma unroll
                for (int bj = 0; bj < 2; ++bj)
#pragma unroll
                    for (int n = 0; n < 2; ++n) xv[m][bj][n] = *(const f32x4*)(X + (size_t)(row0 + ai * HALF + m * 16) * 1024 + col0 + bj * HALF + 4 * n);
#pragma unroll
            for (int m = 0; m < 4; ++m)
#pragma unroll
                for (int bj = 0; bj < 2; ++bj) *(u32x4*)(O + (size_t)(row0 + ai * HALF + m * 16) * 1024 + col0 + bj * HALF) = pack8(xv[m][bj][0] + acc[ai][bj][m][0], xv[m][bj][1] + acc[ai][bj][m][1]);
            asm volatile("" ::: "memory"); }
    }
};
template <bool GATHER_> struct GroupedOrder {
    static constexpr bool GATHER = GATHER_;
    const PG8_LAS int* tile_e; const PG8_LAS int* tb; int ntiles, ntn, G, c; const PG8_LAS int* lds_d; unsigned rowbytes;
    __device__ __forceinline__ bool next(int i, Unit& u) const {
        const int L = i * G + c; if (L >= ntiles * ntn) return false;
        const int mt = L / ntn, nl = L - mt * ntn; const int e = __builtin_amdgcn_readfirstlane(tile_e[mt]);
        u.pm = mt; u.pn = e * ntn + nl; u.r0 = __builtin_amdgcn_readfirstlane((mt - tb[e]) * BM); u.cnt = __builtin_amdgcn_readfirstlane(tb[33 + e]); u.ord = i; return true;
    }
    __device__ __forceinline__ unsigned a_off(const Unit& u, int r) const {
        const int d = lds_d[u.ord * BM + r]; const int tok = d >= 0 ? (d >> 1) : 0;
        return (unsigned)tok * rowbytes;
    }
    __device__ __forceinline__ size_t koff(const Unit&) const { return 0; }
    __device__ __forceinline__ bool is_mid(const Unit&) const { return false; }
    __device__ __forceinline__ void a_ready(const Unit&) const {}
    __device__ __forceinline__ void done(const Unit&) const {}
};
struct EpiSwiglu {
    static constexpr bool PERM = true, AFTER_DRAIN = false, MIDK = false, PROBE2 = false;
    bf16_t* H; const PG8_LAS int* lds_d; const PG8_LAS float* lds_w; int* slot_dst;
    __device__ __forceinline__ void operator()(const f32x4 (&acc)[2][2][4][2], const Unit& u, int wr, int wc, int fr, int fq) const {
        const int rl0 = wr * 64 + fr, row0 = u.pm * BM + rl0, col0 = (u.pn & 1) * 128 + wc * 32 + 8 * fq;
        const bool slots = (u.pn & 1) == 0 && wc == 0 && fq == 0;
        int ld8[2][4]; float lw8[2][4];
#pragma unroll
        for (int ai = 0; ai < 2; ++ai)
#pragma unroll
            for (int m = 0; m < 4; ++m) { const int rl = u.ord * BM + rl0 + ai * HALF + m * 16; ld8[ai][m] = lds_d[rl]; lw8[ai][m] = lds_w[rl]; }
        if (slots) {
#pragma unroll
            for (int ai = 0; ai < 2; ++ai)
#pragma unroll
                for (int m = 0; m < 4; ++m) slot_dst[row0 + ai * HALF + m * 16] = ld8[ai][m]; }
#pragma unroll
        for (int ai = 0; ai < 2; ++ai)
#pragma unroll
            for (int m = 0; m < 4; ++m) { const int row = row0 + ai * HALF + m * 16;
                if (ld8[ai][m] >= 0) { f32x4 v0, v1; const float w = lw8[ai][m];
#pragma unroll
                    for (int j = 0; j < 4; ++j) { const float g0 = acc[ai][0][m][0][j], g1 = acc[ai][0][m][1][j]; v0[j] = w * g0 * sigm(g0) * acc[ai][1][m][0][j]; v1[j] = w * g1 * sigm(g1) * acc[ai][1][m][1][j]; }
                    *(u32x4*)(H + (size_t)row * 256 + col0) = pack8(v0, v1); } }
    }
};
struct EpiDown {
    static constexpr bool PERM = true, AFTER_DRAIN = false, MIDK = false, PROBE2 = false;
    unsigned char* Y; const PG8_LAS int* lds_slot;
    __device__ __forceinline__ static unsigned pk4(float a, float b, float c, float d) { int w = 0; w = __builtin_amdgcn_cvt_pk_fp8_f32(a * 16.f, b * 16.f, w, false); w = __builtin_amdgcn_cvt_pk_fp8_f32(c * 16.f, d * 16.f, w, true); return (unsigned)w; }
    __device__ __forceinline__ void operator()(const f32x4 (&acc)[2][2][4][2], const Unit& u, int wr, int wc, int fr, int fq) const {
        const int row0 = u.pm * BM + wr * 64 + fr, col0 = (u.pn & 3) * 256 + wc * 32 + 8 * fq;
        int dsts[2][4];
#pragma unroll
        for (int ai = 0; ai < 2; ++ai)
#pragma unroll
            for (int m = 0; m < 4; ++m) dsts[ai][m] = lds_slot[u.ord * BM + wr * 64 + fr + ai * HALF + m * 16];
        typedef unsigned u32x2 __attribute__((ext_vector_type(2)));
#pragma unroll
        for (int ai = 0; ai < 2; ++ai)
#pragma unroll
            for (int m = 0; m < 4; ++m) { const int dst = dsts[ai][m];
                if (dst >= 0) {
#pragma unroll
                    for (int bj = 0; bj < 2; ++bj) { const f32x4 v0 = acc[ai][bj][m][0], v1 = acc[ai][bj][m][1]; u32x2 w; w.x = pk4(v0[0], v0[1], v0[2], v0[3]); w.y = pk4(v1[0], v1[1], v1[2], v1[3]);
                        *(u32x2*)(Y + (size_t)dst * 1024 + col0 + bj * HALF) = w; } } }
    }
};
}

constexpr int NWAVES = 8;
constexpr int D = 1024, NB = 8, SEQ = 8192, M = NB * SEQ, NMETA = 16, MV = M + NMETA;
constexpr int IN_COLS = 4608, RCW = 1792;
constexpr int NE = 32, TT_MAX = 544, CAP = TT_MAX * 256, LCAP = 65536;
constexpr int N_PHASES = 12;
#ifndef MK_ONE_LAUNCH
#define MK_ONE_LAUNCH 1
#endif

constexpr size_t MiB = 1u << 20;
constexpr size_t WS_CTL = 0, CTL_ZERO_BYTES = 1 * MiB;
constexpr size_t WS_RSTD = 1 * MiB, WS_METAP = 1 * MiB + 512 * 1024, WS_SLOTD = 3 * MiB, WS_SLOTW = 4 * MiB;
constexpr size_t WS_WIN = 6 * MiB, WS_WOA = 15 * MiB, WS_WOR = 16 * MiB, WS_WOUT = 17 * MiB, WS_WGU = 19 * MiB, WS_WDN = 51 * MiB;
constexpr size_t WS_LISTD = 68 * MiB, WS_LISTW = 76 * MiB;
constexpr size_t WS_XB = 96 * MiB, WS_Q = 224 * MiB, WS_K = 288 * MiB, WS_V = 305 * MiB, WS_RC = 352 * MiB, WS_AR = 96 * MiB;
constexpr size_t WS_GB = 224 * MiB, WS_POST = 288 * MiB, WS_MG = 416 * MiB;
constexpr size_t WS_XN2 = 96 * MiB, WS_XG = 224 * MiB, WS_HMID = 496 * MiB, WS_Y = 611 * MiB, WS_END = 1024 * MiB;
static_assert(WS_Y + (size_t)2 * M * D * 2 <= WS_END && WS_HMID + (size_t)CAP * 256 * 2 <= 611 * MiB && WS_RC + (size_t)MV * RCW * 2 <= 611 * MiB, "ws map");
constexpr int CW_BAR = 4096;
constexpr int CW_GCNT = 16384;

constexpr int LDS_BYTES = 163840;
constexpr int LDS_RT = 147456, LDS_TBL = 159744, LDS_MISC = 163328;

#define LAS __attribute__((address_space(3)))
typedef unsigned short bf16;
typedef unsigned v4u __attribute__((ext_vector_type(4)));
typedef unsigned v2u __attribute__((ext_vector_type(2)));
typedef float f32x4 __attribute__((ext_vector_type(4)));
#define DI __device__ __forceinline__
#define LDS_WAIT() asm volatile("s_waitcnt lgkmcnt(0)" ::: "memory")
#define LDS_BARRIER() asm volatile("s_waitcnt lgkmcnt(0)\n\ts_barrier" ::: "memory")
typedef float f32x2_t __attribute__((ext_vector_type(2)));
typedef __bf16 bf16x2_t __attribute__((ext_vector_type(2)));
DI unsigned pk2(float lo, float hi) { const f32x2_t v = {lo, hi}; const bf16x2_t b = __builtin_convertvector(v, bf16x2_t); return __builtin_bit_cast(unsigned, b); }
DI unsigned f2bf(float f) { return pk2(f, 0.f) & 0xffffu; }
DI float bf2f(bf16 b) { return __uint_as_float((unsigned)b << 16); }
DI float wave_sum(float v) {
#pragma unroll
    for (int o = 1; o < 64; o <<= 1) v += __shfl_xor(v, o);
    return v;
}
DI float wave_max(float v) {
#pragma unroll
    for (int o = 1; o < 64; o <<= 1) v = fmaxf(v, __shfl_xor(v, o));
    return v;
}
DI float sigmoid_f(float x) { return __builtin_amdgcn_rcpf(1.0f + __builtin_amdgcn_exp2f(-1.44269504089f * x)); }

#define XB_TMO      128
#define XB_XCNT(j)  (256  + 64 * (j))
#define XB_XSUB(j)  (1280 + 64 * (j))
#define XB_XGEN(j)  (2304 + 64 * (j))
#define XB_TOP      3328
#define XB_TOPGEN   3392
#define XCD_BAR_WORDS 3456
#define XB_SPIN_CAP (1u << 20)
DI unsigned xb_ld(unsigned* p)              { return __hip_atomic_load(p, __ATOMIC_RELAXED, __HIP_MEMORY_SCOPE_AGENT); }
DI unsigned xb_add(unsigned* p, unsigned v) { return __hip_atomic_fetch_add(p, v, __ATOMIC_RELAXED, __HIP_MEMORY_SCOPE_AGENT); }
DI unsigned xb_xcc_id() { return (unsigned)__builtin_amdgcn_s_getreg((3 << 11) | 20) & 0xFu; }
#define XB_SPIN(cond, bar) do { unsigned _sp = 0; while (cond) { __builtin_amdgcn_s_sleep(1); \
    if ((++_sp & 255u) == 0u) { if (xb_ld(&(bar)[XB_TMO])) break; if (_sp > XB_SPIN_CAP) { atomicAdd(&(bar)[XB_TMO], 1u); break; } } } } while (0)
struct XcdBarrier { unsigned* bar; unsigned x; volatile LAS unsigned* st; };
DI XcdBarrier xcd_barrier_post(unsigned* bar, volatile LAS unsigned* st) {
    XcdBarrier b; b.bar = bar; b.x = xb_xcc_id(); b.st = st;
    if (threadIdx.x == 0) (void)xb_add(&bar[XB_XCNT(b.x)], 1u);
    return b;
}
DI void xcd_barrier_complete(unsigned* bar, unsigned x, unsigned& nloc, unsigned& nx) {
    const unsigned G = gridDim.x * gridDim.y * gridDim.z;
    unsigned sum, cnt, mine, sp = 0u;
    for (;;) {
        sum = 0u; cnt = 0u; mine = 0u;
#pragma unroll
        for (unsigned j = 0; j < 16; ++j) { const unsigned c = xb_ld(&bar[XB_XCNT(j)]); sum += c; cnt += (c > 0u) ? 1u : 0u; mine = (j == x) ? c : mine; }
        if (sum == G) break;
        __builtin_amdgcn_s_sleep(1);
        if ((++sp & 255u) == 0u) { if (xb_ld(&bar[XB_TMO])) break; if (sp > XB_SPIN_CAP) { atomicAdd(&bar[XB_TMO], 1u); break; } }
    }
    nloc = mine > 0u ? mine : 1u; nx = cnt > 0u ? cnt : 1u;
}
DI void xcd_barrier(const XcdBarrier& b) {
    asm volatile("s_waitcnt vmcnt(0)" ::: "memory");
    __syncthreads();
    if (threadIdx.x == 0) {
        unsigned* bar = b.bar;
        __builtin_amdgcn_s_waitcnt(0);
        unsigned nloc = b.st[0], nx = b.st[1];
        if (nloc == 0u) { xcd_barrier_complete(bar, b.x, nloc, nx); b.st[0] = nloc; b.st[1] = nx; }
        const unsigned old = xb_add(&bar[XB_XSUB(b.x)], 1u);
        const unsigned gen = old / nloc;
        if (old + 1u == (gen + 1u) * nloc) {
            __builtin_amdgcn_fence(__ATOMIC_RELEASE, "agent");
            asm volatile("s_waitcnt vmcnt(0)" ::: "memory");
            const unsigned og = xb_add(&bar[XB_TOP], 1u);
            const unsigned tg = og / nx;
            if (og + 1u == (tg + 1u) * nx) xb_add(&bar[XB_TOPGEN], 1u);
            else XB_SPIN(xb_ld(&bar[XB_TOPGEN]) == tg, bar);
            __builtin_amdgcn_fence(__ATOMIC_ACQUIRE, "agent");
            xb_add(&bar[XB_XGEN(b.x)], 1u);
            asm volatile("s_waitcnt vmcnt(0)" ::: "memory");
        } else {
            XB_SPIN(xb_ld(&bar[XB_XGEN(b.x)]) == gen, bar);
            __builtin_amdgcn_fence(__ATOMIC_ACQUIRE, "agent");
            asm volatile("s_waitcnt vmcnt(0)" ::: "memory");
        }
    }
    __syncthreads();
}

struct Args { const float* in[28]; float* out; unsigned char* ws; int ph_lo, ph_hi, li, pad; };
struct Frame {
    LAS unsigned char* lds;
    unsigned* ctl;
    int tid, lane, wave, G;
    float* out; unsigned char* ws;
};
enum { I_X = 0, I_META, I_NMG, I_WIN, I_MU, I_W0, I_WD, I_A0, I_WA, I_WG, I_KK, I_KA, I_RK, I_LNG, I_LNB, I_SINK, I_WOA, I_WOR, I_WOUT, I_NFG, I_WGRP, I_BGRP, I_WEXP, I_BEXP, I_EG, I_EU, I_ED, I_NFIN };

DI void transpose_item(const float* W, int ldw, int K, bf16* WT, int k0, int n0, int drow0, const float* kscale, float nscale, LAS float* scr, int lane) {
    float wv[32];
#pragma unroll
    for (int i = 0; i < 32; ++i) { const int kk = 2 * i + (lane >> 5); wv[i] = W[(size_t)(k0 + kk) * ldw + n0 + (lane & 31)]; }
#pragma unroll
    for (int i = 0; i < 32; ++i) { const int kk = 2 * i + (lane >> 5); float v = wv[i]; if (kscale) v *= kscale[k0 + kk]; scr[kk * 33 + (lane & 31)] = v * nscale; }
    LDS_WAIT(); asm volatile("" ::: "memory");
    const int c = lane & 7;
#pragma unroll
    for (int j = 0; j < 4; ++j) { const int n = (lane >> 3) + 8 * j; const LAS float* s = scr + (8 * c) * 33 + n;
        v4u o; o.x = pk2(s[0 * 33], s[1 * 33]); o.y = pk2(s[2 * 33], s[3 * 33]); o.z = pk2(s[4 * 33], s[5 * 33]); o.w = pk2(s[6 * 33], s[7 * 33]);
        *(v4u*)(WT + (size_t)(drow0 + n) * K + k0 + 8 * c) = o; }
    LDS_WAIT(); asm volatile("" ::: "memory");
}
DI void expert_weights(Frame& F, const Args& A, int wg0) {
    if ((int)blockIdx.x < wg0) return;
    LAS float* scr = (LAS float*)(F.lds + F.wave * 16384);
    unsigned char* ws = F.ws;
    constexpr int I_G = 32 * 16 * 8, I_U = I_G, I_DN = 32 * 4 * 32;
    const int gw = ((int)blockIdx.x - wg0) * NWAVES + F.wave, NGW = (F.G - wg0) * NWAVES;
    for (int it = gw; it < I_G + I_U + I_DN; it += NGW) {
        int r = it;
        if (r < I_G + I_U) { const int up = r >= I_G; if (up) r -= I_G; const int e = r / 128, q = r % 128, kb = q / 8, nb = q % 8, n0 = 32 * nb;
            transpose_item(A.in[up ? I_EU : I_EG] + (size_t)e * 1024 * 256, 256, 1024, (bf16*)(ws + WS_WGU), 64 * kb, n0, e * 512 + (n0 >> 7) * 256 + up * 128 + (n0 & 127), nullptr, 1.0f, scr, F.lane); continue; } r -= I_G + I_U;
        { const int e = r / 128, q = r % 128, kb = q / 32, nb = q % 32; transpose_item(A.in[I_ED] + (size_t)e * 256 * 1024, 1024, 256, (bf16*)(ws + WS_WDN), 64 * kb, 32 * nb, e * 1024 + 32 * nb, nullptr, 1.0f, scr, F.lane); }
    }
}
DI void p0_prologue(Frame& F, const Args& A) {
    LAS float* scr = (LAS float*)(F.lds + F.wave * 16384);
    const int gw = blockIdx.x * NWAVES + F.wave, NGW = F.G * NWAVES;
    unsigned char* ws = F.ws;
    constexpr int I_IN = 16 * 144, I_OA = 8 * 32, I_OR = 8 * 32, I_OUT = 16 * 32, I_LD = 16, I_LA = 16, I_LG = 32;
    constexpr int NITEMS = I_IN + I_OA + I_OR + I_OUT + I_LD + I_LA + I_LG;
    for (int it = gw; it < NITEMS; it += NGW) {
        int r = it;
        if (r < I_IN) { const int kb = r / 144, nb = r % 144, n0 = 32 * nb; int dr = n0;
            if (n0 >= 2560) { const int ng = n0 - 2560, which = ng >> 10, c = ng & 1023; dr = 2560 + (c >> 7) * 256 + which * 128 + (c & 127); }
            transpose_item(A.in[I_WIN], IN_COLS, 1024, (bf16*)(ws + WS_WIN), 64 * kb, n0, dr, A.in[I_NMG], nb < 16 ? 0.125f : 1.0f, scr, F.lane); continue; } r -= I_IN;
        if (r < I_OA) { const int kb = r / 32, nb = r % 32; transpose_item(A.in[I_WOA], 1024, 1024, (bf16*)(ws + WS_WOA), 64 * kb, 32 * nb, 32 * nb, nullptr, 1.0f, scr, F.lane); continue; } r -= I_OA;
        if (r < I_OR) { const int kb = r / 32, nb = r % 32; transpose_item(A.in[I_WOR], 1024, 1024, (bf16*)(ws + WS_WOA) + 512, 64 * kb, 32 * nb, 32 * nb, nullptr, 1.0f, scr, F.lane); continue; } r -= I_OR;
        if (r < I_OUT) { const int kb = r / 32, nb = r % 32; transpose_item(A.in[I_WOUT], 1024, 1024, (bf16*)(ws + WS_WOUT), 64 * kb, 32 * nb, 32 * nb, nullptr, 1.0f, scr, F.lane); continue; } r -= I_OUT;
        if (r < I_LD) { transpose_item(A.in[I_WD], 512, 64, (bf16*)(ws + 5 * MiB), 0, 32 * r, 32 * r, nullptr, 1.0f, scr, F.lane); continue; } r -= I_LD;
        if (r < I_LA) { transpose_item(A.in[I_WA], 512, 64, (bf16*)(ws + 5 * MiB) + 512 * 64, 0, 32 * r, 32 * r, nullptr, 1.0f, scr, F.lane); continue; } r -= I_LA;
        { const int kb = r / 16, nb = r % 16; transpose_item(A.in[I_WG], 512, 128, (bf16*)(ws + 5 * MiB) + 2 * 512 * 64, 64 * kb, 32 * nb, 32 * nb, nullptr, 1.0f, scr, F.lane); }
    }
    {
        bf16* XB = (bf16*)(ws + WS_XB);
        for (int m0 = gw; m0 < M; m0 += 4 * NGW) {
            f32x4 v[4][4];
#pragma unroll
            for (int q = 0; q < 4; ++q) { const int m = m0 + q * NGW < M ? m0 + q * NGW : m0; const f32x4* xr = (const f32x4*)(A.in[I_X] + (size_t)m * D) + F.lane;
#pragma unroll
                for (int j = 0; j < 4; ++j) v[q][j] = xr[64 * j]; }
#pragma unroll
            for (int q = 0; q < 4; ++q) { const int m = m0 + q * NGW; if (m < M) { float s = 0.f;
#pragma unroll
                for (int j = 0; j < 4; ++j) s += (v[q][j].x * v[q][j].x + v[q][j].y * v[q][j].y) + (v[q][j].z * v[q][j].z + v[q][j].w * v[q][j].w);
                const float rs = 1.0f / sqrtf(wave_sum(s) * (1.0f / D) + 1e-6f);
                v2u* o8 = (v2u*)(XB + (size_t)m * D) + F.lane;
#pragma unroll
                for (int j = 0; j < 4; ++j) { v2u o; o.x = pk2(v[q][j].x * rs, v[q][j].y * rs); o.y = pk2(v[q][j].z * rs, v[q][j].w * rs); o8[64 * j] = o; } } }
        }
    }
    __syncthreads();
    {
        LAS float* xnm = (LAS float*)F.lds;
        LAS float* red = (LAS float*)(F.lds + 65536);
        bool have = false;
        for (int it = blockIdx.x; it < 256; it += F.G) {
            if (!have) {
                for (int rr = 0; rr < 2; ++rr) { const int row = 2 * F.wave + rr; const f32x4* xr = (const f32x4*)(A.in[I_META] + row * D) + F.lane; const f32x4* gr = (const f32x4*)(A.in[I_NMG]) + F.lane;
                    f32x4 v[4]; float s = 0.f;
#pragma unroll
                    for (int j = 0; j < 4; ++j) { v[j] = xr[64 * j]; s += (v[j].x * v[j].x + v[j].y * v[j].y) + (v[j].z * v[j].z + v[j].w * v[j].w); }
                    const float rs = 1.0f / sqrtf(wave_sum(s) * (1.0f / D) + 1e-6f);
#pragma unroll
                    for (int j = 0; j < 4; ++j) { const f32x4 g = gr[64 * j]; *(LAS f32x4*)(xnm + row * D + 256 * j + 4 * F.lane) = v[j] * rs * g; } }
                __syncthreads(); have = true;
            }
            const int cg = it >> 3, ks = it & 7, col = 512 + cg * 64 + F.lane, kbase = ks * 128 + F.wave * 16;
            float acc[16];
#pragma unroll
            for (int r = 0; r < 16; ++r) acc[r] = 0.f;
#pragma unroll 4
            for (int k = 0; k < 16; ++k) { const float w = A.in[I_WIN][(size_t)(kbase + k) * IN_COLS + col];
#pragma unroll
                for (int r = 0; r < 16; ++r) acc[r] += xnm[r * D + kbase + k] * w; }
#pragma unroll
            for (int r = 0; r < 16; ++r) red[(F.wave * 16 + r) * 64 + F.lane] = acc[r];
            __syncthreads();
            float* MP = (float*)(ws + WS_METAP);
            for (int e = F.tid; e < 16 * 64; e += NWAVES * 64) { const int r = e >> 6, c = e & 63; float s = 0.f;
#pragma unroll
                for (int w = 0; w < 8; ++w) s += red[(w * 16 + r) * 64 + c];
                MP[(size_t)(ks * 16 + r) * 2048 + cg * 64 + c] = s; }
            __syncthreads();
        }
    }
}
DI void p1_meta_finish(Frame& F, const Args& A) {
    const float* MP = (const float*)(F.ws + WS_METAP);
    bf16* Kb = (bf16*)(F.ws + WS_K); bf16* Vb = (bf16*)(F.ws + WS_V); bf16* RC = (bf16*)(F.ws + WS_RC);
    for (int e = blockIdx.x * 512 + F.tid; e < 16 * 2048; e += F.G * 512) { const int r = e >> 11, c = e & 2047; float s = 0.f;
#pragma unroll
        for (int k = 0; k < 8; ++k) s += MP[(size_t)(k * 16 + r) * 2048 + c];
        const bf16 v = (bf16)f2bf(s);
        if (c < 128) Kb[(size_t)(M + r) * 128 + c] = v; else if (c < 256) Vb[(size_t)(M + r) * 128 + c - 128] = v; else RC[(size_t)(M + r) * RCW + c - 256] = v; }
}

DI void p8_router(Frame& F, const Args& A) {
    LAS float* wr = (LAS float*)F.lds;
    LAS int* lcnt = (LAS int*)(F.lds + LDS_RT); LAS int* lbase = lcnt + 32; LAS int* ent_e = lcnt + 64; LAS int* ent_p = ent_e + 512; LAS int* ent_d = ent_p + 512; LAS float* ent_w = (LAS float*)(ent_d + 512);
    const bf16* H1 = (const bf16*)(F.ws + WS_AR); bf16* XN = (bf16*)(F.ws + WS_XN2);
    int* LD = (int*)(F.ws + WS_LISTD); float* LW = (float*)(F.ws + WS_LISTW);
    const int lane = F.lane;
    for (int e = F.tid; e < 36 * 1024; e += NWAVES * 64) { const int ex = e >> 10, k = e & 1023; wr[e] = ex < 4 ? A.in[I_WGRP][k * 4 + ex] : A.in[I_WEXP][k * 32 + ex - 4]; }
    f32x4 gfr[4];
#pragma unroll
    for (int j = 0; j < 4; ++j) gfr[j] = ((const f32x4*)A.in[I_NFG])[64 * j + lane];
    const float bgv = A.in[I_BGRP][lane & 3], bev = A.in[I_BEXP][lane & 31];
    for (int ch = blockIdx.x; ch < M / 256; ch += F.G) {
        if (F.tid < 32) lcnt[F.tid] = 0;
        __syncthreads();
        v2u xnx[4];
        { const v2u* hr = (const v2u*)(H1 + (size_t)(ch * 256 + F.wave * 32) * D) + lane;
#pragma unroll
            for (int j = 0; j < 4; ++j) xnx[j] = hr[64 * j]; }
        for (int it = 0; it < 32; ++it) {
            const int tok = ch * 256 + F.wave * 32 + it;
            f32x4 xv[4];
            { float ss = 0.f;
#pragma unroll
                for (int j = 0; j < 4; ++j) xv[j] = (f32x4){__uint_as_float(xnx[j].x << 16), __uint_as_float(xnx[j].x & 0xffff0000u), __uint_as_float(xnx[j].y << 16), __uint_as_float(xnx[j].y & 0xffff0000u)};
                { const v2u* hn = (const v2u*)(H1 + (size_t)(it + 1 < 32 ? tok + 1 : tok) * D) + lane;
#pragma unroll
                    for (int j = 0; j < 4; ++j) xnx[j] = hn[64 * j]; }
#pragma unroll
                for (int j = 0; j < 4; ++j) ss += (xv[j].x * xv[j].x + xv[j].y * xv[j].y) + (xv[j].z * xv[j].z + xv[j].w * xv[j].w);
                const float ms = wave_sum(ss) * (1.0f / D) + 1e-6f, rs = 1.0f / sqrtf(ms);
                if (lane == 0) ((float*)(F.ws + WS_RSTD))[tok] = sqrtf(ms);
                v2u* o8 = (v2u*)(XN + (size_t)tok * D) + lane;
#pragma unroll
                for (int j = 0; j < 4; ++j) { xv[j] = xv[j] * rs * gfr[j]; v2u o; o.x = pk2(xv[j].x, xv[j].y); o.y = pk2(xv[j].z, xv[j].w); o8[64 * j] = o; } }
            float gl[4];
#pragma unroll
            for (int ex = 0; ex < 4; ++ex) { float p0 = 0.f;
#pragma unroll
                for (int j = 0; j < 4; ++j) { const f32x4 w4 = *(const LAS f32x4*)(wr + ex * 1024 + 256 * j + 4 * lane); p0 += (xv[j].x * w4.x + xv[j].y * w4.y) + (xv[j].z * w4.z + xv[j].w * w4.w); }
                gl[ex] = wave_sum(p0) + __shfl(bgv, ex); }
            int gs = 0; float gm = gl[0];
#pragma unroll
            for (int g = 1; g < 4; ++g) if (gl[g] > gm) { gm = gl[g]; gs = g; }
            gs = __builtin_amdgcn_readfirstlane(gs);
            float den = 0.f;
#pragma unroll
            for (int g = 0; g < 4; ++g) den += __expf(gl[g] - gm);
            const float pg = 1.0f / den;
            float v1 = -INFINITY, v2 = -INFINITY; int i1 = 0, i2 = 0;
            const LAS float* wg8 = wr + (4 + gs * 8) * 1024;
#pragma unroll
            for (int i = 0; i < 8; ++i) { float p0 = 0.f;
#pragma unroll
                for (int j = 0; j < 4; ++j) { const f32x4 w4 = *(const LAS f32x4*)(wg8 + i * 1024 + 256 * j + 4 * lane); p0 += (xv[j].x * w4.x + xv[j].y * w4.y) + (xv[j].z * w4.z + xv[j].w * w4.w); }
                const float l = wave_sum(p0) + __shfl(bev, gs * 8 + i);
                if (l > v1) { v2 = v1; i2 = i1; v1 = l; i1 = i; } else if (l > v2) { v2 = l; i2 = i; } }
            const float e2 = __expf(v2 - v1), w1 = pg / (1.0f + e2), w2 = pg * e2 / (1.0f + e2);
            if (lane < 2) { const int ex = gs * 8 + (lane == 0 ? i1 : i2); const int pos = atomicAdd((int*)&lcnt[ex], 1); const int slot = (F.wave * 32 + it) * 2 + lane;
                ent_e[slot] = ex; ent_p[slot] = pos; ent_d[slot] = tok * 2 + lane; ent_w[slot] = lane == 0 ? w1 : w2; }
        }
        __syncthreads();
        if (F.tid < 32) lbase[F.tid] = (int)__hip_atomic_fetch_add(F.ctl + CW_GCNT + 64 * F.tid, (unsigned)lcnt[F.tid], __ATOMIC_RELAXED, __HIP_MEMORY_SCOPE_AGENT);
        __syncthreads();
        { const int sl = F.tid; const int ex = ent_e[sl]; const size_t o = (size_t)ex * LCAP + lbase[ex] + ent_p[sl]; LD[o] = ent_d[sl]; LW[o] = ent_w[sl]; }
        __syncthreads();
    }
}
DI int moe_table(Frame& F) {
    LAS int* tile_e = (LAS int*)(F.lds + LDS_TBL); LAS int* tb = tile_e + TT_MAX;
    if (F.wave == 0) {
        const int e = F.lane & 31; const int c = (int)__hip_atomic_load(F.ctl + CW_GCNT + 64 * e, __ATOMIC_RELAXED, __HIP_MEMORY_SCOPE_AGENT); const int nt = (c + 255) >> 8;
        int incl = nt;
#pragma unroll
        for (int d = 1; d < 32; d <<= 1) { const int y = __shfl_up(incl, d); if ((F.lane & 31) >= d) incl += y; }
        const int first = incl - nt;
        if (F.lane < 32) { tb[e] = first; tb[33 + e] = c; for (int t = 0; t < nt; ++t) tile_e[first + t] = e; if (e == 31) { tb[32] = incl; tb[65] = incl; } }
    }
    __syncthreads();
    return tb[65];
}
DI void p12_final(Frame& F, const Args& A) {
    const unsigned char* Y = (const unsigned char*)(F.ws + WS_Y); const bf16* XN = (const bf16*)(F.ws + WS_XN2); const float* IR = (const float*)(F.ws + WS_RSTD);
    const int gw = blockIdx.x * NWAVES + F.wave, NGW = F.G * NWAVES, lane = F.lane;
    f32x4 gf[4], ig[4];
#pragma unroll
    for (int j = 0; j < 4; ++j) { gf[j] = ((const f32x4*)A.in[I_NFIN])[64 * j + lane]; const f32x4 g = ((const f32x4*)A.in[I_NFG])[64 * j + lane]; ig[j] = (f32x4){1.0f / g.x, 1.0f / g.y, 1.0f / g.z, 1.0f / g.w}; }
    for (int m0 = gw; m0 < M; m0 += 2 * NGW) {
        v2u xh[2][4]; unsigned ya[2][4], yb[2][4]; float ir[2];
#pragma unroll
        for (int q = 0; q < 2; ++q) { const int m = m0 + q * NGW < M ? m0 + q * NGW : m0; const v2u* hr = (const v2u*)(XN + (size_t)m * D) + lane; const unsigned* y0 = (const unsigned*)(Y + (size_t)(2 * m) * D) + lane; const unsigned* y1 = (const unsigned*)(Y + (size_t)(2 * m + 1) * D) + lane;
            ir[q] = IR[m];
#pragma unroll
            for (int j = 0; j < 4; ++j) { xh[q][j] = hr[64 * j]; ya[q][j] = y0[64 * j]; yb[q][j] = y1[64 * j]; } }
#pragma unroll
        for (int q = 0; q < 2; ++q) { const int m = m0 + q * NGW; if (m < M) { float s = 0.f; f32x4 v[4];
#pragma unroll
            for (int j = 0; j < 4; ++j) { const v2u h = xh[q][j]; const int a = (int)ya[q][j], c = (int)yb[q][j];
                v[j].x = __uint_as_float(h.x << 16) * ir[q] * ig[j].x + 0.0625f * (__builtin_amdgcn_cvt_f32_fp8(a, 0) + __builtin_amdgcn_cvt_f32_fp8(c, 0)); v[j].y = __uint_as_float(h.x & 0xffff0000u) * ir[q] * ig[j].y + 0.0625f * (__builtin_amdgcn_cvt_f32_fp8(a, 1) + __builtin_amdgcn_cvt_f32_fp8(c, 1));
                v[j].z = __uint_as_float(h.y << 16) * ir[q] * ig[j].z + 0.0625f * (__builtin_amdgcn_cvt_f32_fp8(a, 2) + __builtin_amdgcn_cvt_f32_fp8(c, 2)); v[j].w = __uint_as_float(h.y & 0xffff0000u) * ir[q] * ig[j].w + 0.0625f * (__builtin_amdgcn_cvt_f32_fp8(a, 3) + __builtin_amdgcn_cvt_f32_fp8(c, 3));
                s += (v[j].x * v[j].x + v[j].y * v[j].y) + (v[j].z * v[j].z + v[j].w * v[j].w); }
            const float rs = 1.0f / sqrtf(wave_sum(s) * (1.0f / D) + 1e-6f);
            f32x4* ho = (f32x4*)(F.out + (size_t)m * D) + lane;
#pragma unroll
            for (int j = 0; j < 4; ++j) ho[64 * j] = v[j] * rs * gf[j]; } }
    }
}

typedef short bf16x8 __attribute__((ext_vector_type(8)));
typedef float f32x16 __attribute__((ext_vector_type(16)));
#define MFMA32(a, b, c) __builtin_amdgcn_mfma_f32_32x32x16_bf16((a), (b), (c), 0, 0, 0)
constexpr int LDB = 72;
constexpr int LDF = 68;
constexpr int NCH = SEQ / 64, NITEM = NB * 8 * NCH, NITEM_ALL = NITEM + 8;
constexpr size_t CH_STRIDE = 65 * MiB;
constexpr size_t WS_CH = 611 * MiB;
constexpr size_t WS_LORA = 5 * MiB;
static_assert(WS_CH + 5 * CH_STRIDE <= WS_END && (size_t)NITEM_ALL * 8192 <= CH_STRIDE, "chunk map");

template <int KK> DI void mma_lds(f32x16& acc, const LAS bf16* Y, int ldy, int n0, const LAS bf16* X, int ldx, int m0, int lane) {
    const int r = lane & 31, hh = lane >> 5;
    const LAS bf16* yp = Y + (n0 + r) * ldy + 8 * hh; const LAS bf16* xp = X + (m0 + r) * ldx + 8 * hh;
#pragma unroll
    for (int k0 = 0; k0 < KK; k0 += 16) { const bf16x8 a = *(const LAS bf16x8*)(xp + k0), b = *(const LAS bf16x8*)(yp + k0); acc = MFMA32(a, b, acc); }
}
DI bf16x8 col_frag(const LAS bf16* Mx, int ld, int row0, int col) {
    const LAS bf16* p = Mx + row0 * ld + col; v4u t4;
#pragma unroll
    for (int i = 0; i < 4; ++i) t4[i] = (unsigned)p[(2 * i) * ld] | ((unsigned)p[(2 * i + 1) * ld] << 16);
    return __builtin_bit_cast(bf16x8, t4);
}
template <int KK, bool YT, bool XT> DI void mma_lds_t(f32x16& acc, const LAS bf16* Y, int ldy, int n0, const LAS bf16* X, int ldx, int m0, int lane) {
    const int r = lane & 31, hh = lane >> 5;
#pragma unroll
    for (int k0 = 0; k0 < KK; k0 += 16) {
        const bf16x8 a = XT ? col_frag(X, ldx, k0 + 8 * hh, m0 + r) : *(const LAS bf16x8*)(X + (m0 + r) * ldx + 8 * hh + k0);
        const bf16x8 b = YT ? col_frag(Y, ldy, k0 + 8 * hh, n0 + r) : *(const LAS bf16x8*)(Y + (n0 + r) * ldy + 8 * hh + k0);
        acc = MFMA32(a, b, acc); }
}
DI void add_tile_lds_t(f32x16& acc, const LAS bf16* Rm, int ld, int n0, int m0, int lane) {
    const int r = lane & 31, hh = lane >> 5;
#pragma unroll
    for (int i = 0; i < 16; ++i) acc[i] += __uint_as_float((unsigned)Rm[(m0 + 8 * (i >> 2) + 4 * hh + (i & 3)) * ld + n0 + r] << 16);
}
DI f32x16 zero16() { f32x16 z;
#pragma unroll
    for (int i = 0; i < 16; ++i) z[i] = 0.f; return z; }
DI void st_tile_lds(LAS bf16* Dm, int ld, int n0, int m0, const f32x16& acc, int lane) {
    const int r = lane & 31, hh = lane >> 5;
#pragma unroll
    for (int g = 0; g < 4; ++g) { v2u o; o.x = pk2(acc[4 * g], acc[4 * g + 1]); o.y = pk2(acc[4 * g + 2], acc[4 * g + 3]); *(LAS v2u*)(Dm + (n0 + r) * ld + m0 + 8 * g + 4 * hh) = o; }
}
DI void st_tile_glb(bf16* Dm, int ld, int n0, int m0, const f32x16& acc, int lane) {
    const int r = lane & 31, hh = lane >> 5;
#pragma unroll
    for (int g = 0; g < 4; ++g) { v2u o; o.x = pk2(acc[4 * g], acc[4 * g + 1]); o.y = pk2(acc[4 * g + 2], acc[4 * g + 3]); *(v2u*)(Dm + (size_t)(n0 + r) * ld + m0 + 8 * g + 4 * hh) = o; }
}
DI void st_tile_glb_frag(bf16* Dm, int n0, int m0, const f32x16& acc, int lane) {
    const int r = lane & 31, hh = lane >> 5;
#pragma unroll
    for (int g = 0; g < 4; ++g) { v2u o; o.x = pk2(acc[4 * g], acc[4 * g + 1]); o.y = pk2(acc[4 * g + 2], acc[4 * g + 3]);
        *(v2u*)(Dm + ((n0 >> 5) * 4 + (m0 >> 4) + (g >> 1)) * 512 + ((g & 1) * 32 + r) * 8 + 4 * hh) = o; }
}
DI void st_tile_glb_cl(bf16* Dm, int n0, int m0, const f32x16& acc, int lane) {
#pragma unroll
    for (int g = 0; g < 4; ++g) { v2u o; o.x = pk2(acc[4 * g], acc[4 * g + 1]); o.y = pk2(acc[4 * g + 2], acc[4 * g + 3]); *(v2u*)(Dm + ((n0 >> 5) * 2 + (m0 >> 5)) * 1024 + g * 256 + lane * 4) = o; }
}
DI void add_tile_lds(f32x16& acc, const LAS bf16* R, int ld, int n0, int m0, int lane) {
    const int r = lane & 31, hh = lane >> 5;
#pragma unroll
    for (int g = 0; g < 4; ++g) { const v2u w = *(const LAS v2u*)(R + (n0 + r) * ld + m0 + 8 * g + 4 * hh);
        acc[4 * g] += __uint_as_float(w.x << 16); acc[4 * g + 1] += __uint_as_float(w.x & 0xffff0000u); acc[4 * g + 2] += __uint_as_float(w.y << 16); acc[4 * g + 3] += __uint_as_float(w.y & 0xffff0000u); }
}
DI void up8(const v4u w, float* f) {
#pragma unroll
    for (int i = 0; i < 4; ++i) { f[2 * i] = __uint_as_float(w[i] << 16); f[2 * i + 1] = __uint_as_float(w[i] & 0xffff0000u); }
}
DI v4u pk8(const float* f) { v4u o; o.x = pk2(f[0], f[1]); o.y = pk2(f[2], f[3]); o.z = pk2(f[4], f[5]); o.w = pk2(f[6], f[7]); return o; }


constexpr size_t WS_XA = 936 * MiB;
DI int prev_row_of(int vt) { if (vt < M) return (vt % SEQ) > 0 ? vt - 1 : M + 15; return vt > M ? vt - 1 : -1; }
DI void p2a_lora_inputs(Frame& F, const Args& A) {
    const bf16* RC = (const bf16*)(F.ws + WS_RC); const float* mu = A.in[I_MU]; bf16* XA = (bf16*)(F.ws + WS_XA);
    const int stride = F.G * NWAVES * 64;
    for (int e0 = blockIdx.x * (NWAVES * 64) + F.tid; e0 < MV * 32; e0 += 4 * stride) {
        v4u cur[4], prv[4]; bool hp[4];
#pragma unroll
        for (int u = 0; u < 4; ++u) { const int e = e0 + u * stride < MV * 32 ? e0 + u * stride : e0; const int vt = e >> 5, col = 1536 + (e & 31) * 8, prow = prev_row_of(vt);
            hp[u] = prow >= 0; cur[u] = *(const v4u*)(RC + (size_t)vt * RCW + col); prv[u] = *(const v4u*)(RC + (size_t)(prow >= 0 ? prow : vt) * RCW + col); }
#pragma unroll
        for (int u = 0; u < 4; ++u) { const int e = e0 + u * stride; if (e < MV * 32) { const int vt = e >> 5, cg = e & 31, cl = cg * 8, col = 1536 + cl;
            float cu[8], pv[8], o[8]; up8(cur[u], cu); up8(prv[u], pv);
            if (!hp[u]) {
#pragma unroll
                for (int i = 0; i < 8; ++i) pv[i] = 0.f; }
            const f32x4 m0 = *(const f32x4*)(mu + col), m1 = *(const f32x4*)(mu + col + 4);
#pragma unroll
            for (int i = 0; i < 8; ++i) { const float mm = i < 4 ? m0[i] : m1[i - 4]; const float v = cu[i] + mm * (pv[i] - cu[i]);
                const float ex = __expf(-2.0f * fabsf(v)), th = copysignf((1.0f - ex) * __builtin_amdgcn_rcpf(1.0f + ex), v);
                o[i] = cg < 8 ? th : (cg < 16 ? v : sigmoid_f(v)); }
            *(v4u*)(XA + (size_t)vt * 256 + cl) = pk8(o); } }
    }
}

constexpr int L_AT = 0, L_ATT = 9216, L_RT = 18432, L_BT = 27648, L_BTT = 36864, L_KT = 46080, L_KTT = 55296, L_VT = 64512;
constexpr int L_AF = 73728, L_AP = 91136, L_AAK = 100352, L_ABR = 109568, L_AKR = 118784, L_TP = 128000, L_D1T = 137216, L_XT = 142336, L_PC = 146432;
constexpr int L_W1 = L_AF, L_AKT = L_AF + 9216, L_GT = L_AT, L_NKT = L_ATT;
constexpr int L_XL = 73728, L_LW = 73728, L_SEG = 91136, L_WL = 107520, L_AL = 124928;
constexpr int LDX = 264;

constexpr int L_WLN = 146688, L_ALN = L_WLN + 8192, L_TOT = L_LW;
struct ChunkItem { int h, row0, nvalid, prow0; bool meta; size_t oidx; };
DI ChunkItem chunk_item(int it, int npairs, int G) {
    ChunkItem I; I.meta = it >= npairs * 8;
    const int pair = I.meta ? 0 : (int)blockIdx.x + (it >> 3) * G; I.h = I.meta ? (int)blockIdx.x : (it & 7);
    const int b = I.meta ? 0 : pair / NCH, c = I.meta ? 0 : pair % NCH;
    I.row0 = I.meta ? M : b * SEQ + 64 * c; I.nvalid = I.meta ? 16 : 64; I.prow0 = I.meta ? -1 : (c > 0 ? I.row0 - 1 : M + 15);
    I.oidx = I.meta ? (size_t)(NITEM + I.h) : (size_t)((b * 8 + I.h) * NCH + c);
    return I;
}
DI void lora_tile(LAS unsigned char* L, const ChunkItem& I, int kind, int tq, const bf16* XA, const bf16* WdT, const bf16* WaT, const bf16* WgT, bf16* GB, int lane) {
    const int r32 = lane & 31, hh = lane >> 5, n0 = 32 * (tq >> 1), m0 = 32 * (tq & 1);
    const int tvx = (n0 + r32) < I.nvalid ? (n0 + r32) : I.nvalid - 1; const bf16* XLr = XA + (size_t)(I.row0 + tvx) * 256 + 8 * hh;
    f32x16 acc = zero16();
    if (kind < 2) { const bf16* Wt = (kind ? WaT : WdT) + (size_t)(I.h * 64 + m0 + r32) * 64 + 8 * hh;
#pragma unroll
        for (int k0 = 0; k0 < 64; k0 += 16) { const bf16x8 a = *(const bf16x8*)(Wt + k0), bb = *(const bf16x8*)(XLr + kind * 64 + k0); acc = MFMA32(a, bb, acc); }
        st_tile_lds((LAS bf16*)(L + (kind ? L_ALN : L_WLN)), 64, n0, m0, acc, lane);
    } else { const bf16* Wt = WgT + (size_t)(I.h * 64 + m0 + r32) * 128 + 8 * hh;
#pragma unroll
        for (int k0 = 0; k0 < 128; k0 += 16) { const bf16x8 a = *(const bf16x8*)(Wt + k0), bb = *(const bf16x8*)(XLr + 128 + k0); acc = MFMA32(a, bb, acc); }
        if (!I.meta) st_tile_glb_cl(GB + I.oidx * 4096, n0, m0, acc, lane); }
}
DI void stage1_tile(LAS unsigned char* L, int p, int n0, int m0, int lane) {
    const int r32 = lane & 31, hh = lane >> 5, n = n0 + r32;
    const LAS bf16* Y = (const LAS bf16*)(L + (p == 0 ? L_AT : p == 1 ? L_KT : L_RT));
    const LAS bf16* X = (const LAS bf16*)(L + (p == 0 ? L_BT : p == 1 ? L_AT : p == 2 ? L_BT : L_KT));
    f32x16 acc = zero16(); mma_lds<64>(acc, Y, LDB, n0, X, LDB, m0, lane);
#pragma unroll
    for (int i = 0; i < 16; ++i) { const int m = m0 + 8 * (i >> 2) + 4 * hh + (i & 3); const bool keep = p == 0 ? (m < n) : p == 1 ? (n < m) : (m <= n); if (!keep) acc[i] = 0.f; }
    if (p == 0) { LAS float* AFm = (LAS float*)(L + L_AF);
#pragma unroll
        for (int g = 0; g < 4; ++g) *(LAS f32x4*)(AFm + n * LDF + m0 + 8 * g + 4 * hh) = (f32x4){acc[4 * g], acc[4 * g + 1], acc[4 * g + 2], acc[4 * g + 3]};
        st_tile_lds((LAS bf16*)(L + L_AP), LDB, n0, m0, acc, lane); }
    else st_tile_lds((LAS bf16*)(L + (p == 1 ? L_AAK : p == 2 ? L_ABR : L_AKR)), LDB, n0, m0, acc, lane);
}
#ifndef P3I_REPS
#define P3I_REPS 1
#endif
DI void p3_rwkv_chunk(Frame& F, const Args& A) {
    LAS unsigned char* L = F.lds;
    const bf16* RC = (const bf16*)(F.ws + WS_RC); const float* mu = A.in[I_MU];
    bf16* GB = (bf16*)(F.ws + WS_GB); bf16* PO = (bf16*)(F.ws + WS_POST);
    const bf16* WdT = (const bf16*)(F.ws + WS_LORA); const bf16* WaT = WdT + 512 * 64; const bf16* WgT = WaT + 512 * 64;
    bf16* W2T = (bf16*)(F.ws + WS_CH); bf16* MTg = (bf16*)(F.ws + WS_CH + CH_STRIDE); bf16* YLT = (bf16*)(F.ws + WS_CH + 2 * CH_STRIDE); bf16* NBg = (bf16*)(F.ws + WS_CH + 3 * CH_STRIDE);
    const int tid = F.tid, lane = F.lane, w = F.wave, r32 = lane & 31, hh = lane >> 5;
    const bf16* XA = (const bf16*)(F.ws + WS_XA);
    const int npairs = (NB * NCH - (int)blockIdx.x + F.G - 1) / F.G, nmine = npairs * 8 + (blockIdx.x < 8 ? 1 : 0);
    if (nmine == 0) return;
    { LAS float* P1 = (LAS float*)(L + L_BTT); LAS float* P2 = (LAS float*)(L + L_KTT); const int i = tid;
        P1[i] = A.in[I_W0][i]; P1[512 + i] = A.in[I_A0][i]; P1[1024 + i] = A.in[I_KK][i]; P1[1536 + i] = A.in[I_KA][i]; ((LAS bf16*)(P1 + 2048))[i] = (bf16)f2bf(A.in[I_RK][i]);
        P2[i] = mu[i]; P2[512 + i] = mu[512 + i]; P2[1024 + i] = mu[1024 + i]; ((LAS bf16*)(P2 + 1536))[i] = (bf16)f2bf(A.in[I_LNB][i]); }
    const int t = tid >> 3, jg = tid & 7, j0 = 8 * jg;
    v4u rcu[3], rpv[3];
#define P3_REQ_ROWS(I_) do { const int tv_ = t < (I_).nvalid ? t : (I_).nvalid - 1, row_ = (I_).row0 + tv_, prow_ = tv_ > 0 ? row_ - 1 : (I_).prow0, ch_ = (I_).h * 64 + j0; \
        _Pragma("unroll") for (int which = 0; which < 3; ++which) { rcu[which] = *(const v4u*)(RC + (size_t)row_ * RCW + which * 512 + ch_); rpv[which] = *(const v4u*)(RC + (size_t)(prow_ >= 0 ? prow_ : row_) * RCW + which * 512 + ch_); } } while (0)
    {
        const ChunkItem I0 = chunk_item(0, npairs, F.G);
        P3_REQ_ROWS(I0);
        if (w < 4) { lora_tile(L, I0, 0, w, XA, WdT, WaT, WgT, GB, lane); lora_tile(L, I0, 1, w, XA, WdT, WaT, WgT, GB, lane); } else lora_tile(L, I0, 2, w - 4, XA, WdT, WaT, WgT, GB, lane);
    }
    LDS_BARRIER();
    for (int it = 0; it < nmine; ++it) {
        const ChunkItem I = chunk_item(it, npairs, F.G);
        const bool has_next = it + 1 < nmine; const ChunkItem IN = chunk_item(has_next ? it + 1 : it, npairs, F.G);
        const int h = I.h, row0 = I.row0, nvalid = I.nvalid, prow0 = I.prow0; const bool meta = I.meta; const size_t oidx = I.oidx;
        const int ch = h * 64 + j0;
        float rr[8], kp[8], vv[8], lw[8], aa[8], bb8[8], cum[8];
        {
            const bool valid = t < nvalid; const int tv = valid ? t : nvalid - 1;
            const int row = row0 + tv, prow = tv > 0 ? row - 1 : prow0;
            float cu[8], pv[8], kr[8];
#pragma unroll
            for (int which = 0; which < 3; ++which) { const int col = which * 512 + ch;
                up8(rcu[which], cu); up8(rpv[which], pv);
                if (prow < 0) {
#pragma unroll
                    for (int e = 0; e < 8; ++e) pv[e] = 0.f; }
                const f32x4 m0 = *(const LAS f32x4*)(L + L_KTT + (which * 512 + ch) * 4), m1 = *(const LAS f32x4*)(L + L_KTT + (which * 512 + ch + 4) * 4);
#pragma unroll
                for (int e = 0; e < 8; ++e) { const float mm = e < 4 ? m0[e] : m1[e - 4]; const float v = cu[e] + mm * (pv[e] - cu[e]); if (which == 0) rr[e] = v; else if (which == 1) kr[e] = v; else vv[e] = v; } }
            float wl8[8], al8[8]; up8(*(const LAS v4u*)(L + L_WLN + (t * 64 + j0) * 2), wl8); up8(*(const LAS v4u*)(L + L_ALN + (t * 64 + j0) * 2), al8);
            float s1 = 0.f, asg[8], pw0[8], pa0[8], pkk[8], pka[8], prk[8], plb[8];
#pragma unroll
            for (int q = 0; q < 2; ++q) { const LAS float* P1 = (const LAS float*)(L + L_BTT) + ch + 4 * q; const f32x4 v0 = *(const LAS f32x4*)P1, v1 = *(const LAS f32x4*)(P1 + 512), v2 = *(const LAS f32x4*)(P1 + 1024), v3 = *(const LAS f32x4*)(P1 + 1536);
#pragma unroll
                for (int i = 0; i < 4; ++i) { pw0[4 * q + i] = v0[i]; pa0[4 * q + i] = v1[i]; pkk[4 * q + i] = v2[i]; pka[4 * q + i] = v3[i]; } }
            up8(*(const LAS v4u*)(L + L_BTT + 8192 + ch * 2), prk); up8(*(const LAS v4u*)(L + L_KTT + 6144 + ch * 2), plb);
#pragma unroll
            for (int e = 0; e < 8; ++e) { lw[e] = -0.60653065971f * sigmoid_f(pw0[e] + wl8[e]);
                asg[e] = sigmoid_f(pa0[e] + al8[e]); aa[e] = kr[e] * pkk[e]; s1 += aa[e] * aa[e];
                kp[e] = kr[e] * (1.0f + (asg[e] - 1.0f) * pka[e]); }
            s1 += __shfl_xor(s1, 1); s1 += __shfl_xor(s1, 2); s1 += __shfl_xor(s1, 4);
            const float inv = __builtin_amdgcn_rcpf(fmaxf(__builtin_amdgcn_sqrtf(s1), 1e-12f));
            float s2 = 0.f;
#pragma unroll
            for (int e = 0; e < 8; ++e) { const float kkv = aa[e] * inv; aa[e] = -kkv; bb8[e] = kkv * asg[e]; s2 += rr[e] * kp[e] * prk[e]; }
            s2 += __shfl_xor(s2, 1); s2 += __shfl_xor(s2, 2); s2 += __shfl_xor(s2, 4);
            if (!meta) { float po[8];
#pragma unroll
                for (int e = 0; e < 8; ++e) po[e] = plb[e] + s2 * vv[e];
                const v4u pp = pk8(po); bf16* pd = PO + oidx * 4096 + ((t >> 5) * 2 + (jg >> 2)) * 1024 + (jg & 3) * 256 + (t & 31) * 4;
                v2u lo; lo.x = pp.x; lo.y = pp.y; v2u hi; hi.x = pp.z; hi.y = pp.w; *(v2u*)pd = lo; *(v2u*)(pd + 128) = hi; }
            if (!valid) {
#pragma unroll
                for (int e = 0; e < 8; ++e) { rr[e] = 0.f; kp[e] = 0.f; vv[e] = 0.f; lw[e] = 0.f; aa[e] = 0.f; bb8[e] = 0.f; } }
#pragma unroll
            for (int e = 0; e < 8; ++e) { float x = lw[e];
#pragma unroll
                for (int dlt = 8; dlt < 64; dlt <<= 1) { const float y = __shfl_up(x, dlt); if (lane >= dlt) x += y; }
                cum[e] = x; }
            if ((lane >> 3) == 7) { LAS float* TOT = (LAS float*)(L + L_TOT) + w * 64 + j0; *(LAS f32x4*)TOT = (f32x4){cum[0], cum[1], cum[2], cum[3]}; *(LAS f32x4*)(TOT + 4) = (f32x4){cum[4], cum[5], cum[6], cum[7]}; }
        }
        LDS_BARRIER();
        {
            const LAS float* TOT = (const LAS float*)(L + L_TOT) + j0;
            for (int q = 0; q < w; ++q) { const f32x4 a4 = *(const LAS f32x4*)(TOT + q * 64), b4 = *(const LAS f32x4*)(TOT + q * 64 + 4);
                cum[0] += a4.x; cum[1] += a4.y; cum[2] += a4.z; cum[3] += a4.w; cum[4] += b4.x; cum[5] += b4.y; cum[6] += b4.z; cum[7] += b4.w; }
            float at[8], rt[8], bt[8], kt[8];
#pragma unroll
            for (int e = 0; e < 8; ++e) { const float p = __builtin_amdgcn_exp2f(1.44269504089f * cum[e]), pprev = __builtin_amdgcn_exp2f(1.44269504089f * (cum[e] - lw[e])), pinv = __builtin_amdgcn_rcpf(p);
                at[e] = aa[e] * pprev; rt[e] = rr[e] * p; bt[e] = bb8[e] * pinv; kt[e] = kp[e] * pinv;
                if (t == 63) ((LAS float*)(L + L_PC))[j0 + e] = p; }
            *(LAS v4u*)(L + L_RT + (t * LDB + j0) * 2) = pk8(rt);
            const v4u pat = pk8(at), pbt = pk8(bt), pkt = pk8(kt), pvt = pk8(vv);
            *(LAS v4u*)(L + L_AT + (t * LDB + j0) * 2) = pat; *(LAS v4u*)(L + L_BT + (t * LDB + j0) * 2) = pbt; *(LAS v4u*)(L + L_KT + (t * LDB + j0) * 2) = pkt;
            *(LAS v4u*)(L + L_VT + (t * LDB + j0) * 2) = pvt;
        }
        LDS_BARRIER();
        stage1_tile(L, w >> 2, 32 * ((w >> 1) & 1), 32 * (w & 1), lane);
        LDS_BARRIER();
        _Pragma("unroll 1") for (int repi_ = 0; repi_ < P3I_REPS; ++repi_)
        if (w == 0) {
            LAS bf16* TP = (LAS bf16*)(L + L_TP); const LAS bf16* AP = (const LAS bf16*)(L + L_AP); LAS bf16* XT1 = (LAS bf16*)(L + L_D1T); LAS bf16* XT2 = (LAS bf16*)(L + L_XT);
            const int d4 = lane >> 4, cc = lane & 15; const LAS float* AFm = (const LAS float*)(L + L_AF) + (16 * d4) * LDF + 16 * d4;
#pragma unroll
            for (int i = 0; i < 9; ++i) *(LAS v4u*)(L + L_TP + (lane + 64 * i) * 16) = (v4u){0u, 0u, 0u, 0u};
            float x[16];
#pragma unroll
            for (int tt = 0; tt < 16; ++tt) x[tt] = 0.f;
            x[0] = cc == 0 ? 1.f : 0.f;
            {
                f32x4 ar[7][2];
#pragma unroll
                for (int tt = 1; tt < 8; ++tt)
#pragma unroll
                    for (int q = 0; q < 2; ++q) if (4 * q < tt) ar[tt - 1][q] = *(const LAS f32x4*)(AFm + tt * LDF + 4 * q);
#pragma unroll
                for (int tt = 1; tt < 8; ++tt) { float acc = (tt == cc) ? 1.f : 0.f;
#pragma unroll
                    for (int q = 0; q < 2; ++q) if (4 * q < tt) acc += (ar[tt - 1][q].x * x[4 * q] + ar[tt - 1][q].y * x[4 * q + 1]) + (ar[tt - 1][q].z * x[4 * q + 2] + ar[tt - 1][q].w * x[4 * q + 3]);
                    x[tt] = acc; }
            }
            {
                f32x4 ar[8][4];
#pragma unroll
                for (int tt = 8; tt < 16; ++tt)
#pragma unroll
                    for (int q = 0; q < 4; ++q) if (4 * q < tt) ar[tt - 8][q] = *(const LAS f32x4*)(AFm + tt * LDF + 4 * q);
#pragma unroll
                for (int tt = 8; tt < 16; ++tt) { float acc = (tt == cc) ? 1.f : 0.f;
#pragma unroll
                    for (int q = 0; q < 4; ++q) if (4 * q < tt) acc += (ar[tt - 8][q].x * x[4 * q] + ar[tt - 8][q].y * x[4 * q + 1]) + (ar[tt - 8][q].z * x[4 * q + 2] + ar[tt - 8][q].w * x[4 * q + 3]);
                    x[tt] = acc; }
            }
#pragma unroll
            for (int tt = 0; tt < 16; ++tt) TP[(16 * d4 + tt) * LDB + 16 * d4 + cc] = (bf16)f2bf(x[tt]);
            LDS_WAIT();
            f32x16 f0 = zero16(), f1 = zero16();
            mma_lds_t<32, true, false>(f0, TP, LDB, 0, AP, LDB, 0, lane); mma_lds_t<32, true, false>(f1, TP + 32 * LDB + 32, LDB, 0, AP + 32 * LDB + 32, LDB, 0, lane);
            st_tile_lds(XT1, 40, 0, 0, f0, lane); st_tile_lds(XT1 + 1280, 40, 0, 0, f1, lane);
            LDS_WAIT();
            f0 = zero16(); f1 = zero16();
            mma_lds<32>(f0, TP, LDB, 0, XT1, 40, 0, lane); mma_lds<32>(f1, TP + 32 * LDB + 32, LDB, 0, XT1 + 1280, 40, 0, lane);
            if (r32 >= 16) {
#pragma unroll
                for (int g = 0; g < 2; ++g) { v2u o0, o1; o0.x = pk2(f0[4 * g], f0[4 * g + 1]); o0.y = pk2(f0[4 * g + 2], f0[4 * g + 3]); o1.x = pk2(f1[4 * g], f1[4 * g + 1]); o1.y = pk2(f1[4 * g + 2], f1[4 * g + 3]);
                    *(LAS v2u*)(TP + r32 * LDB + 8 * g + 4 * hh) = o0; *(LAS v2u*)(TP + (32 + r32) * LDB + 32 + 8 * g + 4 * hh) = o1; } }
            LDS_WAIT();
            {
                f32x16 acc = zero16(); mma_lds_t<32, true, false>(acc, TP, LDB, 0, AP + 32 * LDB, LDB, 0, lane);
                st_tile_lds(XT2, 40, 0, 0, acc, lane);
            }
            LDS_WAIT();
            {
                f32x16 acc = zero16(); mma_lds<32>(acc, TP + 32 * LDB + 32, LDB, 0, XT2, 40, 0, lane);
                st_tile_lds(TP + 32 * LDB, LDB, 0, 0, acc, lane);
            }
        } else {
            if (w <= 4) { const int p = 2 + ((w - 1) >> 1), n0 = 32 * ((w - 1) & 1); stage1_tile(L, p, n0, 0, lane); stage1_tile(L, p, n0, 32, lane); }
            if (has_next) {
                if (w <= 4) { lora_tile(L, IN, 0, w - 1, XA, WdT, WaT, WgT, GB, lane); lora_tile(L, IN, 1, w - 1, XA, WdT, WaT, WgT, GB, lane); }
                else if (w == 5) { lora_tile(L, IN, 2, 0, XA, WdT, WaT, WgT, GB, lane); lora_tile(L, IN, 2, 1, XA, WdT, WaT, WgT, GB, lane); }
                else lora_tile(L, IN, 2, w - 4, XA, WdT, WaT, WgT, GB, lane);
            }
        }
        LDS_BARRIER();
        {
            const int p = w >> 2, n0 = 32 * ((w >> 1) & 1), m0 = 32 * (w & 1);
            f32x16 acc = zero16();
            if (p) mma_lds<64>(acc, (const LAS bf16*)(L + L_AAK), LDB, n0, (const LAS bf16*)(L + L_TP), LDB, m0, lane);
            else mma_lds_t<64, true, false>(acc, (const LAS bf16*)(L + L_AT), LDB, n0, (const LAS bf16*)(L + L_TP), LDB, m0, lane);
            st_tile_lds((LAS bf16*)(L + (p ? L_AKT : L_W1)), LDB, n0, m0, acc, lane);
        }
        LDS_BARRIER();
        {
            const int p = w >> 1, n0 = 32 * (w & 1), n = n0 + r32;
            const LAS bf16* Y = (const LAS bf16*)(L + (p < 2 ? L_ABR : L_BT)); const LAS bf16* X = (const LAS bf16*)(L + ((p & 1) ? L_AKT : L_W1));
            const float pc = ((const LAS float*)(L + L_PC))[n];
#pragma unroll 1
            for (int mt = 0; mt < 2; ++mt) { const int m0 = 32 * mt; f32x16 acc = zero16();
                if (p < 2) mma_lds<64>(acc, Y, LDB, n0, X, LDB, m0, lane); else mma_lds_t<64, true, false>(acc, Y, LDB, n0, X, LDB, m0, lane);
                if (p == 0) { add_tile_lds(acc, (const LAS bf16*)(L + L_RT), LDB, n0, m0, lane); st_tile_glb_frag(W2T + oidx * 4096, n0, m0, acc, lane); }
                else if (p == 1) { add_tile_lds(acc, (const LAS bf16*)(L + L_AKR), LDB, n0, m0, lane); st_tile_lds((LAS bf16*)(L + L_GT), LDB, n0, m0, acc, lane); }
                else if (p == 2) {
#pragma unroll
                    for (int i = 0; i < 16; ++i) { const int m = m0 + 8 * (i >> 2) + 4 * hh + (i & 3); acc[i] = (acc[i] + (m == n ? 1.f : 0.f)) * pc; }
                    st_tile_glb(MTg + oidx * 4096, 64, n0, m0, acc, lane); }
                else { add_tile_lds_t(acc, (const LAS bf16*)(L + L_KT), LDB, n0, m0, lane);
#pragma unroll
                    for (int i = 0; i < 16; ++i) acc[i] *= pc;
                    st_tile_lds((LAS bf16*)(L + L_NKT), LDB, n0, m0, acc, lane); } }
        }
        LDS_BARRIER();
        if (has_next) P3_REQ_ROWS(IN);
        {
            const int p = w >> 2, n0 = 32 * ((w >> 1) & 1), m0 = 32 * (w & 1);
            f32x16 acc = zero16();
            if (p) mma_lds_t<64, true, false>(acc, (const LAS bf16*)(L + L_VT), LDB, n0, (const LAS bf16*)(L + L_NKT), LDB, m0, lane);
            else mma_lds_t<64, false, true>(acc, (const LAS bf16*)(L + L_GT), LDB, n0, (const LAS bf16*)(L + L_VT), LDB, m0, lane);
            if (p) st_tile_glb(NBg + oidx * 4096, 64, n0, m0, acc, lane); else st_tile_glb_cl(YLT + oidx * 4096, n0, m0, acc, lane);
        }
    }
#undef P3_REQ_ROWS
}

constexpr int CH_GC = 4, CH_SLOT = (64 + 32) * LDB * 2, CH_NOFF = 64 * LDB * 2;
DI void p4_rwkv_chain(Frame& F, const Args& A) {
    const bf16* MTg = (const bf16*)(F.ws + WS_CH + CH_STRIDE); const bf16* NBg = (const bf16*)(F.ws + WS_CH + 3 * CH_STRIDE); bf16* S0g = (bf16*)(F.ws + WS_CH + 4 * CH_STRIDE);
    const int lane = F.lane, r32 = lane & 31, hh = lane >> 5, w = F.wave;
    for (int task = blockIdx.x; task < NB * 8 * 2; task += F.G) {
        const int bh = task >> 1, n0 = 32 * (task & 1), hd = bh & 7;
        f32x16 s[2];
        if (w == 0) { const bf16* Nm = NBg + (size_t)(NITEM + hd) * 4096 + (size_t)(n0 + r32) * 64 + 4 * hh;
#pragma unroll
            for (int mt = 0; mt < 2; ++mt)
#pragma unroll
                for (int g = 0; g < 4; ++g) { const v2u wv = *(const v2u*)(Nm + 32 * mt + 8 * g);
                    s[mt][4 * g] = __uint_as_float(wv.x << 16); s[mt][4 * g + 1] = __uint_as_float(wv.x & 0xffff0000u); s[mt][4 * g + 2] = __uint_as_float(wv.y << 16); s[mt][4 * g + 3] = __uint_as_float(wv.y & 0xffff0000u); } }
#define CH_STAGE(gi) do { if (w > 0) { v4u rg_[7]; \
            _Pragma("unroll") for (int u_ = 0; u_ < 7; ++u_) { const int pc_ = F.tid - 64 + u_ * 448; if (pc_ < CH_GC * 768) { const int sl_ = pc_ / 768, q_ = pc_ - sl_ * 768; const size_t o_ = (size_t)(bh * NCH + CH_GC * (gi) + sl_) * 4096; \
                rg_[u_] = q_ < 512 ? *(const v4u*)(MTg + o_ + (size_t)q_ * 8) : *(const v4u*)(NBg + o_ + (size_t)(n0 + ((q_ - 512) >> 3)) * 64 + ((q_ - 512) & 7) * 8); } } \
            _Pragma("unroll") for (int u_ = 0; u_ < 7; ++u_) { const int pc_ = F.tid - 64 + u_ * 448; if (pc_ < CH_GC * 768) { const int sl_ = pc_ / 768, q_ = pc_ - sl_ * 768; \
                LAS unsigned char* dst_ = F.lds + (((gi) & 1) * CH_GC + sl_) * CH_SLOT; \
                if (q_ < 512) *(LAS v4u*)(dst_ + (q_ >> 3) * (LDB * 2) + (q_ & 7) * 16) = rg_[u_]; \
                else { const int q2_ = q_ - 512; *(LAS v4u*)(dst_ + CH_NOFF + (q2_ >> 3) * (LDB * 2) + (q2_ & 7) * 16) = rg_[u_]; } } } } } while (0)
        CH_STAGE(0);
        LDS_BARRIER();
        for (int gi = 0; gi < NCH / CH_GC; ++gi) {
            if (gi + 1 < NCH / CH_GC) CH_STAGE(gi + 1);
            if (w == 0) {
#pragma unroll 1
                for (int sl = 0; sl < CH_GC; ++sl) { const int c = CH_GC * gi + sl;
                    const LAS bf16* Ms = (const LAS bf16*)(F.lds + ((gi & 1) * CH_GC + sl) * CH_SLOT); const LAS bf16* Ns = Ms + 64 * LDB;
                    bf16x8 am[2][4]; f32x16 acc[2];
#pragma unroll
                    for (int mt = 0; mt < 2; ++mt)
#pragma unroll
                        for (int q = 0; q < 4; ++q) { const LAS bf16* mr = Ms + (32 * mt + r32) * LDB + 16 * q + 4 * hh; const v2u lo = *(const LAS v2u*)mr, hi = *(const LAS v2u*)(mr + 8); const v2u nv = *(const LAS v2u*)(Ns + r32 * LDB + 32 * mt + 8 * q + 4 * hh);
                            v4u t4; t4.x = lo.x; t4.y = lo.y; t4.z = hi.x; t4.w = hi.y; am[mt][q] = __builtin_bit_cast(bf16x8, t4);
                            acc[mt][4 * q] = __uint_as_float(nv.x << 16); acc[mt][4 * q + 1] = __uint_as_float(nv.x & 0xffff0000u); acc[mt][4 * q + 2] = __uint_as_float(nv.y << 16); acc[mt][4 * q + 3] = __uint_as_float(nv.y & 0xffff0000u); }
                    bf16x8 sb[4];
                    { bf16* So = S0g + (size_t)(bh * NCH + c) * 4096 + (n0 >> 5) * 2048 + r32 * 8 + 4 * hh;
#pragma unroll
                        for (int q = 0; q < 4; ++q) { const int mt = q >> 1, i0 = 8 * (q & 1); v4u t4; t4.x = pk2(s[mt][i0], s[mt][i0 + 1]); t4.y = pk2(s[mt][i0 + 2], s[mt][i0 + 3]); t4.z = pk2(s[mt][i0 + 4], s[mt][i0 + 5]); t4.w = pk2(s[mt][i0 + 6], s[mt][i0 + 7]);
                            sb[q] = __builtin_bit_cast(bf16x8, t4);
                            v2u lo; lo.x = t4.x; lo.y = t4.y; v2u hi; hi.x = t4.z; hi.y = t4.w; *(v2u*)(So + 512 * q) = lo; *(v2u*)(So + 512 * q + 256) = hi; } }
#pragma unroll
                    for (int mt = 0; mt < 2; ++mt)
#pragma unroll
                        for (int q = 0; q < 4; ++q) acc[mt] = MFMA32(am[mt][q], sb[q], acc[mt]);
                    s[0] = acc[0]; s[1] = acc[1];
                }
            }
            LDS_BARRIER();
        }
#undef CH_STAGE
    }
}

DI void p5_rwkv_out(Frame& F, const Args& A) {
    const bf16* W2T = (const bf16*)(F.ws + WS_CH); const bf16* YLT = (const bf16*)(F.ws + WS_CH + 2 * CH_STRIDE); const bf16* S0g = (const bf16*)(F.ws + WS_CH + 4 * CH_STRIDE);
    const bf16* GB = (const bf16*)(F.ws + WS_GB); const bf16* PO = (const bf16*)(F.ws + WS_POST); bf16* RY = (bf16*)(F.ws + WS_AR) + 512;
    const int lane = F.lane, r32 = lane & 31, hh = lane >> 5;
    LAS bf16* stg = (LAS bf16*)(F.lds + F.wave * 8192);
    for (int pm = blockIdx.x; pm < M / 256; pm += F.G)
    for (int q = F.wave; q < 64; q += NWAVES) {
        const int b = pm >> 5, c = 4 * (pm & 31) + (q >> 4), h = (q >> 1) & 7, n0 = 32 * (q & 1), idx = (b * 8 + h) * NCH + c;
        const size_t o = (size_t)idx * 4096; const int row = b * SEQ + 64 * c + n0 + r32;
        const bf16* Yr = W2T + o + (n0 >> 5) * 2048 + lane * 8;
        v2u pwr[2][4], gvr[2][4]; f32x4 lgr[2][4];
#pragma unroll
        for (int mt = 0; mt < 2; ++mt)
#pragma unroll
            for (int g = 0; g < 4; ++g) { const int i0 = h * 64 + 32 * mt + 8 * g + 4 * hh; const size_t go = o + ((n0 >> 5) * 2 + mt) * 1024 + g * 256 + lane * 4; lgr[mt][g] = *(const f32x4*)(A.in[I_LNG] + i0); pwr[mt][g] = *(const v2u*)(PO + go); gvr[mt][g] = *(const v2u*)(GB + go); }
        f32x16 acc[2];
#pragma unroll
        for (int mt = 0; mt < 2; ++mt) { const bf16* Lr = YLT + o + ((n0 >> 5) * 2 + mt) * 1024 + lane * 4;
#pragma unroll
            for (int g = 0; g < 4; ++g) { const v2u wv = *(const v2u*)(Lr + 256 * g);
                acc[mt][4 * g] = __uint_as_float(wv.x << 16); acc[mt][4 * g + 1] = __uint_as_float(wv.x & 0xffff0000u); acc[mt][4 * g + 2] = __uint_as_float(wv.y << 16); acc[mt][4 * g + 3] = __uint_as_float(wv.y & 0xffff0000u); } }
#pragma unroll
        for (int k0 = 0; k0 < 64; k0 += 16) { const bf16x8 yb = *(const bf16x8*)(Yr + (k0 >> 4) * 512);
#pragma unroll
            for (int mt = 0; mt < 2; ++mt) { const bf16x8 xa = *(const bf16x8*)(S0g + o + (mt * 4 + (k0 >> 4)) * 512 + lane * 8); acc[mt] = MFMA32(xa, yb, acc[mt]); } }
        float sum = 0.f;
#pragma unroll
        for (int mt = 0; mt < 2; ++mt)
#pragma unroll
            for (int i = 0; i < 16; ++i) sum += acc[mt][i];
        sum += __shfl_xor(sum, 32); const float mean = sum * (1.0f / 64.0f);
        float sq = 0.f;
#pragma unroll
        for (int mt = 0; mt < 2; ++mt)
#pragma unroll
            for (int i = 0; i < 16; ++i) { acc[mt][i] -= mean; sq += acc[mt][i] * acc[mt][i]; }
        sq += __shfl_xor(sq, 32); const float rstd = 1.0f / sqrtf(sq * (1.0f / 64.0f) + 64e-5f);
#pragma unroll
        for (int mt = 0; mt < 2; ++mt)
#pragma unroll
            for (int g = 0; g < 4; ++g) { const int i0 = h * 64 + 32 * mt + 8 * g + 4 * hh; const size_t go = (size_t)row * 512 + i0;
                const f32x4 lg = lgr[mt][g]; const v2u pw = pwr[mt][g], gv = gvr[mt][g];
                const float o0 = (acc[mt][4 * g] * rstd * lg.x + __uint_as_float(pw.x << 16)) * __uint_as_float(gv.x << 16), o1 = (acc[mt][4 * g + 1] * rstd * lg.y + __uint_as_float(pw.x & 0xffff0000u)) * __uint_as_float(gv.x & 0xffff0000u);
                const float o2 = (acc[mt][4 * g + 2] * rstd * lg.z + __uint_as_float(pw.y << 16)) * __uint_as_float(gv.y << 16), o3 = (acc[mt][4 * g + 3] * rstd * lg.w + __uint_as_float(pw.y & 0xffff0000u)) * __uint_as_float(gv.y & 0xffff0000u);
                v2u ov; ov.x = pk2(o0, o1); ov.y = pk2(o2, o3); *(LAS v2u*)(stg + r32 * 72 + 32 * mt + 8 * g + 4 * hh) = ov; }
        LDS_WAIT();
        {
            const size_t rb = (size_t)(b * SEQ + 64 * c + n0) * 1024 + h * 64;
#pragma unroll
            for (int k = 0; k < 4; ++k) { const int p = lane + 64 * k, tk = p >> 3, c16 = p & 7; *(v4u*)(RY + rb + (size_t)tk * 1024 + c16 * 8) = *(const LAS v4u*)(stg + tk * 72 + c16 * 8); }
        }
        LDS_WAIT();
    }
}

constexpr int AT_LDK = 72, AT_LDV = 300, AT_VT = 288 * AT_LDK * 2;
DI void p2_attention_mfma(Frame& F, const Args& A) {
    LAS bf16* ostg = (LAS bf16*)(F.lds + 81920 + F.wave * 8192);
    LAS bf16* Ks = (LAS bf16*)F.lds; LAS bf16* Vt = (LAS bf16*)(F.lds + AT_VT);
    const bf16* Q = (const bf16*)(F.ws + WS_Q); const bf16* Kb = (const bf16*)(F.ws + WS_K); const bf16* Vb = (const bf16*)(F.ws + WS_V); bf16* AO = (bf16*)(F.ws + WS_AR);
    const int tid = F.tid, lane = F.lane, w = F.wave, r32 = lane & 31, hh = lane >> 5;
    for (int item = blockIdx.x; item < NB * 2 * (SEQ / 128); item += F.G) {
        const int b = item >> 7, kvh = (item >> 6) & 1, jb = item & 63, tok0 = 128 * (jb - 1);
        {
            v4u kvr[5], vvr[5];
#pragma unroll
            for (int u = 0; u < 5; ++u) { const int ch = tid + u * (NWAVES * 64), key = ch >> 3, c = ch & 7;
                const int tk = tok0 + key; int row = key < 256 ? (tk >= 0 ? b * SEQ + tk : -1) : (key < 272 ? M + key - 256 : -1);
                const unsigned msk = (unsigned)~(row >> 31); row = row < 0 ? 0 : row;
                kvr[u] = *(const v4u*)(Kb + (size_t)row * 128 + kvh * 64 + 8 * c); vvr[u] = *(const v4u*)(Vb + (size_t)row * 128 + kvh * 64 + 8 * c);
#pragma unroll
                for (int i = 0; i < 4; ++i) { kvr[u][i] &= msk; vvr[u][i] &= msk; } }
#pragma unroll
            for (int u = 0; u < 5; ++u) { const int ch = tid + u * (NWAVES * 64), key = ch >> 3, c = ch & 7;
                if (u < 4 || ch < 288 * 8) { *(LAS v4u*)(Ks + key * AT_LDK + 8 * c) = kvr[u];
#pragma unroll
                    for (int e2 = 0; e2 < 8; ++e2) Vt[(8 * c + e2) * AT_LDV + key] = (bf16)((e2 & 1) ? (vvr[u][e2 >> 1] >> 16) : (vvr[u][e2 >> 1] & 0xffffu)); } }
        }
        LDS_BARRIER();
        const int g = w & 3, qh = w >> 2, h = kvh * 4 + g;
        const float slope = exp2f(-(float)(h + 1)), sink = A.in[I_SINK][h];
#pragma unroll 1
        for (int qq = 0; qq < 2; ++qq) {
            const int qt = 2 * qh + qq, ql = 32 * qt + r32, t = 128 * jb + ql; const size_t row = (size_t)b * SEQ + t;
            bf16x8 qf[4];
#pragma unroll
            for (int ks = 0; ks < 4; ++ks) qf[ks] = *(const bf16x8*)(Q + row * 512 + h * 64 + 16 * ks + 8 * hh);
            f32x16 sc[6]; float mx = -INFINITY;
            const LAS bf16* kbase = Ks + (32 * qt + r32) * AT_LDK + 8 * hh; const LAS bf16* kmeta = Ks + (256 + r32) * AT_LDK + 8 * hh;
            const LAS bf16* vbase = Vt + r32 * AT_LDV + 32 * qt + 4 * hh; const LAS bf16* vmeta = Vt + r32 * AT_LDV + 256 + 4 * hh;
#pragma unroll
            for (int k6 = 0; k6 < 6; ++k6) { const int kta = k6 < 5 ? qt + k6 : 8; f32x16 acc = zero16(); const LAS bf16* kp = k6 < 5 ? kbase + 32 * k6 * AT_LDK : kmeta;
#pragma unroll
                for (int ks = 0; ks < 4; ++ks) { const bf16x8 a = *(const LAS bf16x8*)(kp + 16 * ks); acc = MFMA32(a, qf[ks], acc); }
#pragma unroll
                for (int i = 0; i < 16; ++i) { const int kr = 8 * (i >> 2) + 4 * hh + (i & 3); bool ok; float dist;
                    if (k6 < 5) { const int kb = 32 * kta + kr, diff = 128 + ql - kb; dist = (float)diff;
                        if (k6 >= 1 && k6 <= 3) ok = jb > 0 || tok0 + kb >= 0;
                        else ok = diff >= 0 && diff < 128 && tok0 + kb >= 0; }
                    else { const int dm = t + 16 - kr; ok = kr < 16; dist = (float)(dm < 128 ? dm : 128); }
                    const float v = ok ? acc[i] - slope * dist : -INFINITY; sc[k6][i] = v; mx = fmaxf(mx, v); } }
            mx = fmaxf(mx, __shfl_xor(mx, 32)); mx = fmaxf(mx, sink);
            float sum = 0.f;
#pragma unroll
            for (int k6 = 0; k6 < 6; ++k6)
#pragma unroll
                for (int i = 0; i < 16; ++i) { const float p = __expf(sc[k6][i] - mx); sc[k6][i] = p; sum += p; }
            sum += __shfl_xor(sum, 32); sum += __expf(sink - mx);
            const float inv = 1.0f / sum;
            f32x16 o[2]; o[0] = zero16(); o[1] = zero16();
#pragma unroll
            for (int k6 = 0; k6 < 6; ++k6) { const int kta = k6 < 5 ? qt + k6 : 8;
#pragma unroll
                for (int s = 0; s < 2; ++s) { v4u t4; t4.x = pk2(sc[k6][8 * s], sc[k6][8 * s + 1]); t4.y = pk2(sc[k6][8 * s + 2], sc[k6][8 * s + 3]); t4.z = pk2(sc[k6][8 * s + 4], sc[k6][8 * s + 5]); t4.w = pk2(sc[k6][8 * s + 6], sc[k6][8 * s + 7]);
                    const bf16x8 pb = __builtin_bit_cast(bf16x8, t4);
#pragma unroll
                    for (int dt = 0; dt < 2; ++dt) { const LAS bf16* vp = (k6 < 5 ? vbase + 32 * k6 : vmeta) + 32 * dt * AT_LDV + 16 * s; const v2u lo = *(const LAS v2u*)vp, hi = *(const LAS v2u*)(vp + 8);
                        v4u a4; a4.x = lo.x; a4.y = lo.y; a4.z = hi.x; a4.w = hi.y; o[dt] = MFMA32(__builtin_bit_cast(bf16x8, a4), pb, o[dt]); } } }
#pragma unroll
            for (int dt = 0; dt < 2; ++dt)
#pragma unroll
                for (int g4 = 0; g4 < 4; ++g4) { v2u ov; ov.x = pk2(o[dt][4 * g4] * inv, o[dt][4 * g4 + 1] * inv); ov.y = pk2(o[dt][4 * g4 + 2] * inv, o[dt][4 * g4 + 3] * inv);
                    *(LAS v2u*)(ostg + r32 * 72 + 32 * dt + 8 * g4 + 4 * hh) = ov; }
            LDS_WAIT();
            {
                const size_t rb = ((size_t)b * SEQ + 128 * jb + 32 * qt) * 1024 + h * 64;
#pragma unroll
                for (int k = 0; k < 4; ++k) { const int p = lane + 64 * k, tk = p >> 3, c16 = p & 7; *(v4u*)(AO + rb + (size_t)tk * 1024 + c16 * 8) = *(const LAS v4u*)(ostg + tk * 72 + c16 * 8); }
            }
            LDS_WAIT();
        }
        LDS_BARRIER();
    }
}
__global__ void __launch_bounds__(NWAVES * 64, 2) mk_fwd(Args args) {
    extern __shared__ __attribute__((aligned(16))) unsigned char lds[];
    Frame F;
    F.lds = (LAS unsigned char*)lds;
    F.tid = threadIdx.x; F.lane = F.tid & 63; F.wave = __builtin_amdgcn_readfirstlane(F.tid >> 6); F.G = gridDim.x;
    F.out = args.out; F.ws = args.ws; F.ctl = (unsigned*)(args.ws + WS_CTL);
    volatile LAS unsigned* MISC = (volatile LAS unsigned*)(F.lds + LDS_MISC);
    if (F.tid < 64) MISC[F.tid] = 0u;
    __syncthreads();
    const int lo = args.ph_lo, hi = args.ph_hi;
    XcdBarrier bar; bar.bar = (unsigned*)(F.ctl + CW_BAR); bar.x = 0; bar.st = nullptr;
    if (hi - lo > 1) bar = xcd_barrier_post((unsigned*)(F.ctl + CW_BAR), MISC + 8);
#ifdef ONLY_PHASE
#define IN(k) ((k) == ONLY_PHASE && lo <= (k) && (k) < hi)
#elif defined(SKIP_PHASE)
#define IN(k) ((k) != SKIP_PHASE && lo <= (k) && (k) < hi)
#else
#define IN(k) (lo <= (k) && (k) < hi)
#endif
#ifndef PROBE_MASK
#define PROBE_MASK 0
#endif
#define REPS(k) (1 + ((PROBE_MASK >> (k)) & 1))
#define SEAM(k) do { if (IN(k) && IN((k) + 1)) xcd_barrier(bar); } while (0)
#define LOCAL_SEAM(k) do { if (IN(k) && IN((k) + 1)) { asm volatile("s_waitcnt vmcnt(0)" ::: "memory"); __syncthreads(); __builtin_amdgcn_fence(__ATOMIC_ACQUIRE, "agent"); asm volatile("s_waitcnt vmcnt(0)" ::: "memory"); __syncthreads(); } } while (0)
    unsigned char* ws = args.ws;
    if (IN(0)) { _Pragma("unroll") for (int rep = 0; rep < REPS(0); ++rep) { p0_prologue(F, args); } SEAM(0); }
    if (IN(1)) {
        p1_meta_finish(F, args);
        pg8::Gemm g{(const pg8::bf16_t*)(ws + WS_XB), (const pg8::bf16_t*)(ws + WS_WIN), M, IN_COLS, D, 0}; pg8::StaticOrder S; S.init(M, IN_COLS, F.G, (int)blockIdx.x);
        pg8::EpiIn E{(bf16*)(ws + WS_Q), (bf16*)(ws + WS_K), (bf16*)(ws + WS_V), (bf16*)(ws + WS_RC), (bf16*)F.out};
        _Pragma("unroll") for (int rep = 0; rep < REPS(1); ++rep) { pg8::gemm_phase<pg8::EpiIn, pg8::StaticOrder, true, true>(F.lds, g, S, E); }
        SEAM(1);
    }
    if (IN(2)) { _Pragma("unroll") for (int rep = 0; rep < REPS(2); ++rep) { p2a_lora_inputs(F, args); p2_attention_mfma(F, args); } SEAM(2); }
    if (IN(3)) { _Pragma("unroll") for (int rep = 0; rep < REPS(3); ++rep) { p3_rwkv_chunk(F, args); } SEAM(3); }
    if (IN(4)) { _Pragma("unroll") for (int rep = 0; rep < REPS(4); ++rep) { if (F.G >= 2 * NB * 8 * 2) expert_weights(F, args, NB * 8 * 2); else { expert_weights(F, args, 0); LDS_BARRIER(); } p4_rwkv_chain(F, args); } SEAM(4); }
    if (IN(5)) { _Pragma("unroll") for (int rep = 0; rep < REPS(5); ++rep) { p5_rwkv_out(F, args); } LOCAL_SEAM(5); }
    if (IN(6)) {
        pg8::Gemm g{(const pg8::bf16_t*)(ws + WS_AR), (const pg8::bf16_t*)(ws + WS_WOA), M, D, D, 512}; pg8::PairOrder<pg8::PanelOrder> S; S.base.init(M, D, F.G, (int)blockIdx.x); S.koff_bytes = 1024;
        pg8::EpiGate2 E{(const bf16*)F.out, (bf16*)(ws + WS_MG)};
        _Pragma("unroll") for (int rep = 0; rep < REPS(6); ++rep) { pg8::gemm_phase<pg8::EpiGate2, pg8::PairOrder<pg8::PanelOrder>, true, true>(F.lds, g, S, E); }
        LOCAL_SEAM(6);
    }
    if (IN(7)) {
        pg8::Gemm g{(const pg8::bf16_t*)(ws + WS_MG), (const pg8::bf16_t*)(ws + WS_WOUT), M, D, D, 0}; pg8::PanelOrder S; S.init(M, D, F.G, (int)blockIdx.x);
        pg8::EpiRes E{args.in[I_X], (bf16*)(ws + WS_AR)};
        _Pragma("unroll") for (int rep = 0; rep < REPS(7); ++rep) { pg8::gemm_phase<pg8::EpiRes, pg8::PanelOrder, true, true>(F.lds, g, S, E); }
        LOCAL_SEAM(7);
    }
    if (IN(8)) { _Pragma("unroll") for (int rep = 0; rep < REPS(8); ++rep) { p8_router(F, args); } SEAM(8); }
    if (IN(9)) {
        const int TT = moe_table(F);
        const LAS int* tile_e = (const LAS int*)(F.lds + LDS_TBL); const LAS int* tb = tile_e + TT_MAX;
        LAS int* ldd = (LAS int*)(F.lds + 131072); LAS float* ldw = (LAS float*)(F.lds + 131072 + 8 * 1024);
        pg8::Gemm g{(const pg8::bf16_t*)(ws + WS_XN2), (const pg8::bf16_t*)(ws + WS_WGU), CAP, NE * 512, D, 0};
        pg8::GroupedOrder<true> S{tile_e, tb, TT, 2, F.G, (int)blockIdx.x, ldd, (unsigned)(D * 2)};
        { const int* LD = (const int*)(ws + WS_LISTD); const float* LW = (const float*)(ws + WS_LISTW);
          for (int idx = F.tid; idx < 8 * 256; idx += NWAVES * 64) { pg8::Unit u; const int i = idx >> 8, r = idx & 255;
              if (S.next(i, u)) { const int li = u.r0 + r; const bool ok = li < u.cnt; const int e = u.pn >> 1; ldd[idx] = ok ? LD[e * LCAP + li] : -1; ldw[idx] = ok ? LW[e * LCAP + li] : 0.f; } }
          __syncthreads(); }
        pg8::EpiSwiglu E{(bf16*)(ws + WS_HMID), ldd, ldw, (int*)(ws + WS_SLOTD)};
        _Pragma("unroll") for (int rep = 0; rep < REPS(9); ++rep) { pg8::gemm_phase<pg8::EpiSwiglu, pg8::GroupedOrder<true>, true, true>(F.lds, g, S, E); }
        SEAM(9);
    }
    if (IN(10)) {
        const int TT = moe_table(F);
        const LAS int* tile_e = (const LAS int*)(F.lds + LDS_TBL); const LAS int* tb = tile_e + TT_MAX;
        LAS int* lsl = (LAS int*)(F.lds + 131072);
        pg8::Gemm g{(const pg8::bf16_t*)(ws + WS_HMID), (const pg8::bf16_t*)(ws + WS_WDN), CAP, NE * 1024, 256, 0};
        pg8::GroupedOrder<false> S{tile_e, tb, TT, 4, F.G, (int)blockIdx.x, nullptr, 0u};
        { const int* SD = (const int*)(ws + WS_SLOTD);
          for (int idx = F.tid; idx < 12 * 256; idx += NWAVES * 64) { pg8::Unit u; const int i = idx >> 8, r = idx & 255; if (S.next(i, u)) lsl[idx] = SD[u.pm * 256 + r]; }
          __syncthreads(); }
        pg8::EpiDown E{(unsigned char*)(ws + WS_Y), lsl};
        _Pragma("unroll") for (int rep = 0; rep < REPS(10); ++rep) { pg8::gemm_phase<pg8::EpiDown, pg8::GroupedOrder<false>, true, true>(F.lds, g, S, E); }
        SEAM(10);
    }
    if (IN(11)) { _Pragma("unroll") for (int rep = 0; rep < REPS(11); ++rep) { p12_final(F, args); } }
#undef IN
#undef SEAM
}

extern "C" void kernel_launch(void* const* d_in, const int* in_sizes, int n_in, void* d_out, int out_size, void* d_ws, size_t ws_size, hipStream_t stream) {
    static int grid = 0;
    if (grid == 0) {
        if (n_in != 28 || in_sizes[0] != M * D || out_size != M * D || ws_size < WS_END) { fprintf(stderr, "kernel_launch: unexpected shapes (n_in %d, in0 %d, out %d, ws %zu)\n", n_in, n_in > 0 ? in_sizes[0] : -1, out_size, ws_size); grid = -1; return; }
        int dev = 0, cus = 0, per_cu = 0;
        if (hipGetDevice(&dev) != hipSuccess || hipDeviceGetAttribute(&cus, hipDeviceAttributeMultiprocessorCount, dev) != hipSuccess) { grid = -1; return; }
        if (hipFuncSetAttribute((const void*)mk_fwd, hipFuncAttributeMaxDynamicSharedMemorySize, LDS_BYTES) != hipSuccess) { fprintf(stderr, "kernel_launch: hipFuncSetAttribute failed\n"); grid = -1; return; }
        if (hipOccupancyMaxActiveBlocksPerMultiprocessor(&per_cu, (const void*)mk_fwd, NWAVES * 64, LDS_BYTES) != hipSuccess || per_cu < 1) fprintf(stderr, "kernel_launch: occupancy query reports %d\n", per_cu);
        (void)hipGetLastError();
        grid = cus;
    }
    if (grid < 0) return;
    if (hipMemsetAsync((char*)d_ws + WS_CTL, 0, CTL_ZERO_BYTES, stream) != hipSuccess) return;
    Args a{};
    for (int i = 0; i < 28; ++i) a.in[i] = (const float*)d_in[i];
    a.out = (float*)d_out; a.ws = (unsigned char*)d_ws;
#if MK_ONE_LAUNCH
    a.ph_lo = 0; a.ph_hi = N_PHASES; a.li = 0;
    hipLaunchKernelGGL(mk_fwd, dim3(grid), dim3(NWAVES * 64), LDS_BYTES, stream, a);
#else
    for (int p = 0; p < N_PHASES; ++p) { a.ph_lo = p; a.ph_hi = p + 1; a.li = p; hipLaunchKernelGGL(mk_fwd, dim3(grid), dim3(NWAVES * 64), LDS_BYTES, stream, a); }
#endif
}
```

```cpp
#include <hip/hip_runtime.h>
#include <cstdio>
#include <cstdint>
#define PROBE_MASK 0
namespace pg8 {
#define PG8_LAS __attribute__((address_space(3)))
typedef unsigned short bf16_t;
typedef short bf16x8 __attribute__((ext_vector_type(8)));
typedef float f32x4 __attribute__((ext_vector_type(4)));
typedef unsigned u32x4 __attribute__((ext_vector_type(4)));
constexpr int BM = 256, BK = 64, HALF = 128, HTB = HALF * BK * 2  , STAGE_BYTES = 8 * HTB, NXCD = 8, WGM = 8;

__host__ __device__ __forceinline__ int lds_byte(int r, int c) { const int st = (r >> 4) * 2 + (c >> 5), rr = r & 15, cc = c & 31, ob = rr * 64 + cc * 2; return st * 1024 + (ob ^ (((ob >> 9) & 1) << 5)); }
__host__ __device__ __forceinline__ void stage_rc(int b, int& R, int& C) { const int st = b / 1024, sb = b % 1024, swz = sb ^ (((sb >> 9) & 1) << 5); R = (st >> 1) * 16 + swz / 64; C = (st & 1) * 32 + (swz % 64) / 2; }
__host__ __device__ __forceinline__ int perm32(int rho) { const int n = rho >> 4, i = rho & 15; return 8 * (i >> 2) + 4 * n + (i & 3); }

struct Unit { int pm, pn, r0, cnt, ord; };
struct Gemm { const bf16_t* A; const bf16_t* Bt; int M, N, K, kext; };

struct StaticOrder {
    static constexpr bool GATHER = false;
    __device__ __forceinline__ unsigned a_off(const Unit&, int) const { return 0u; }
    __device__ __forceinline__ size_t koff(const Unit&) const { return 0; }
    __device__ __forceinline__ bool is_mid(const Unit&) const { return false; }
    int nM, nN, nwg, G, c;
    __host__ __device__ void init(int M, int N, int G_, int c_) { nM = M / BM; nN = N / BM; nwg = nM * nN; G = G_; c = c_; }
    __host__ __device__ bool next(int i, Unit& u) const {
        const long L = (long)i * G + c; if (L >= nwg) return false;
        int wgid = (int)L; { const int q = nwg / NXCD, r = nwg % NXCD, xcd = wgid % NXCD, off = wgid / NXCD; wgid = (xcd < r ? xcd * (q + 1) : r * (q + 1) + (xcd - r) * q) + off; }
        const int nig = WGM * nN, gid = wgid / nig, fm = gid * WGM, gsz = (nM - fm) < WGM ? (nM - fm) : WGM;
        u.pm = fm + ((wgid % nig) % gsz); u.pn = (wgid % nig) / gsz; u.r0 = 0; u.cnt = 0; u.ord = i; return true;
    }
    __device__ __forceinline__ void a_ready(const Unit&) const {}
    __device__ __forceinline__ void done(const Unit&) const {}
};

__device__ __forceinline__ unsigned cvt_pk_bf16(float lo, float hi) { unsigned r; asm volatile("v_cvt_pk_bf16_f32 %0, %1, %2" : "=v"(r) : "v"(lo), "v"(hi)); return r; }
typedef float f32x2 __attribute__((ext_vector_type(2)));

struct PanelOrder {
    static constexpr bool GATHER = false;
    int nM, nN, G, c;
    __host__ __device__ void init(int M, int N, int G_, int c_) { nM = M / BM; nN = N / BM; G = G_; c = c_; }
    __device__ __forceinline__ bool next(int i, Unit& u) const { const int p = c + (i / nN) * G; if (p >= nM) return false; u.pm = p; u.pn = i % nN; u.r0 = 0; u.cnt = 0; u.ord = i; return true; }
    __device__ __forceinline__ unsigned a_off(const Unit&, int) const { return 0u; }
    __device__ __forceinline__ size_t koff(const Unit&) const { return 0; }
    __device__ __forceinline__ bool is_mid(const Unit&) const { return false; }
    __device__ __forceinline__ void a_ready(const Unit&) const {}
    __device__ __forceinline__ void done(const Unit&) const {}
};
template <class Base> struct PairOrder {
    static constexpr bool GATHER = false;
    Base base; size_t koff_bytes;
    __device__ __forceinline__ bool next(int i, Unit& u) const { if (!base.next(i >> 1, u)) return false; u.r0 = i & 1; u.cnt = 0; u.ord = i; return true; }
    __device__ __forceinline__ unsigned a_off(const Unit&, int) const { return 0u; }
    __device__ __forceinline__ size_t koff(const Unit& u) const { return u.r0 ? koff_bytes : (size_t)0; }
    __device__ __forceinline__ bool is_mid(const Unit& u) const { return u.r0 == 0; }
    __device__ __forceinline__ void a_ready(const Unit&) const {}
    __device__ __forceinline__ void done(const Unit&) const {}
};
template <class Epi, class Sched, bool ALIGN_EPI = false, bool SP2 = false>
__device__ __forceinline__ void gemm_phase(PG8_LAS unsigned char* lds, const Gemm g, const Sched& S, const Epi& E) {
    const int tid = threadIdx.x, wid = __builtin_amdgcn_readfirstlane(tid >> 6), lane = tid & 63, wr = wid >> 2, wc = wid & 3, fr = lane & 15, fq = lane >> 4;
    const int K = g.K, nt = (g.kext ? g.kext : K) / BK;
    unsigned voffA[2], voffB[2];
#pragma unroll
    for (int i = 0; i < 2; ++i) { int R, C; stage_rc(tid * 16 + i * 8192, R, C); const int Rb = Epi::PERM ? ((R & ~31) + perm32(R & 31)) : R;
        voffA[i] = (unsigned)(R * K + C) * 2u; voffB[i] = (unsigned)(Rb * K + C) * 2u; }
    unsigned gAc[2][2], gAn[2][2]; int gR[2], gC[2];
#pragma unroll
    for (int i = 0; i < 2; ++i) { int R, C; stage_rc(tid * 16 + i * 8192, R, C); gR[i] = R; gC[i] = C * 2; gAc[0][i] = gAc[1][i] = gAn[0][i] = gAn[1][i] = 0u; }
    const size_t kstep = (size_t)(BK * 2);
    const size_t hstep = (size_t)HALF * K * 2;
    const size_t hstepA = Sched::GATHER ? (size_t)0 : hstep;
    const size_t tstep = 2 * hstep;
    const unsigned ldsw = (unsigned)wid * 1024u;
    const int aoff = lds_byte(wr * 64 + fr, fq * 8), boff = lds_byte(wc * 32 + fr, fq * 8);
#define PG8_SA(b, h) (((b) * 2 + (h)) * HTB)
#define PG8_SB(b, h) ((4 + (b) * 2 + (h)) * HTB)
#define PG8_STAGE(bufoff, gbase, voff) do { _Pragma("unroll") for (int _i = 0; _i < 2; ++_i) \
        __builtin_amdgcn_global_load_lds((const unsigned*)((const char*)(gbase) + (voff)[_i]), (PG8_LAS unsigned*)(lds + (bufoff) + ldsw + _i * 8192), 16, 0, 0); } while (0)
#define PG8_LDA(dst, b, h) do { _Pragma("unroll") for (int m = 0; m < 4; ++m) _Pragma("unroll") for (int k = 0; k < 2; ++k) dst[m][k] = *(const PG8_LAS bf16x8*)(lds + PG8_SA(b, h) + aoff + m * 2048 + k * 1024); } while (0)
#define PG8_LDB(dst, b, h) do { _Pragma("unroll") for (int n = 0; n < 2; ++n) _Pragma("unroll") for (int k = 0; k < 2; ++k) dst[n][k] = *(const PG8_LAS bf16x8*)(lds + PG8_SB(b, h) + boff + n * 2048 + k * 1024); } while (0)
#define PG8_MMA(ai, bj, At, Bt) do { __builtin_amdgcn_s_setprio(1); _Pragma("unroll") for (int m = 0; m < 4; ++m) _Pragma("unroll") for (int n = 0; n < 2; ++n) _Pragma("unroll") for (int k = 0; k < 2; ++k) \
        acc[ai][bj][m][n] = __builtin_amdgcn_mfma_f32_16x16x32_bf16(Bt[n][k], At[m][k], acc[ai][bj][m][n], 0, 0, 0); __builtin_amdgcn_s_setprio(0); } while (0)
#define PG8_WAIT_V(n) asm volatile("s_waitcnt vmcnt(" #n ")" ::: "memory")
#define PG8_WAIT_L(n) asm volatile("s_waitcnt lgkmcnt(" #n ")" ::: "memory")
#define PG8_BAR __builtin_amdgcn_s_barrier()
#define PG8_SCHED __builtin_amdgcn_sched_barrier(0)
    Unit cur, nxt; int ui = 0;
    if (!S.next(0, cur)) return;
    f32x4 acc[2][2][4][2];
#pragma unroll
    for (int a = 0; a < 2; ++a)
#pragma unroll
        for (int b = 0; b < 2; ++b)
#pragma unroll
            for (int m = 0; m < 4; ++m)
#pragma unroll
                for (int n = 0; n < 2; ++n) acc[a][b][m][n] = (f32x4){0.f, 0.f, 0.f, 0.f};
    bf16x8 At[4][2], B0[2][2], B1[2][2];
    const char* cA = (const char*)g.A + (Sched::GATHER ? (size_t)0 : (size_t)cur.pm * tstep) + S.koff(cur); const char* cB = (const char*)g.Bt + (size_t)cur.pn * tstep + S.koff(cur);
    if constexpr (Sched::GATHER) {
#pragma unroll
        for (int h = 0; h < 2; ++h)
#pragma unroll
            for (int i = 0; i < 2; ++i) gAc[h][i] = S.a_off(cur, h * HALF + gR[i]) + (unsigned)gC[i]; }
#define PG8_VA(sel, h) (Sched::GATHER ? (sel)[h] : voffA)
    S.a_ready(cur);
    if constexpr (SP2) {
        PG8_STAGE(PG8_SB(0, 0), cB, voffB); PG8_STAGE(PG8_SB(0, 1), cB + hstep, voffB); PG8_STAGE(PG8_SA(0, 0), cA, PG8_VA(gAc, 0)); PG8_STAGE(PG8_SA(0, 1), cA + hstepA, PG8_VA(gAc, 1));
        if (wr == 1) PG8_BAR;
        PG8_WAIT_V(2); PG8_BAR;
        PG8_STAGE(PG8_SB(1, 0), cB + kstep, voffB); PG8_STAGE(PG8_SA(1, 0), cA + kstep, PG8_VA(gAc, 0)); PG8_STAGE(PG8_SB(1, 1), cB + hstep + kstep, voffB);
        PG8_WAIT_V(6); PG8_BAR;
    } else {
        PG8_STAGE(PG8_SB(0, 0), cB, voffB); PG8_STAGE(PG8_SA(0, 0), cA, voffA); PG8_STAGE(PG8_SB(0, 1), cB + hstep, voffB); PG8_STAGE(PG8_SA(0, 1), cA + hstep, voffA);
        if (wr == 1) PG8_BAR;
        PG8_WAIT_V(4); PG8_BAR;
        PG8_STAGE(PG8_SB(1, 0), cB + kstep, voffB); PG8_STAGE(PG8_SA(1, 0), cA + kstep, voffA); PG8_STAGE(PG8_SB(1, 1), cB + hstep + kstep, voffB);
        PG8_WAIT_V(6); PG8_BAR;
    }
    for (;;) {
        const bool has_next = S.next(ui + 1, nxt);
        const char* nA = (has_next && !Sched::GATHER) ? (const char*)g.A + (size_t)nxt.pm * tstep + S.koff(nxt) : cA; const char* nB = has_next ? (const char*)g.Bt + (size_t)nxt.pn * tstep + S.koff(nxt) : cB;
        if constexpr (Sched::GATHER) {
#pragma unroll
            for (int h = 0; h < 2; ++h)
#pragma unroll
                for (int i = 0; i < 2; ++i) gAn[h][i] = has_next ? S.a_off(nxt, h * HALF + gR[i]) + (unsigned)gC[i] : gAc[h][i]; }
#pragma unroll 1
        for (int t = 0; t < nt; t += 2) {
            const bool last = (t == nt - 2);
            const char* a1 = cA + (size_t)(t + 1) * kstep;
            const char* a2 = last ? nA : cA + (size_t)(t + 2) * kstep; const char* b2 = last ? nB : cB + (size_t)(t + 2) * kstep;
            const char* a3 = a2 + kstep; const char* b3 = b2 + kstep;
            if (last && has_next) S.a_ready(nxt);
            unsigned g2[2][2];
#pragma unroll
            for (int h = 0; h < 2; ++h)
#pragma unroll
                for (int i = 0; i < 2; ++i) g2[h][i] = last ? gAn[h][i] : gAc[h][i];
            if constexpr (SP2) {
            PG8_LDB(B0, 0, 0); PG8_LDB(B1, 0, 1); PG8_SCHED; PG8_LDA(At, 0, 0); PG8_STAGE(PG8_SA(1, 1), a1 + hstepA, PG8_VA(gAc, 1));
            PG8_WAIT_V(8); PG8_WAIT_L(0); PG8_BAR; PG8_MMA(0, 0, At, B0); PG8_MMA(0, 1, At, B1); PG8_BAR; PG8_SCHED;
            PG8_LDA(At, 0, 1); PG8_STAGE(PG8_SB(0, 0), b2, voffB); PG8_STAGE(PG8_SB(0, 1), b2 + hstep, voffB); PG8_STAGE(PG8_SA(0, 0), a2, PG8_VA(g2, 0));
            PG8_WAIT_V(8); PG8_WAIT_L(0); PG8_BAR; PG8_MMA(1, 0, At, B0); PG8_MMA(1, 1, At, B1); PG8_BAR; PG8_SCHED;
            PG8_LDB(B0, 1, 0); PG8_LDB(B1, 1, 1); PG8_SCHED; PG8_LDA(At, 1, 0); PG8_STAGE(PG8_SA(0, 1), a2 + hstepA, PG8_VA(g2, 1));
            PG8_WAIT_V(8); PG8_WAIT_L(0); PG8_BAR; PG8_MMA(0, 0, At, B0); PG8_MMA(0, 1, At, B1); PG8_BAR; PG8_SCHED;
            PG8_LDA(At, 1, 1); PG8_STAGE(PG8_SB(1, 0), b3, voffB); PG8_STAGE(PG8_SB(1, 1), b3 + hstep, voffB); PG8_STAGE(PG8_SA(1, 0), a3, PG8_VA(g2, 0));
            PG8_WAIT_V(8); PG8_WAIT_L(0); PG8_BAR; PG8_MMA(1, 0, At, B0); PG8_MMA(1, 1, At, B1); PG8_BAR; PG8_SCHED;
            } else {
            PG8_LDB(B0, 0, 0); PG8_SCHED; PG8_LDA(At, 0, 0); PG8_STAGE(PG8_SA(1, 1), a1 + hstep, voffA);
            PG8_WAIT_L(8); PG8_BAR; PG8_WAIT_L(0); PG8_MMA(0, 0, At, B0); PG8_BAR; PG8_SCHED;
            PG8_LDB(B1, 0, 1); PG8_STAGE(PG8_SB(0, 0), b2, voffB);
            PG8_BAR; PG8_WAIT_L(0); PG8_MMA(0, 1, At, B1); PG8_BAR;
            PG8_LDA(At, 0, 1); PG8_STAGE(PG8_SA(0, 0), a2, voffA);
            PG8_BAR; PG8_WAIT_L(0); PG8_MMA(1, 0, At, B0); PG8_BAR; PG8_SCHED;
            PG8_STAGE(PG8_SB(0, 1), b2 + hstep, voffB);
            PG8_WAIT_V(6); PG8_BAR; PG8_MMA(1, 1, At, B1); PG8_BAR;
            PG8_LDB(B0, 1, 0); PG8_SCHED; PG8_LDA(At, 1, 0); PG8_STAGE(PG8_SA(0, 1), a2 + hstep, voffA);
            PG8_WAIT_L(8); PG8_BAR; PG8_WAIT_L(0); PG8_MMA(0, 0, At, B0); PG8_BAR; PG8_SCHED;
            PG8_LDB(B1, 1, 1); PG8_STAGE(PG8_SB(1, 0), b3, voffB);
            PG8_BAR; PG8_WAIT_L(0); PG8_MMA(0, 1, At, B1); PG8_BAR;
            PG8_LDA(At, 1, 1); PG8_STAGE(PG8_SA(1, 0), a3, voffA);
            PG8_BAR; PG8_WAIT_L(0); PG8_MMA(1, 0, At, B0); PG8_BAR; PG8_SCHED;
            PG8_STAGE(PG8_SB(1, 1), b3 + hstep, voffB);
            PG8_WAIT_V(6); PG8_BAR; PG8_MMA(1, 1, At, B1); PG8_BAR;
            }
        }
        if constexpr (ALIGN_EPI) { if (wr == 0) PG8_BAR; }
        bool keep_acc = false;
        if constexpr (Epi::MIDK) { if (S.is_mid(cur)) { E.mid(acc, cur, wr, wc, fr, fq); keep_acc = true; } else E(acc, cur, wr, wc, fr, fq); }
        else if constexpr (!Epi::AFTER_DRAIN) { E(acc, cur, wr, wc, fr, fq);
#ifdef PROBE_EPI2
            if constexpr (Epi::PROBE2) { asm volatile("" ::: "memory"); E(acc, cur, wr, wc, fr, fq); }
#endif
            S.done(cur); }
        if (!has_next) break;
        if (!keep_acc)
#pragma unroll
        for (int a = 0; a < 2; ++a)
#pragma unroll
            for (int b = 0; b < 2; ++b)
#pragma unroll
                for (int m = 0; m < 4; ++m)
#pragma unroll
                    for (int n = 0; n < 2; ++n) acc[a][b][m][n] = (f32x4){0.f, 0.f, 0.f, 0.f};
        cur = nxt; cA = nA; cB = nB; ++ui;
        if constexpr (Sched::GATHER) {
#pragma unroll
            for (int h = 0; h < 2; ++h)
#pragma unroll
                for (int i = 0; i < 2; ++i) gAc[h][i] = gAn[h][i]; }
        if constexpr (ALIGN_EPI) { if (wr == 1) PG8_BAR; }
    }
    PG8_WAIT_V(0);
    if constexpr (!ALIGN_EPI) { if (wr == 0) PG8_BAR; }
    PG8_BAR;
    if constexpr (Epi::AFTER_DRAIN) { E.fused(acc, cur, wr, wc, fr, fq, lds, wid, lane); S.done(cur); }
#undef PG8_SA
#undef PG8_VA
#undef PG8_SB
#undef PG8_STAGE
#undef PG8_LDA
#undef PG8_LDB
#undef PG8_MMA
#undef PG8_WAIT_V
#undef PG8_WAIT_L
#undef PG8_BAR
#undef PG8_SCHED
}

__device__ __forceinline__ float sigm(float x) { return __builtin_amdgcn_rcpf(1.0f + __builtin_amdgcn_exp2f(-1.44269504089f * x)); }
__device__ __forceinline__ f32x4 up_lo(u32x4 w) { f32x4 r; r[0] = __uint_as_float(w[0] << 16); r[1] = __uint_as_float(w[0] & 0xffff0000u); r[2] = __uint_as_float(w[1] << 16); r[3] = __uint_as_float(w[1] & 0xffff0000u); return r; }
__device__ __forceinline__ f32x4 up_hi(u32x4 w) { f32x4 r; r[0] = __uint_as_float(w[2] << 16); r[1] = __uint_as_float(w[2] & 0xffff0000u); r[2] = __uint_as_float(w[3] << 16); r[3] = __uint_as_float(w[3] & 0xffff0000u); return r; }
__device__ __forceinline__ u32x4 pack8(f32x4 v0, f32x4 v1) { u32x4 w; w.x = cvt_pk_bf16(v0[0], v0[1]); w.y = cvt_pk_bf16(v0[2], v0[3]); w.z = cvt_pk_bf16(v1[0], v1[1]); w.w = cvt_pk_bf16(v1[2], v1[3]); return w; }

struct EpiIn {
    static constexpr bool PERM = true, AFTER_DRAIN = false, MIDK = false, PROBE2 = true;
    bf16_t *Q, *Kb, *Vb, *RC, *G;
    __device__ __forceinline__ void operator()(const f32x4 (&acc)[2][2][4][2], const Unit& u, int wr, int wc, int fr, int fq) const {
        const int row0 = u.pm * BM + wr * 64 + fr, cl = wc * 32 + 8 * fq;
        bf16_t* b0; bf16_t* b1; int ld; const int pn = u.pn;
        if (pn < 2) { ld = 512; b0 = Q + pn * 256 + cl; b1 = b0 + 128; }
        else if (pn == 2) { ld = 128; b0 = Kb + cl; b1 = Vb + cl; }
        else if (pn < 10) { ld = 1792; b0 = RC + (pn - 3) * 256 + cl; b1 = b0 + 128; }
        else { ld = 2048; b0 = G + (pn - 10) * 128 + cl; b1 = b0 + 1024; }
        const bool sg = pn >= 10;
#pragma unroll
        for (int ai = 0; ai < 2; ++ai)
#pragma unroll
            for (int m = 0; m < 4; ++m) { const int row = row0 + ai * HALF + m * 16;
                f32x4 a0 = acc[ai][0][m][0], a1 = acc[ai][0][m][1], c0 = acc[ai][1][m][0], c1 = acc[ai][1][m][1];
                if (sg) {
#pragma unroll
                    for (int j = 0; j < 4; ++j) { const float ea0 = __builtin_amdgcn_exp2f(-1.44269504089f * a0[j]), ea1 = __builtin_amdgcn_exp2f(-1.44269504089f * a1[j]), eb0 = __builtin_amdgcn_exp2f(-1.44269504089f * c0[j]), eb1 = __builtin_amdgcn_exp2f(-1.44269504089f * c1[j]);
                        a0[j] = (1.0f + eb0) * __builtin_amdgcn_rcpf(1.0f + ea0); a1[j] = (1.0f + eb1) * __builtin_amdgcn_rcpf(1.0f + ea1); c0[j] = __builtin_amdgcn_rcpf(1.0f + eb0); c1[j] = __builtin_amdgcn_rcpf(1.0f + eb1); } }
                *(u32x4*)(b0 + (size_t)row * ld) = pack8(a0, a1); *(u32x4*)(b1 + (size_t)row * ld) = pack8(c0, c1); }
    }
};
struct EpiGate2 {
    static constexpr bool PERM = true, AFTER_DRAIN = false, MIDK = true;
    const bf16_t* G; bf16_t* O;
    __device__ __forceinline__ void mid(f32x4 (&acc)[2][2][4][2], const Unit& u, int wr, int wc, int fr, int fq) const {
        const int row0 = u.pm * BM + wr * 64 + fr, col0 = u.pn * BM + wc * 32 + 8 * fq;
        u32x4 g0w[2][4][2];
#pragma unroll
        for (int ai = 0; ai < 2; ++ai)
#pragma unroll
            for (int m = 0; m < 4; ++m)
#pragma unroll
                for (int bj = 0; bj < 2; ++bj) g0w[ai][m][bj] = *(const u32x4*)(G + (size_t)(row0 + ai * HALF + m * 16) * 2048 + col0 + bj * HALF);
#pragma unroll
        for (int ai = 0; ai < 2; ++ai)
#pragma unroll
            for (int m = 0; m < 4; ++m)
#pragma unroll
                for (int bj = 0; bj < 2; ++bj)
#pragma unroll
                    for (int j = 0; j < 4; ++j) { const unsigned gn = g0w[ai][m][bj][j];
                        acc[ai][bj][m][j >> 1][2 * (j & 1)] *= __uint_as_float(gn << 16); acc[ai][bj][m][j >> 1][2 * (j & 1) + 1] *= __uint_as_float(gn & 0xffff0000u); }
    }
    __device__ __forceinline__ void operator()(const f32x4 (&acc)[2][2][4][2], const Unit& u, int wr, int wc, int fr, int fq) const {
        const int row0 = u.pm * BM + wr * 64 + fr, col0 = u.pn * BM + wc * 32 + 8 * fq;
        u32x4 gw[2][4][2];
#pragma unroll
        for (int ai = 0; ai < 2; ++ai)
#pragma unroll
            for (int m = 0; m < 4; ++m)
#pragma unroll
                for (int bj = 0; bj < 2; ++bj) gw[ai][m][bj] = *(const u32x4*)(G + (size_t)(row0 + ai * HALF + m * 16) * 2048 + 1024 + col0 + bj * HALF);
#pragma unroll
        for (int ai = 0; ai < 2; ++ai)
#pragma unroll
            for (int m = 0; m < 4; ++m)
#pragma unroll
                for (int bj = 0; bj < 2; ++bj) *(u32x4*)(O + (size_t)(row0 + ai * HALF + m * 16) * 1024 + col0 + bj * HALF) = pack8(acc[ai][bj][m][0] * up_lo(gw[ai][m][bj]), acc[ai][bj][m][1] * up_hi(gw[ai][m][bj]));
    }
};
struct EpiRes {
    static constexpr bool PERM = true, AFTER_DRAIN = false, MIDK = false, PROBE2 = false;
    const float* X; bf16_t* O;
    __device__ __forceinline__ void operator()(const f32x4 (&acc)[2][2][4][2], const Unit& u, int wr, int wc, int fr, int fq) const {
        const int row0 = u.pm * BM + wr * 64 + fr, col0 = u.pn * BM + wc * 32 + 8 * fq;
#pragma unroll
        for (int ai = 0; ai < 2; ++ai) { f32x4 xv[4][2][2];
#pragma unroll
            for (int m = 0; m < 4; ++m)
#pragma unroll
                for (int bj = 0; bj < 2; ++bj)
#pragma unroll
                    for (int n = 0; n < 2; ++n) xv[m][bj][n] = *(const f32x4*)(X + (size_t)(row0 + ai * HALF + m * 16) * 1024 + col0 + bj * HALF + 4 * n);
#pragma unroll
            for (int m = 0; m < 4; ++m)
#pragma unroll
                for (int bj = 0; bj < 2; ++bj) *(u32x4*)(O + (size_t)(row0 + ai * HALF + m * 16) * 1024 + col0 + bj * HALF) = pack8(xv[m][bj][0] + acc[ai][bj][m][0], xv[m][bj][1] + acc[ai][bj][m][1]);
            asm volatile("" ::: "memory"); }
    }
};
template <bool GATHER_> struct GroupedOrder {
    static constexpr bool GATHER = GATHER_;
    const PG8_LAS int* tile_e; const PG8_LAS int* tb; int ntiles, ntn, G, c; const PG8_LAS int* lds_d; unsigned rowbytes;
    __device__ __forceinline__ bool next(int i, Unit& u) const {
        const int L = i * G + c; if (L >= ntiles * ntn) return false;
        const int mt = L / ntn, nl = L - mt * ntn; const int e = __builtin_amdgcn_readfirstlane(tile_e[mt]);
        u.pm = mt; u.pn = e * ntn + nl; u.r0 = __builtin_amdgcn_readfirstlane((mt - tb[e]) * BM); u.cnt = __builtin_amdgcn_readfirstlane(tb[33 + e]); u.ord = i; return true;
    }
    __device__ __forceinline__ unsigned a_off(const Unit& u, int r) const {
        const int d = lds_d[u.ord * BM + r]; const int tok = d >= 0 ? (d >> 1) : 0;
        return (unsigned)tok * rowbytes;
    }
    __device__ __forceinline__ size_t koff(const Unit&) const { return 0; }
    __device__ __forceinline__ bool is_mid(const Unit&) const { return false; }
    __device__ __forceinline__ void a_ready(const Unit&) const {}
    __device__ __forceinline__ void done(const Unit&) const {}
};
struct EpiSwiglu {
    static constexpr bool PERM = true, AFTER_DRAIN = false, MIDK = false, PROBE2 = false;
    bf16_t* H; const PG8_LAS int* lds_d; const PG8_LAS float* lds_w; int* slot_dst;
    __device__ __forceinline__ void operator()(const f32x4 (&acc)[2][2][4][2], const Unit& u, int wr, int wc, int fr, int fq) const {
        const int rl0 = wr * 64 + fr, row0 = u.pm * BM + rl0, col0 = (u.pn & 1) * 128 + wc * 32 + 8 * fq;
        const bool slots = (u.pn & 1) == 0 && wc == 0 && fq == 0;
        int ld8[2][4]; float lw8[2][4];
#pragma unroll
        for (int ai = 0; ai < 2; ++ai)
#pragma unroll
            for (int m = 0; m < 4; ++m) { const int rl = u.ord * BM + rl0 + ai * HALF + m * 16; ld8[ai][m] = lds_d[rl]; lw8[ai][m] = lds_w[rl]; }
        if (slots) {
#pragma unroll
            for (int ai = 0; ai < 2; ++ai)
#pragma unroll
                for (int m = 0; m < 4; ++m) slot_dst[row0 + ai * HALF + m * 16] = ld8[ai][m]; }
#pragma unroll
        for (int ai = 0; ai < 2; ++ai)
#pragma unroll
            for (int m = 0; m < 4; ++m) { const int row = row0 + ai * HALF + m * 16;
                if (ld8[ai][m] >= 0) { f32x4 v0, v1; const float w = lw8[ai][m];
#pragma unroll
                    for (int j = 0; j < 4; ++j) { const float g0 = acc[ai][0][m][0][j], g1 = acc[ai][0][m][1][j]; v0[j] = w * g0 * sigm(g0) * acc[ai][1][m][0][j]; v1[j] = w * g1 * sigm(g1) * acc[ai][1][m][1][j]; }
                    *(u32x4*)(H + (size_t)row * 256 + col0) = pack8(v0, v1); } }
    }
};
struct EpiDown {
    static constexpr bool PERM = true, AFTER_DRAIN = false, MIDK = false, PROBE2 = false;
    unsigned char* Y; const PG8_LAS int* lds_slot;
    __device__ __forceinline__ static unsigned pk4(float a, float b, float c, float d) { int w = 0; w = __builtin_amdgcn_cvt_pk_fp8_f32(a * 16.f, b * 16.f, w, false); w = __builtin_amdgcn_cvt_pk_fp8_f32(c * 16.f, d * 16.f, w, true); return (unsigned)w; }
    __device__ __forceinline__ void operator()(const f32x4 (&acc)[2][2][4][2], const Unit& u, int wr, int wc, int fr, int fq) const {
        const int row0 = u.pm * BM + wr * 64 + fr, col0 = (u.pn & 3) * 256 + wc * 32 + 8 * fq;
        int dsts[2][4];
#pragma unroll
        for (int ai = 0; ai < 2; ++ai)
#pragma unroll
            for (int m = 0; m < 4; ++m) dsts[ai][m] = lds_slot[u.ord * BM + wr * 64 + fr + ai * HALF + m * 16];
        typedef unsigned u32x2 __attribute__((ext_vector_type(2)));
#pragma unroll
        for (int ai = 0; ai < 2; ++ai)
#pragma unroll
            for (int m = 0; m < 4; ++m) { const int dst = dsts[ai][m];
                if (dst >= 0) {
#pragma unroll
                    for (int bj = 0; bj < 2; ++bj) { const f32x4 v0 = acc[ai][bj][m][0], v1 = acc[ai][bj][m][1]; u32x2 w; w.x = pk4(v0[0], v0[1], v0[2], v0[3]); w.y = pk4(v1[0], v1[1], v1[2], v1[3]);
                        *(u32x2*)(Y + (size_t)dst * 1024 + col0 + bj * HALF) = w; } } }
    }
};
}

constexpr int NWAVES = 8;
constexpr int D = 1024, NB = 8, SEQ = 8192, M = NB * SEQ, NMETA = 16, MV = M + NMETA;
constexpr int IN_COLS = 4608, RCW = 1792;
constexpr int NE = 32, TT_MAX = 544, CAP = TT_MAX * 256, LCAP = 65536;
constexpr int N_PHASES = 12;
#ifndef MK_ONE_LAUNCH
#define MK_ONE_LAUNCH 1
#endif

constexpr size_t MiB = 1u << 20;
constexpr size_t WS_CTL = 0, CTL_ZERO_BYTES = 96 * 1024;
constexpr size_t WS_RSTD = 1 * MiB, WS_METAP = 1 * MiB + 512 * 1024, WS_SLOTD = 3 * MiB, WS_SLOTW = 4 * MiB;
constexpr size_t WS_WIN = 6 * MiB, WS_WOA = 15 * MiB, WS_WOR = 16 * MiB, WS_WOUT = 17 * MiB, WS_WGU = 19 * MiB, WS_WDN = 51 * MiB;
constexpr size_t WS_LISTD = 68 * MiB, WS_LISTW = 76 * MiB;
constexpr size_t WS_XB = 96 * MiB, WS_Q = 224 * MiB, WS_K = 288 * MiB, WS_V = 305 * MiB, WS_RC = 352 * MiB, WS_AR = 96 * MiB;
constexpr size_t WS_GB = 224 * MiB, WS_POST = 288 * MiB, WS_MG = 416 * MiB;
constexpr size_t WS_XN2 = 96 * MiB, WS_XG = 224 * MiB, WS_HMID = 496 * MiB, WS_Y = 611 * MiB, WS_END = 1024 * MiB;
static_assert(WS_Y + (size_t)2 * M * D * 2 <= WS_END && WS_HMID + (size_t)CAP * 256 * 2 <= 611 * MiB && WS_RC + (size_t)MV * RCW * 2 <= 611 * MiB, "ws map");
constexpr int CW_BAR = 4096;
constexpr int CW_GCNT = 16384;

constexpr int LDS_BYTES = 163840;
constexpr int LDS_RT = 147456, LDS_TBL = 159744, LDS_MISC = 163328;

#define LAS __attribute__((address_space(3)))
typedef unsigned short bf16;
typedef unsigned v4u __attribute__((ext_vector_type(4)));
typedef unsigned v2u __attribute__((ext_vector_type(2)));
typedef float f32x4 __attribute__((ext_vector_type(4)));
#define DI __device__ __forceinline__
#define LDS_WAIT() asm volatile("s_waitcnt lgkmcnt(0)" ::: "memory")
#define LDS_BARRIER() asm volatile("s_waitcnt lgkmcnt(0)\n\ts_barrier" ::: "memory")
typedef float f32x2_t __attribute__((ext_vector_type(2)));
typedef __bf16 bf16x2_t __attribute__((ext_vector_type(2)));
DI unsigned pk2(float lo, float hi) { const f32x2_t v = {lo, hi}; const bf16x2_t b = __builtin_convertvector(v, bf16x2_t); return __builtin_bit_cast(unsigned, b); }
DI unsigned f2bf(float f) { return pk2(f, 0.f) & 0xffffu; }
DI float bf2f(bf16 b) { return __uint_as_float((unsigned)b << 16); }
DI float wave_sum(float v) {
#pragma unroll
    for (int o = 1; o < 64; o <<= 1) v += __shfl_xor(v, o);
    return v;
}
DI float wave_max(float v) {
#pragma unroll
    for (int o = 1; o < 64; o <<= 1) v = fmaxf(v, __shfl_xor(v, o));
    return v;
}
DI float sigmoid_f(float x) { return __builtin_amdgcn_rcpf(1.0f + __builtin_amdgcn_exp2f(-1.44269504089f * x)); }

#define XB_TMO      128
#define XB_XCNT(j)  (256  + 64 * (j))
#define XB_XSUB(j)  (1280 + 64 * (j))
#define XB_XGEN(j)  (2304 + 64 * (j))
#define XB_TOP      3328
#define XB_TOPGEN   3392
#define XCD_BAR_WORDS 3456
#define XB_SPIN_CAP (1u << 20)
DI unsigned xb_ld(unsigned* p)              { return __hip_atomic_load(p, __ATOMIC_RELAXED, __HIP_MEMORY_SCOPE_AGENT); }
DI unsigned xb_add(unsigned* p, unsigned v) { return __hip_atomic_fetch_add(p, v, __ATOMIC_RELAXED, __HIP_MEMORY_SCOPE_AGENT); }
DI unsigned xb_xcc_id() { return (unsigned)__builtin_amdgcn_s_getreg((3 << 11) | 20) & 0xFu; }
#define XB_SPIN(cond, bar) do { unsigned _sp = 0; while (cond) { __builtin_amdgcn_s_sleep(1); \
    if ((++_sp & 255u) == 0u) { if (xb_ld(&(bar)[XB_TMO])) break; if (_sp > XB_SPIN_CAP) { atomicAdd(&(bar)[XB_TMO], 1u); break; } } } } while (0)
struct XcdBarrier { unsigned* bar; unsigned x; volatile LAS unsigned* st; };
DI XcdBarrier xcd_barrier_post(unsigned* bar, volatile LAS unsigned* st) {
    XcdBarrier b; b.bar = bar; b.x = xb_xcc_id(); b.st = st;
    if (threadIdx.x == 0) (void)xb_add(&bar[XB_XCNT(b.x)], 1u);
    return b;
}
DI void xcd_barrier_complete(unsigned* bar, unsigned x, unsigned& nloc, unsigned& nx) {
    const unsigned G = gridDim.x * gridDim.y * gridDim.z;
    unsigned sum, cnt, mine, sp = 0u;
    for (;;) {
        sum = 0u; cnt = 0u; mine = 0u;
#pragma unroll
        for (unsigned j = 0; j < 16; ++j) { const unsigned c = xb_ld(&bar[XB_XCNT(j)]); sum += c; cnt += (c > 0u) ? 1u : 0u; mine = (j == x) ? c : mine; }
        if (sum == G) break;
        __builtin_amdgcn_s_sleep(1);
        if ((++sp & 255u) == 0u) { if (xb_ld(&bar[XB_TMO])) break; if (sp > XB_SPIN_CAP) { atomicAdd(&bar[XB_TMO], 1u); break; } }
    }
    nloc = mine > 0u ? mine : 1u; nx = cnt > 0u ? cnt : 1u;
}
DI void xcd_barrier(const XcdBarrier& b) {
    asm volatile("s_waitcnt vmcnt(0)" ::: "memory");
    __syncthreads();
    if (threadIdx.x == 0) {
        unsigned* bar = b.bar;
        __builtin_amdgcn_s_waitcnt(0);
        unsigned nloc = b.st[0], nx = b.st[1];
        if (nloc == 0u) { xcd_barrier_complete(bar, b.x, nloc, nx); b.st[0] = nloc; b.st[1] = nx; }
        const unsigned old = xb_add(&bar[XB_XSUB(b.x)], 1u);
        const unsigned gen = old / nloc;
        if (old + 1u == (gen + 1u) * nloc) {
            __builtin_amdgcn_fence(__ATOMIC_RELEASE, "agent");
            asm volatile("s_waitcnt vmcnt(0)" ::: "memory");
            const unsigned og = xb_add(&bar[XB_TOP], 1u);
            const unsigned tg = og / nx;
            if (og + 1u == (tg + 1u) * nx) xb_add(&bar[XB_TOPGEN], 1u);
            else XB_SPIN(xb_ld(&bar[XB_TOPGEN]) == tg, bar);
            __builtin_amdgcn_fence(__ATOMIC_ACQUIRE, "agent");
            xb_add(&bar[XB_XGEN(b.x)], 1u);
            asm volatile("s_waitcnt vmcnt(0)" ::: "memory");
        } else {
            XB_SPIN(xb_ld(&bar[XB_XGEN(b.x)]) == gen, bar);
            __builtin_amdgcn_fence(__ATOMIC_ACQUIRE, "agent");
            asm volatile("s_waitcnt vmcnt(0)" ::: "memory");
        }
    }
    __syncthreads();
}

struct Args { const float* in[28]; float* out; unsigned char* ws; int ph_lo, ph_hi, li, pad; };
struct Frame {
    LAS unsigned char* lds;
    unsigned* ctl;
    int tid, lane, wave, G;
    float* out; unsigned char* ws;
};
enum { I_X = 0, I_META, I_NMG, I_WIN, I_MU, I_W0, I_WD, I_A0, I_WA, I_WG, I_KK, I_KA, I_RK, I_LNG, I_LNB, I_SINK, I_WOA, I_WOR, I_WOUT, I_NFG, I_WGRP, I_BGRP, I_WEXP, I_BEXP, I_EG, I_EU, I_ED, I_NFIN };

DI void transpose_item(const float* W, int ldw, int K, bf16* WT, int k0, int n0, int drow0, const float* kscale, float nscale, LAS float* scr, int lane) {
    float wv[32];
#pragma unroll
    for (int i = 0; i < 32; ++i) { const int kk = 2 * i + (lane >> 5); wv[i] = W[(size_t)(k0 + kk) * ldw + n0 + (lane & 31)]; }
#pragma unroll
    for (int i = 0; i < 32; ++i) { const int kk = 2 * i + (lane >> 5); float v = wv[i]; if (kscale) v *= kscale[k0 + kk]; scr[kk * 33 + (lane & 31)] = v * nscale; }
    LDS_WAIT(); asm volatile("" ::: "memory");
    const int c = lane & 7;
#pragma unroll
    for (int j = 0; j < 4; ++j) { const int n = (lane >> 3) + 8 * j; const LAS float* s = scr + (8 * c) * 33 + n;
        v4u o; o.x = pk2(s[0 * 33], s[1 * 33]); o.y = pk2(s[2 * 33], s[3 * 33]); o.z = pk2(s[4 * 33], s[5 * 33]); o.w = pk2(s[6 * 33], s[7 * 33]);
        *(v4u*)(WT + (size_t)(drow0 + n) * K + k0 + 8 * c) = o; }
    LDS_WAIT(); asm volatile("" ::: "memory");
}
DI void expert_weights(Frame& F, const Args& A, int wg0) {
    if ((int)blockIdx.x < wg0) return;
    LAS float* scr = (LAS float*)(F.lds + F.wave * 16384);
    unsigned char* ws = F.ws;
    constexpr int I_G = 32 * 16 * 8, I_U = I_G, I_DN = 32 * 4 * 32;
    const int gw = ((int)blockIdx.x - wg0) * NWAVES + F.wave, NGW = (F.G - wg0) * NWAVES;
    for (int it = gw; it < I_G + I_U + I_DN; it += NGW) {
        int r = it;
        if (r < I_G + I_U) { const int up = r >= I_G; if (up) r -= I_G; const int e = r / 128, q = r % 128, kb = q / 8, nb = q % 8, n0 = 32 * nb;
            transpose_item(A.in[up ? I_EU : I_EG] + (size_t)e * 1024 * 256, 256, 1024, (bf16*)(ws + WS_WGU), 64 * kb, n0, e * 512 + (n0 >> 7) * 256 + up * 128 + (n0 & 127), nullptr, 1.0f, scr, F.lane); continue; } r -= I_G + I_U;
        { const int e = r / 128, q = r % 128, kb = q / 32, nb = q % 32; transpose_item(A.in[I_ED] + (size_t)e * 256 * 1024, 1024, 256, (bf16*)(ws + WS_WDN), 64 * kb, 32 * nb, e * 1024 + 32 * nb, nullptr, 1.0f, scr, F.lane); }
    }
}
DI void p0_prologue(Frame& F, const Args& A) {
    LAS float* scr = (LAS float*)(F.lds + F.wave * 16384);
    const int gw = blockIdx.x * NWAVES + F.wave, NGW = F.G * NWAVES;
    unsigned char* ws = F.ws;
    constexpr int I_IN = 16 * 144, I_OA = 8 * 32, I_OR = 8 * 32, I_OUT = 16 * 32, I_LD = 16, I_LA = 16, I_LG = 32;
    constexpr int NITEMS = I_IN + I_OA + I_OR + I_OUT + I_LD + I_LA + I_LG;
    for (int it = gw; it < NITEMS; it += NGW) {
        int r = it;
        if (r < I_IN) { const int kb = r / 144, nb = r % 144, n0 = 32 * nb; int dr = n0;
            if (n0 >= 2560) { const int ng = n0 - 2560, which = ng >> 10, c = ng & 1023; dr = 2560 + (c >> 7) * 256 + which * 128 + (c & 127); }
            transpose_item(A.in[I_WIN], IN_COLS, 1024, (bf16*)(ws + WS_WIN), 64 * kb, n0, dr, A.in[I_NMG], nb < 16 ? 0.125f : 1.0f, scr, F.lane); continue; } r -= I_IN;
        if (r < I_OA) { const int kb = r / 32, nb = r % 32; transpose_item(A.in[I_WOA], 1024, 1024, (bf16*)(ws + WS_WOA), 64 * kb, 32 * nb, 32 * nb, nullptr, 1.0f, scr, F.lane); continue; } r -= I_OA;
        if (r < I_OR) { const int kb = r / 32, nb = r % 32; transpose_item(A.in[I_WOR], 1024, 1024, (bf16*)(ws + WS_WOA) + 512, 64 * kb, 32 * nb, 32 * nb, nullptr, 1.0f, scr, F.lane); continue; } r -= I_OR;
        if (r < I_OUT) { const int kb = r / 32, nb = r % 32; transpose_item(A.in[I_WOUT], 1024, 1024, (bf16*)(ws + WS_WOUT), 64 * kb, 32 * nb, 32 * nb, nullptr, 1.0f, scr, F.lane); continue; } r -= I_OUT;
        if (r < I_LD) { transpose_item(A.in[I_WD], 512, 64, (bf16*)(ws + 5 * MiB), 0, 32 * r, 32 * r, nullptr, 1.0f, scr, F.lane); continue; } r -= I_LD;
        if (r < I_LA) { transpose_item(A.in[I_WA], 512, 64, (bf16*)(ws + 5 * MiB) + 512 * 64, 0, 32 * r, 32 * r, nullptr, 1.0f, scr, F.lane); continue; } r -= I_LA;
        { const int kb = r / 16, nb = r % 16; transpose_item(A.in[I_WG], 512, 128, (bf16*)(ws + 5 * MiB) + 2 * 512 * 64, 64 * kb, 32 * nb, 32 * nb, nullptr, 1.0f, scr, F.lane); }
    }
    {
        bf16* XB = (bf16*)(ws + WS_XB);
        for (int m0 = gw; m0 < M; m0 += 4 * NGW) {
            f32x4 v[4][4];
#pragma unroll
            for (int q = 0; q < 4; ++q) { const int m = m0 + q * NGW < M ? m0 + q * NGW : m0; const f32x4* xr = (const f32x4*)(A.in[I_X] + (size_t)m * D) + F.lane;
#pragma unroll
                for (int j = 0; j < 4; ++j) v[q][j] = xr[64 * j]; }
#pragma unroll
            for (int q = 0; q < 4; ++q) { const int m = m0 + q * NGW; if (m < M) { float s = 0.f;
#pragma unroll
                for (int j = 0; j < 4; ++j) s += (v[q][j].x * v[q][j].x + v[q][j].y * v[q][j].y) + (v[q][j].z * v[q][j].z + v[q][j].w * v[q][j].w);
                const float rs = 1.0f / sqrtf(wave_sum(s) * (1.0f / D) + 1e-6f);
                v2u* o8 = (v2u*)(XB + (size_t)m * D) + F.lane;
#pragma unroll
                for (int j = 0; j < 4; ++j) { v2u o; o.x = pk2(v[q][j].x * rs, v[q][j].y * rs); o.y = pk2(v[q][j].z * rs, v[q][j].w * rs); o8[64 * j] = o; } } }
        }
    }
    __syncthreads();
    {
        LAS float* xnm = (LAS float*)F.lds;
        LAS float* red = (LAS float*)(F.lds + 65536);
        bool have = false;
        for (int it = blockIdx.x; it < 256; it += F.G) {
            if (!have) {
                for (int rr = 0; rr < 2; ++rr) { const int row = 2 * F.wave + rr; const f32x4* xr = (const f32x4*)(A.in[I_META] + row * D) + F.lane; const f32x4* gr = (const f32x4*)(A.in[I_NMG]) + F.lane;
                    f32x4 v[4]; float s = 0.f;
#pragma unroll
                    for (int j = 0; j < 4; ++j) { v[j] = xr[64 * j]; s += (v[j].x * v[j].x + v[j].y * v[j].y) + (v[j].z * v[j].z + v[j].w * v[j].w); }
                    const float rs = 1.0f / sqrtf(wave_sum(s) * (1.0f / D) + 1e-6f);
#pragma unroll
                    for (int j = 0; j < 4; ++j) { const f32x4 g = gr[64 * j]; *(LAS f32x4*)(xnm + row * D + 256 * j + 4 * F.lane) = v[j] * rs * g; } }
                __syncthreads(); have = true;
            }
            const int cg = it >> 3, ks = it & 7, col = 512 + cg * 64 + F.lane, kbase = ks * 128 + F.wave * 16;
            float acc[16];
#pragma unroll
            for (int r = 0; r < 16; ++r) acc[r] = 0.f;
#pragma unroll 4
            for (int k = 0; k < 16; ++k) { const float w = A.in[I_WIN][(size_t)(kbase + k) * IN_COLS + col];
#pragma unroll
                for (int r = 0; r < 16; ++r) acc[r] += xnm[r * D + kbase + k] * w; }
#pragma unroll
            for (int r = 0; r < 16; ++r) red[(F.wave * 16 + r) * 64 + F.lane] = acc[r];
            __syncthreads();
            float* MP = (float*)(ws + WS_METAP);
            for (int e = F.tid; e < 16 * 64; e += NWAVES * 64) { const int r = e >> 6, c = e & 63; float s = 0.f;
#pragma unroll
                for (int w = 0; w < 8; ++w) s += red[(w * 16 + r) * 64 + c];
                MP[(size_t)(ks * 16 + r) * 2048 + cg * 64 + c] = s; }
            __syncthreads();
        }
    }
}
DI void p1_meta_finish(Frame& F, const Args& A) {
    const float* MP = (const float*)(F.ws + WS_METAP);
    bf16* Kb = (bf16*)(F.ws + WS_K); bf16* Vb = (bf16*)(F.ws + WS_V); bf16* RC = (bf16*)(F.ws + WS_RC);
    for (int e = blockIdx.x * 512 + F.tid; e < 16 * 2048; e += F.G * 512) { const int r = e >> 11, c = e & 2047; float s = 0.f;
#pragma unroll
        for (int k = 0; k < 8; ++k) s += MP[(size_t)(k * 16 + r) * 2048 + c];
        const bf16 v = (bf16)f2bf(s);
        if (c < 128) Kb[(size_t)(M + r) * 128 + c] = v; else if (c < 256) Vb[(size_t)(M + r) * 128 + c - 128] = v; else RC[(size_t)(M + r) * RCW + c - 256] = v; }
}

DI void p8_router(Frame& F, const Args& A) {
    LAS float* wr = (LAS float*)F.lds;
    LAS int* lcnt = (LAS int*)(F.lds + LDS_RT); LAS int* lbase = lcnt + 32; LAS int* ent_e = lcnt + 64; LAS int* ent_p = ent_e + 512; LAS int* ent_d = ent_p + 512; LAS float* ent_w = (LAS float*)(ent_d + 512);
    const bf16* H1 = (const bf16*)(F.ws + WS_AR); bf16* XN = (bf16*)(F.ws + WS_XN2);
    int* LD = (int*)(F.ws + WS_LISTD); float* LW = (float*)(F.ws + WS_LISTW);
    const int lane = F.lane;
    for (int e = F.tid; e < 36 * 1024; e += NWAVES * 64) { const int ex = e >> 10, k = e & 1023; wr[e] = ex < 4 ? A.in[I_WGRP][k * 4 + ex] : A.in[I_WEXP][k * 32 + ex - 4]; }
    f32x4 gfr[4];
#pragma unroll
    for (int j = 0; j < 4; ++j) gfr[j] = ((const f32x4*)A.in[I_NFG])[64 * j + lane];
    const float bgv = A.in[I_BGRP][lane & 3], bev = A.in[I_BEXP][lane & 31];
    for (int ch = blockIdx.x; ch < M / 256; ch += F.G) {
        if (F.tid < 32) lcnt[F.tid] = 0;
        __syncthreads();
        v2u xnx[4];
        { const v2u* hr = (const v2u*)(H1 + (size_t)(ch * 256 + F.wave * 32) * D) + lane;
#pragma unroll
            for (int j = 0; j < 4; ++j) xnx[j] = hr[64 * j]; }
        for (int it = 0; it < 32; ++it) {
            const int tok = ch * 256 + F.wave * 32 + it;
            f32x4 xv[4];
            { float ss = 0.f;
#pragma unroll
                for (int j = 0; j < 4; ++j) xv[j] = (f32x4){__uint_as_float(xnx[j].x << 16), __uint_as_float(xnx[j].x & 0xffff0000u), __uint_as_float(xnx[j].y << 16), __uint_as_float(xnx[j].y & 0xffff0000u)};
                { const v2u* hn = (const v2u*)(H1 + (size_t)(it + 1 < 32 ? tok + 1 : tok) * D) + lane;
#pragma unroll
                    for (int j = 0; j < 4; ++j) xnx[j] = hn[64 * j]; }
#pragma unroll
                for (int j = 0; j < 4; ++j) ss += (xv[j].x * xv[j].x + xv[j].y * xv[j].y) + (xv[j].z * xv[j].z + xv[j].w * xv[j].w);
                const float ms = wave_sum(ss) * (1.0f / D) + 1e-6f, rs = 1.0f / sqrtf(ms);
                if (lane == 0) ((float*)(F.ws + WS_RSTD))[tok] = sqrtf(ms);
                v2u* o8 = (v2u*)(XN + (size_t)tok * D) + lane;
#pragma unroll
                for (int j = 0; j < 4; ++j) { xv[j] = xv[j] * rs * gfr[j]; v2u o; o.x = pk2(xv[j].x, xv[j].y); o.y = pk2(xv[j].z, xv[j].w); o8[64 * j] = o; } }
            float gl[4];
#pragma unroll
            for (int ex = 0; ex < 4; ++ex) { float p0 = 0.f;
#pragma unroll
                for (int j = 0; j < 4; ++j) { const f32x4 w4 = *(const LAS f32x4*)(wr + ex * 1024 + 256 * j + 4 * lane); p0 += (xv[j].x * w4.x + xv[j].y * w4.y) + (xv[j].z * w4.z + xv[j].w * w4.w); }
                gl[ex] = wave_sum(p0) + __shfl(bgv, ex); }
            int gs = 0; float gm = gl[0];
#pragma unroll
            for (int g = 1; g < 4; ++g) if (gl[g] > gm) { gm = gl[g]; gs = g; }
            gs = __builtin_amdgcn_readfirstlane(gs);
            float den = 0.f;
#pragma unroll
            for (int g = 0; g < 4; ++g) den += __expf(gl[g] - gm);
            const float pg = 1.0f / den;
            float v1 = -INFINITY, v2 = -INFINITY; int i1 = 0, i2 = 0;
            const LAS float* wg8 = wr + (4 + gs * 8) * 1024;
#pragma unroll
            for (int i = 0; i < 8; ++i) { float p0 = 0.f;
#pragma unroll
                for (int j = 0; j < 4; ++j) { const f32x4 w4 = *(const LAS f32x4*)(wg8 + i * 1024 + 256 * j + 4 * lane); p0 += (xv[j].x * w4.x + xv[j].y * w4.y) + (xv[j].z * w4.z + xv[j].w * w4.w); }
                const float l = wave_sum(p0) + __shfl(bev, gs * 8 + i);
                if (l > v1) { v2 = v1; i2 = i1; v1 = l; i1 = i; } else if (l > v2) { v2 = l; i2 = i; } }
            const float e2 = __expf(v2 - v1), w1 = pg / (1.0f + e2), w2 = pg * e2 / (1.0f + e2);
            if (lane < 2) { const int ex = gs * 8 + (lane == 0 ? i1 : i2); const int pos = atomicAdd((int*)&lcnt[ex], 1); const int slot = (F.wave * 32 + it) * 2 + lane;
                ent_e[slot] = ex; ent_p[slot] = pos; ent_d[slot] = tok * 2 + lane; ent_w[slot] = lane == 0 ? w1 : w2; }
        }
        __syncthreads();
        if (F.tid < 32) lbase[F.tid] = (int)__hip_atomic_fetch_add(F.ctl + CW_GCNT + 64 * F.tid, (unsigned)lcnt[F.tid], __ATOMIC_RELAXED, __HIP_MEMORY_SCOPE_AGENT);
        __syncthreads();
        { const int sl = F.tid; const int ex = ent_e[sl]; const size_t o = (size_t)ex * LCAP + lbase[ex] + ent_p[sl]; LD[o] = ent_d[sl]; LW[o] = ent_w[sl]; }
        __syncthreads();
    }
}
DI int moe_table(Frame& F) {
    LAS int* tile_e = (LAS int*)(F.lds + LDS_TBL); LAS int* tb = tile_e + TT_MAX;
    if (F.wave == 0) {
        const int e = F.lane & 31; const int c = (int)__hip_atomic_load(F.ctl + CW_GCNT + 64 * e, __ATOMIC_RELAXED, __HIP_MEMORY_SCOPE_AGENT); const int nt = (c + 255) >> 8;
        int incl = nt;
#pragma unroll
        for (int d = 1; d < 32; d <<= 1) { const int y = __shfl_up(incl, d); if ((F.lane & 31) >= d) incl += y; }
        const int first = incl - nt;
        if (F.lane < 32) { tb[e] = first; tb[33 + e] = c; for (int t = 0; t < nt; ++t) tile_e[first + t] = e; if (e == 31) { tb[32] = incl; tb[65] = incl; } }
    }
    __syncthreads();
    return tb[65];
}
DI void p12_final(Frame& F, const Args& A) {
    const unsigned char* Y = (const unsigned char*)(F.ws + WS_Y); const bf16* XN = (const bf16*)(F.ws + WS_XN2); const float* IR = (const float*)(F.ws + WS_RSTD);
    const int gw = blockIdx.x * NWAVES + F.wave, NGW = F.G * NWAVES, lane = F.lane;
    f32x4 gf[4], ig[4];
#pragma unroll
    for (int j = 0; j < 4; ++j) { gf[j] = ((const f32x4*)A.in[I_NFIN])[64 * j + lane]; const f32x4 g = ((const f32x4*)A.in[I_NFG])[64 * j + lane]; ig[j] = (f32x4){1.0f / g.x, 1.0f / g.y, 1.0f / g.z, 1.0f / g.w}; }
    for (int m0 = gw; m0 < M; m0 += 2 * NGW) {
        v2u xh[2][4]; unsigned ya[2][4], yb[2][4]; float ir[2];
#pragma unroll
        for (int q = 0; q < 2; ++q) { const int m = m0 + q * NGW < M ? m0 + q * NGW : m0; const v2u* hr = (const v2u*)(XN + (size_t)m * D) + lane; const unsigned* y0 = (const unsigned*)(Y + (size_t)(2 * m) * D) + lane; const unsigned* y1 = (const unsigned*)(Y + (size_t)(2 * m + 1) * D) + lane;
            ir[q] = IR[m];
#pragma unroll
            for (int j = 0; j < 4; ++j) { xh[q][j] = hr[64 * j]; ya[q][j] = y0[64 * j]; yb[q][j] = y1[64 * j]; } }
#pragma unroll
        for (int q = 0; q < 2; ++q) { const int m = m0 + q * NGW; if (m < M) { float s = 0.f; f32x4 v[4];
#pragma unroll
            for (int j = 0; j < 4; ++j) { const v2u h = xh[q][j]; const int a = (int)ya[q][j], c = (int)yb[q][j];
                v[j].x = __uint_as_float(h.x << 16) * ir[q] * ig[j].x + 0.0625f * (__builtin_amdgcn_cvt_f32_fp8(a, 0) + __builtin_amdgcn_cvt_f32_fp8(c, 0)); v[j].y = __uint_as_float(h.x & 0xffff0000u) * ir[q] * ig[j].y + 0.0625f * (__builtin_amdgcn_cvt_f32_fp8(a, 1) + __builtin_amdgcn_cvt_f32_fp8(c, 1));
                v[j].z = __uint_as_float(h.y << 16) * ir[q] * ig[j].z + 0.0625f * (__builtin_amdgcn_cvt_f32_fp8(a, 2) + __builtin_amdgcn_cvt_f32_fp8(c, 2)); v[j].w = __uint_as_float(h.y & 0xffff0000u) * ir[q] * ig[j].w + 0.0625f * (__builtin_amdgcn_cvt_f32_fp8(a, 3) + __builtin_amdgcn_cvt_f32_fp8(c, 3));
                s += (v[j].x * v[j].x + v[j].y * v[j].y) + (v[j].z * v[j].z + v[j].w * v[j].w); }
            const float rs = 1.0f / sqrtf(wave_sum(s) * (1.0f / D) + 1e-6f);
            f32x4* ho = (f32x4*)(F.out + (size_t)m * D) + lane;
#pragma unroll
            for (int j = 0; j < 4; ++j) ho[64 * j] = v[j] * rs * gf[j]; } }
    }
}

typedef short bf16x8 __attribute__((ext_vector_type(8)));
typedef float f32x16 __attribute__((ext_vector_type(16)));
#define MFMA32(a, b, c) __builtin_amdgcn_mfma_f32_32x32x16_bf16((a), (b), (c), 0, 0, 0)
constexpr int LDB = 72;
constexpr int LDF = 68;
constexpr int NCH = SEQ / 64, NITEM = NB * 8 * NCH, NITEM_ALL = NITEM + 8;
constexpr size_t CH_STRIDE = 65 * MiB;
constexpr size_t WS_CH = 611 * MiB;
constexpr size_t WS_LORA = 5 * MiB;
static_assert(WS_CH + 5 * CH_STRIDE <= WS_END && (size_t)NITEM_ALL * 8192 <= CH_STRIDE, "chunk map");

template <int KK> DI void mma_lds(f32x16& acc, const LAS bf16* Y, int ldy, int n0, const LAS bf16* X, int ldx, int m0, int lane) {
    const int r = lane & 31, hh = lane >> 5;
    const LAS bf16* yp = Y + (n0 + r) * ldy + 8 * hh; const LAS bf16* xp = X + (m0 + r) * ldx + 8 * hh;
#pragma unroll
    for (int k0 = 0; k0 < KK; k0 += 16) { const bf16x8 a = *(const LAS bf16x8*)(xp + k0), b = *(const LAS bf16x8*)(yp + k0); acc = MFMA32(a, b, acc); }
}
DI bf16x8 col_frag(const LAS bf16* Mx, int ld, int row0, int col) {
    const LAS bf16* p = Mx + row0 * ld + col; v4u t4;
#pragma unroll
    for (int i = 0; i < 4; ++i) t4[i] = (unsigned)p[(2 * i) * ld] | ((unsigned)p[(2 * i + 1) * ld] << 16);
    return __builtin_bit_cast(bf16x8, t4);
}
template <int KK, bool YT, bool XT> DI void mma_lds_t(f32x16& acc, const LAS bf16* Y, int ldy, int n0, const LAS bf16* X, int ldx, int m0, int lane) {
    const int r = lane & 31, hh = lane >> 5;
#pragma unroll
    for (int k0 = 0; k0 < KK; k0 += 16) {
        const bf16x8 a = XT ? col_frag(X, ldx, k0 + 8 * hh, m0 + r) : *(const LAS bf16x8*)(X + (m0 + r) * ldx + 8 * hh + k0);
        const bf16x8 b = YT ? col_frag(Y, ldy, k0 + 8 * hh, n0 + r) : *(const LAS bf16x8*)(Y + (n0 + r) * ldy + 8 * hh + k0);
        acc = MFMA32(a, b, acc); }
}
DI void add_tile_lds_t(f32x16& acc, const LAS bf16* Rm, int ld, int n0, int m0, int lane) {
    const int r = lane & 31, hh = lane >> 5;
#pragma unroll
    for (int i = 0; i < 16; ++i) acc[i] += __uint_as_float((unsigned)Rm[(m0 + 8 * (i >> 2) + 4 * hh + (i & 3)) * ld + n0 + r] << 16);
}
DI f32x16 zero16() { f32x16 z;
#pragma unroll
    for (int i = 0; i < 16; ++i) z[i] = 0.f; return z; }
DI void st_tile_lds(LAS bf16* Dm, int ld, int n0, int m0, const f32x16& acc, int lane) {
    const int r = lane & 31, hh = lane >> 5;
#pragma unroll
    for (int g = 0; g < 4; ++g) { v2u o; o.x = pk2(acc[4 * g], acc[4 * g + 1]); o.y = pk2(acc[4 * g + 2], acc[4 * g + 3]); *(LAS v2u*)(Dm + (n0 + r) * ld + m0 + 8 * g + 4 * hh) = o; }
}
DI void st_tile_glb(bf16* Dm, int ld, int n0, int m0, const f32x16& acc, int lane) {
    const int r = lane & 31, hh = lane >> 5;
#pragma unroll
    for (int g = 0; g < 4; ++g) { v2u o; o.x = pk2(acc[4 * g], acc[4 * g + 1]); o.y = pk2(acc[4 * g + 2], acc[4 * g + 3]); *(v2u*)(Dm + (size_t)(n0 + r) * ld + m0 + 8 * g + 4 * hh) = o; }
}
DI void st_tile_glb_frag(bf16* Dm, int n0, int m0, const f32x16& acc, int lane) {
    const int r = lane & 31, hh = lane >> 5;
#pragma unroll
    for (int g = 0; g < 4; ++g) { v2u o; o.x = pk2(acc[4 * g], acc[4 * g + 1]); o.y = pk2(acc[4 * g + 2], acc[4 * g + 3]);
        *(v2u*)(Dm + ((n0 >> 5) * 4 + (m0 >> 4) + (g >> 1)) * 512 + ((g & 1) * 32 + r) * 8 + 4 * hh) = o; }
}
DI void st_tile_glb_cl(bf16* Dm, int n0, int m0, const f32x16& acc, int lane) {
#pragma unroll
    for (int g = 0; g < 4; ++g) { v2u o; o.x = pk2(acc[4 * g], acc[4 * g + 1]); o.y = pk2(acc[4 * g + 2], acc[4 * g + 3]); *(v2u*)(Dm + ((n0 >> 5) * 2 + (m0 >> 5)) * 1024 + g * 256 + lane * 4) = o; }
}
DI void add_tile_lds(f32x16& acc, const LAS bf16* R, int ld, int n0, int m0, int lane) {
    const int r = lane & 31, hh = lane >> 5;
#pragma unroll
    for (int g = 0; g < 4; ++g) { const v2u w = *(const LAS v2u*)(R + (n0 + r) * ld + m0 + 8 * g + 4 * hh);
        acc[4 * g] += __uint_as_float(w.x << 16); acc[4 * g + 1] += __uint_as_float(w.x & 0xffff0000u); acc[4 * g + 2] += __uint_as_float(w.y << 16); acc[4 * g + 3] += __uint_as_float(w.y & 0xffff0000u); }
}
DI void up8(const v4u w, float* f) {
#pragma unroll
    for (int i = 0; i < 4; ++i) { f[2 * i] = __uint_as_float(w[i] << 16); f[2 * i + 1] = __uint_as_float(w[i] & 0xffff0000u); }
}
DI v4u pk8(const float* f) { v4u o; o.x = pk2(f[0], f[1]); o.y = pk2(f[2], f[3]); o.z = pk2(f[4], f[5]); o.w = pk2(f[6], f[7]); return o; }


constexpr size_t WS_XA = 936 * MiB;
DI int prev_row_of(int vt) { if (vt < M) return (vt % SEQ) > 0 ? vt - 1 : M + 15; return vt > M ? vt - 1 : -1; }
DI void p2a_lora_inputs(Frame& F, const Args& A) {
    const bf16* RC = (const bf16*)(F.ws + WS_RC); const float* mu = A.in[I_MU]; bf16* XA = (bf16*)(F.ws + WS_XA);
    const int stride = F.G * NWAVES * 64;
    for (int e0 = blockIdx.x * (NWAVES * 64) + F.tid; e0 < MV * 32; e0 += 4 * stride) {
        v4u cur[4], prv[4]; bool hp[4];
#pragma unroll
        for (int u = 0; u < 4; ++u) { const int e = e0 + u * stride < MV * 32 ? e0 + u * stride : e0; const int vt = e >> 5, col = 1536 + (e & 31) * 8, prow = prev_row_of(vt);
            hp[u] = prow >= 0; cur[u] = *(const v4u*)(RC + (size_t)vt * RCW + col); prv[u] = *(const v4u*)(RC + (size_t)(prow >= 0 ? prow : vt) * RCW + col); }
#pragma unroll
        for (int u = 0; u < 4; ++u) { const int e = e0 + u * stride; if (e < MV * 32) { const int vt = e >> 5, cg = e & 31, cl = cg * 8, col = 1536 + cl;
            float cu[8], pv[8], o[8]; up8(cur[u], cu); up8(prv[u], pv);
            if (!hp[u]) {
#pragma unroll
                for (int i = 0; i < 8; ++i) pv[i] = 0.f; }
            const f32x4 m0 = *(const f32x4*)(mu + col), m1 = *(const f32x4*)(mu + col + 4);
#pragma unroll
            for (int i = 0; i < 8; ++i) { const float mm = i < 4 ? m0[i] : m1[i - 4]; const float v = cu[i] + mm * (pv[i] - cu[i]);
                const float ex = __expf(-2.0f * fabsf(v)), th = copysignf((1.0f - ex) * __builtin_amdgcn_rcpf(1.0f + ex), v);
                o[i] = cg < 8 ? th : (cg < 16 ? v : sigmoid_f(v)); }
            *(v4u*)(XA + (size_t)vt * 256 + cl) = pk8(o); } }
    }
}

constexpr int L_AT = 0, L_ATT = 9216, L_RT = 18432, L_BT = 27648, L_BTT = 36864, L_KT = 46080, L_KTT = 55296, L_VT = 64512;
constexpr int L_AF = 73728, L_AP = 91136, L_AAK = 100352, L_ABR = 109568, L_AKR = 118784, L_TP = 128000, L_D1T = 137216, L_XT = 142336, L_PC = 146432;
constexpr int L_W1 = L_AF, L_AKT = L_AF + 9216, L_GT = L_AT, L_NKT = L_ATT;
constexpr int L_XL = 73728, L_LW = 73728, L_SEG = 91136, L_WL = 107520, L_AL = 124928;
constexpr int LDX = 264;

constexpr int L_WLN = 146688, L_ALN = L_WLN + 8192, L_TOT = L_LW;
struct ChunkItem { int h, row0, nvalid, prow0; bool meta; size_t oidx; };
DI ChunkItem chunk_item(int it, int npairs, int G) {
    ChunkItem I; I.meta = it >= npairs * 8;
    const int pair = I.meta ? 0 : (int)blockIdx.x + (it >> 3) * G; I.h = I.meta ? (int)blockIdx.x : (it & 7);
    const int b = I.meta ? 0 : pair / NCH, c = I.meta ? 0 : pair % NCH;
    I.row0 = I.meta ? M : b * SEQ + 64 * c; I.nvalid = I.meta ? 16 : 64; I.prow0 = I.meta ? -1 : (c > 0 ? I.row0 - 1 : M + 15);
    I.oidx = I.meta ? (size_t)(NITEM + I.h) : (size_t)((b * 8 + I.h) * NCH + c);
    return I;
}
DI void lora_tile(LAS unsigned char* L, const ChunkItem& I, int kind, int tq, const bf16* XA, const bf16* WdT, const bf16* WaT, const bf16* WgT, bf16* GB, int lane) {
    const int r32 = lane & 31, hh = lane >> 5, n0 = 32 * (tq >> 1), m0 = 32 * (tq & 1);
    const int tvx = (n0 + r32) < I.nvalid ? (n0 + r32) : I.nvalid - 1; const bf16* XLr = XA + (size_t)(I.row0 + tvx) * 256 + 8 * hh;
    f32x16 acc = zero16();
    if (kind < 2) { const bf16* Wt = (kind ? WaT : WdT) + (size_t)(I.h * 64 + m0 + r32) * 64 + 8 * hh;
#pragma unroll
        for (int k0 = 0; k0 < 64; k0 += 16) { const bf16x8 a = *(const bf16x8*)(Wt + k0), bb = *(const bf16x8*)(XLr + kind * 64 + k0); acc = MFMA32(a, bb, acc); }
        st_tile_lds((LAS bf16*)(L + (kind ? L_ALN : L_WLN)), 64, n0, m0, acc, lane);
    } else { const bf16* Wt = WgT + (size_t)(I.h * 64 + m0 + r32) * 128 + 8 * hh;
#pragma unroll
        for (int k0 = 0; k0 < 128; k0 += 16) { const bf16x8 a = *(const bf16x8*)(Wt + k0), bb = *(const bf16x8*)(XLr + 128 + k0); acc = MFMA32(a, bb, acc); }
        if (!I.meta) st_tile_glb_cl(GB + I.oidx * 4096, n0, m0, acc, lane); }
}
DI void stage1_tile(LAS unsigned char* L, int p, int n0, int m0, int lane) {
    const int r32 = lane & 31, hh = lane >> 5, n = n0 + r32;
    const LAS bf16* Y = (const LAS bf16*)(L + (p == 0 ? L_AT : p == 1 ? L_KT : L_RT));
    const LAS bf16* X = (const LAS bf16*)(L + (p == 0 ? L_BT : p == 1 ? L_AT : p == 2 ? L_BT : L_KT));
    f32x16 acc = zero16(); mma_lds<64>(acc, Y, LDB, n0, X, LDB, m0, lane);
#pragma unroll
    for (int i = 0; i < 16; ++i) { const int m = m0 + 8 * (i >> 2) + 4 * hh + (i & 3); const bool keep = p == 0 ? (m < n) : p == 1 ? (n < m) : (m <= n); if (!keep) acc[i] = 0.f; }
    if (p == 0) { LAS float* AFm = (LAS float*)(L + L_AF);
#pragma unroll
        for (int g = 0; g < 4; ++g) *(LAS f32x4*)(AFm + n * LDF + m0 + 8 * g + 4 * hh) = (f32x4){acc[4 * g], acc[4 * g + 1], acc[4 * g + 2], acc[4 * g + 3]};
        st_tile_lds((LAS bf16*)(L + L_AP), LDB, n0, m0, acc, lane); }
    else st_tile_lds((LAS bf16*)(L + (p == 1 ? L_AAK : p == 2 ? L_ABR : L_AKR)), LDB, n0, m0, acc, lane);
}
#ifndef P3I_REPS
#define P3I_REPS 1
#endif
DI void p3_rwkv_chunk(Frame& F, const Args& A) {
    LAS unsigned char* L = F.lds;
    const bf16* RC = (const bf16*)(F.ws + WS_RC); const float* mu = A.in[I_MU];
    bf16* GB = (bf16*)(F.ws + WS_GB); bf16* PO = (bf16*)(F.ws + WS_POST);
    const bf16* WdT = (const bf16*)(F.ws + WS_LORA); const bf16* WaT = WdT + 512 * 64; const bf16* WgT = WaT + 512 * 64;
    bf16* W2T = (bf16*)(F.ws + WS_CH); bf16* MTg = (bf16*)(F.ws + WS_CH + CH_STRIDE); bf16* YLT = (bf16*)(F.ws + WS_CH + 2 * CH_STRIDE); bf16* NBg = (bf16*)(F.ws + WS_CH + 3 * CH_STRIDE);
    const int tid = F.tid, lane = F.lane, w = F.wave, r32 = lane & 31, hh = lane >> 5;
    const bf16* XA = (const bf16*)(F.ws + WS_XA);
    const int npairs = (NB * NCH - (int)blockIdx.x + F.G - 1) / F.G, nmine = npairs * 8 + (blockIdx.x < 8 ? 1 : 0);
    if (nmine == 0) return;
    { LAS float* P1 = (LAS float*)(L + L_BTT); LAS float* P2 = (LAS float*)(L + L_KTT); const int i = tid;
        P1[i] = A.in[I_W0][i]; P1[512 + i] = A.in[I_A0][i]; P1[1024 + i] = A.in[I_KK][i]; P1[1536 + i] = A.in[I_KA][i]; ((LAS bf16*)(P1 + 2048))[i] = (bf16)f2bf(A.in[I_RK][i]);
        P2[i] = mu[i]; P2[512 + i] = mu[512 + i]; P2[1024 + i] = mu[1024 + i]; ((LAS bf16*)(P2 + 1536))[i] = (bf16)f2bf(A.in[I_LNB][i]); }
    const int t = tid >> 3, jg = tid & 7, j0 = 8 * jg;
    v4u rcu[3], rpv[3];
#define P3_REQ_ROWS(I_) do { const int tv_ = t < (I_).nvalid ? t : (I_).nvalid - 1, row_ = (I_).row0 + tv_, prow_ = tv_ > 0 ? row_ - 1 : (I_).prow0, ch_ = (I_).h * 64 + j0; \
        _Pragma("unroll") for (int which = 0; which < 3; ++which) { rcu[which] = *(const v4u*)(RC + (size_t)row_ * RCW + which * 512 + ch_); rpv[which] = *(const v4u*)(RC + (size_t)(prow_ >= 0 ? prow_ : row_) * RCW + which * 512 + ch_); } } while (0)
    {
        const ChunkItem I0 = chunk_item(0, npairs, F.G);
        P3_REQ_ROWS(I0);
        if (w < 4) { lora_tile(L, I0, 0, w, XA, WdT, WaT, WgT, GB, lane); lora_tile(L, I0, 1, w, XA, WdT, WaT, WgT, GB, lane); } else lora_tile(L, I0, 2, w - 4, XA, WdT, WaT, WgT, GB, lane);
    }
    LDS_BARRIER();
    for (int it = 0; it < nmine; ++it) {
        const ChunkItem I = chunk_item(it, npairs, F.G);
        const bool has_next = it + 1 < nmine; const ChunkItem IN = chunk_item(has_next ? it + 1 : it, npairs, F.G);
        const int h = I.h, row0 = I.row0, nvalid = I.nvalid, prow0 = I.prow0; const bool meta = I.meta; const size_t oidx = I.oidx;
        const int ch = h * 64 + j0;
        float rr[8], kp[8], vv[8], lw[8], aa[8], bb8[8], cum[8];
        {
            const bool valid = t < nvalid; const int tv = valid ? t : nvalid - 1;
            const int row = row0 + tv, prow = tv > 0 ? row - 1 : prow0;
            float cu[8], pv[8], kr[8];
#pragma unroll
            for (int which = 0; which < 3; ++which) { const int col = which * 512 + ch;
                up8(rcu[which], cu); up8(rpv[which], pv);
                if (prow < 0) {
#pragma unroll
                    for (int e = 0; e < 8; ++e) pv[e] = 0.f; }
                const f32x4 m0 = *(const LAS f32x4*)(L + L_KTT + (which * 512 + ch) * 4), m1 = *(const LAS f32x4*)(L + L_KTT + (which * 512 + ch + 4) * 4);
#pragma unroll
                for (int e = 0; e < 8; ++e) { const float mm = e < 4 ? m0[e] : m1[e - 4]; const float v = cu[e] + mm * (pv[e] - cu[e]); if (which == 0) rr[e] = v; else if (which == 1) kr[e] = v; else vv[e] = v; } }
            float wl8[8], al8[8]; up8(*(const LAS v4u*)(L + L_WLN + (t * 64 + j0) * 2), wl8); up8(*(const LAS v4u*)(L + L_ALN + (t * 64 + j0) * 2), al8);
            float s1 = 0.f, asg[8], pw0[8], pa0[8], pkk[8], pka[8], prk[8], plb[8];
#pragma unroll
            for (int q = 0; q < 2; ++q) { const LAS float* P1 = (const LAS float*)(L + L_BTT) + ch + 4 * q; const f32x4 v0 = *(const LAS f32x4*)P1, v1 = *(const LAS f32x4*)(P1 + 512), v2 = *(const LAS f32x4*)(P1 + 1024), v3 = *(const LAS f32x4*)(P1 + 1536);
#pragma unroll
                for (int i = 0; i < 4; ++i) { pw0[4 * q + i] = v0[i]; pa0[4 * q + i] = v1[i]; pkk[4 * q + i] = v2[i]; pka[4 * q + i] = v3[i]; } }
            up8(*(const LAS v4u*)(L + L_BTT + 8192 + ch * 2), prk); up8(*(const LAS v4u*)(L + L_KTT + 6144 + ch * 2), plb);
#pragma unroll
            for (int e = 0; e < 8; ++e) { lw[e] = -0.60653065971f * sigmoid_f(pw0[e] + wl8[e]);
                asg[e] = sigmoid_f(pa0[e] + al8[e]); aa[e] = kr[e] * pkk[e]; s1 += aa[e] * aa[e];
                kp[e] = kr[e] * (1.0f + (asg[e] - 1.0f) * pka[e]); }
            s1 += __shfl_xor(s1, 1); s1 += __shfl_xor(s1, 2); s1 += __shfl_xor(s1, 4);
            const float inv = __builtin_amdgcn_rcpf(fmaxf(__builtin_amdgcn_sqrtf(s1), 1e-12f));
            float s2 = 0.f;
#pragma unroll
            for (int e = 0; e < 8; ++e) { const float kkv = aa[e] * inv; aa[e] = -kkv; bb8[e] = kkv * asg[e]; s2 += rr[e] * kp[e] * prk[e]; }
            s2 += __shfl_xor(s2, 1); s2 += __shfl_xor(s2, 2); s2 += __shfl_xor(s2, 4);
            if (!meta) { float po[8];
#pragma unroll
                for (int e = 0; e < 8; ++e) po[e] = plb[e] + s2 * vv[e];
                const v4u pp = pk8(po); bf16* pd = PO + oidx * 4096 + ((t >> 5) * 2 + (jg >> 2)) * 1024 + (jg & 3) * 256 + (t & 31) * 4;
                v2u lo; lo.x = pp.x; lo.y = pp.y; v2u hi; hi.x = pp.z; hi.y = pp.w; *(v2u*)pd = lo; *(v2u*)(pd + 128) = hi; }
            if (!valid) {
#pragma unroll
                for (int e = 0; e < 8; ++e) { rr[e] = 0.f; kp[e] = 0.f; vv[e] = 0.f; lw[e] = 0.f; aa[e] = 0.f; bb8[e] = 0.f; } }
#pragma unroll
            for (int e = 0; e < 8; ++e) { float x = lw[e];
#pragma unroll
                for (int dlt = 8; dlt < 64; dlt <<= 1) { const float y = __shfl_up(x, dlt); if (lane >= dlt) x += y; }
                cum[e] = x; }
            if ((lane >> 3) == 7) { LAS float* TOT = (LAS float*)(L + L_TOT) + w * 64 + j0; *(LAS f32x4*)TOT = (f32x4){cum[0], cum[1], cum[2], cum[3]}; *(LAS f32x4*)(TOT + 4) = (f32x4){cum[4], cum[5], cum[6], cum[7]}; }
        }
        LDS_BARRIER();
        {
            const LAS float* TOT = (const LAS float*)(L + L_TOT) + j0;
            for (int q = 0; q < w; ++q) { const f32x4 a4 = *(const LAS f32x4*)(TOT + q * 64), b4 = *(const LAS f32x4*)(TOT + q * 64 + 4);
                cum[0] += a4.x; cum[1] += a4.y; cum[2] += a4.z; cum[3] += a4.w; cum[4] += b4.x; cum[5] += b4.y; cum[6] += b4.z; cum[7] += b4.w; }
            float at[8], rt[8], bt[8], kt[8];
#pragma unroll
            for (int e = 0; e < 8; ++e) { const float p = __builtin_amdgcn_exp2f(1.44269504089f * cum[e]), pprev = __builtin_amdgcn_exp2f(1.44269504089f * (cum[e] - lw[e])), pinv = __builtin_amdgcn_rcpf(p);
                at[e] = aa[e] * pprev; rt[e] = rr[e] * p; bt[e] = bb8[e] * pinv; kt[e] = kp[e] * pinv;
                if (t == 63) ((LAS float*)(L + L_PC))[j0 + e] = p; }
            *(LAS v4u*)(L + L_RT + (t * LDB + j0) * 2) = pk8(rt);
            const v4u pat = pk8(at), pbt = pk8(bt), pkt = pk8(kt), pvt = pk8(vv);
            *(LAS v4u*)(L + L_AT + (t * LDB + j0) * 2) = pat; *(LAS v4u*)(L + L_BT + (t * LDB + j0) * 2) = pbt; *(LAS v4u*)(L + L_KT + (t * LDB + j0) * 2) = pkt;
            *(LAS v4u*)(L + L_VT + (t * LDB + j0) * 2) = pvt;
        }
        LDS_BARRIER();
        stage1_tile(L, w >> 2, 32 * ((w >> 1) & 1), 32 * (w & 1), lane);
        LDS_BARRIER();
        _Pragma("unroll 1") for (int repi_ = 0; repi_ < P3I_REPS; ++repi_)
        if (w == 0) {
            LAS bf16* TP = (LAS bf16*)(L + L_TP); const LAS bf16* AP = (const LAS bf16*)(L + L_AP); LAS bf16* XT1 = (LAS bf16*)(L + L_D1T); LAS bf16* XT2 = (LAS bf16*)(L + L_XT);
            const int d4 = lane >> 4, cc = lane & 15; const LAS float* AFm = (const LAS float*)(L + L_AF) + (16 * d4) * LDF + 16 * d4;
#pragma unroll
            for (int i = 0; i < 9; ++i) *(LAS v4u*)(L + L_TP + (lane + 64 * i) * 16) = (v4u){0u, 0u, 0u, 0u};
            float x[16];
#pragma unroll
            for (int tt = 0; tt < 16; ++tt) x[tt] = 0.f;
            x[0] = cc == 0 ? 1.f : 0.f;
            {
                f32x4 ar[7][2];
#pragma unroll
                for (int tt = 1; tt < 8; ++tt)
#pragma unroll
                    for (int q = 0; q < 2; ++q) if (4 * q < tt) ar[tt - 1][q] = *(const LAS f32x4*)(AFm + tt * LDF + 4 * q);
#pragma unroll
                for (int tt = 1; tt < 8; ++tt) { float acc = (tt == cc) ? 1.f : 0.f;
#pragma unroll
                    for (int q = 0; q < 2; ++q) if (4 * q < tt) acc += (ar[tt - 1][q].x * x[4 * q] + ar[tt - 1][q].y * x[4 * q + 1]) + (ar[tt - 1][q].z * x[4 * q + 2] + ar[tt - 1][q].w * x[4 * q + 3]);
                    x[tt] = acc; }
            }
            {
                f32x4 ar[8][4];
#pragma unroll
                for (int tt = 8; tt < 16; ++tt)
#pragma unroll
                    for (int q = 0; q < 4; ++q) if (4 * q < tt) ar[tt - 8][q] = *(const LAS f32x4*)(AFm + tt * LDF + 4 * q);
#pragma unroll
                for (int tt = 8; tt < 16; ++tt) { float acc = (tt == cc) ? 1.f : 0.f;
#pragma unroll
                    for (int q = 0; q < 4; ++q) if (4 * q < tt) acc += (ar[tt - 8][q].x * x[4 * q] + ar[tt - 8][q].y * x[4 * q + 1]) + (ar[tt - 8][q].z * x[4 * q + 2] + ar[tt - 8][q].w * x[4 * q + 3]);
                    x[tt] = acc; }
            }
#pragma unroll
            for (int tt = 0; tt < 16; ++tt) TP[(16 * d4 + tt) * LDB + 16 * d4 + cc] = (bf16)f2bf(x[tt]);
            LDS_WAIT();
            f32x16 f0 = zero16(), f1 = zero16();
            mma_lds_t<32, true, false>(f0, TP, LDB, 0, AP, LDB, 0, lane); mma_lds_t<32, true, false>(f1, TP + 32 * LDB + 32, LDB, 0, AP + 32 * LDB + 32, LDB, 0, lane);
            st_tile_lds(XT1, 40, 0, 0, f0, lane); st_tile_lds(XT1 + 1280, 40, 0, 0, f1, lane);
            LDS_WAIT();
            f0 = zero16(); f1 = zero16();
            mma_lds<32>(f0, TP, LDB, 0, XT1, 40, 0, lane); mma_lds<32>(f1, TP + 32 * LDB + 32, LDB, 0, XT1 + 1280, 40, 0, lane);
            if (r32 >= 16) {
#pragma unroll
                for (int g = 0; g < 2; ++g) { v2u o0, o1; o0.x = pk2(f0[4 * g], f0[4 * g + 1]); o0.y = pk2(f0[4 * g + 2], f0[4 * g + 3]); o1.x = pk2(f1[4 * g], f1[4 * g + 1]); o1.y = pk2(f1[4 * g + 2], f1[4 * g + 3]);
                    *(LAS v2u*)(TP + r32 * LDB + 8 * g + 4 * hh) = o0; *(LAS v2u*)(TP + (32 + r32) * LDB + 32 + 8 * g + 4 * hh) = o1; } }
            LDS_WAIT();
            {
                f32x16 acc = zero16(); mma_lds_t<32, true, false>(acc, TP, LDB, 0, AP + 32 * LDB, LDB, 0, lane);
                st_tile_lds(XT2, 40, 0, 0, acc, lane);
            }
            LDS_WAIT();
            {
                f32x16 acc = zero16(); mma_lds<32>(acc, TP + 32 * LDB + 32, LDB, 0, XT2, 40, 0, lane);
                st_tile_lds(TP + 32 * LDB, LDB, 0, 0, acc, lane);
            }
        } else {
            if (w <= 4) { const int p = 2 + ((w - 1) >> 1), n0 = 32 * ((w - 1) & 1); stage1_tile(L, p, n0, 0, lane); stage1_tile(L, p, n0, 32, lane); }
            if (has_next) {
                if (w <= 4) { lora_tile(L, IN, 0, w - 1, XA, WdT, WaT, WgT, GB, lane); lora_tile(L, IN, 1, w - 1, XA, WdT, WaT, WgT, GB, lane); }
                else if (w == 5) { lora_tile(L, IN, 2, 0, XA, WdT, WaT, WgT, GB, lane); lora_tile(L, IN, 2, 1, XA, WdT, WaT, WgT, GB, lane); }
                else lora_tile(L, IN, 2, w - 4, XA, WdT, WaT, WgT, GB, lane);
            }
        }
        LDS_BARRIER();
        {
            const int p = w >> 2, n0 = 32 * ((w >> 1) & 1), m0 = 32 * (w & 1);
            f32x16 acc = zero16();
            if (p) mma_lds<64>(acc, (const LAS bf16*)(L + L_AAK), LDB, n0, (const LAS bf16*)(L + L_TP), LDB, m0, lane);
            else mma_lds_t<64, true, false>(acc, (const LAS bf16*)(L + L_AT), LDB, n0, (const LAS bf16*)(L + L_TP), LDB, m0, lane);
            st_tile_lds((LAS bf16*)(L + (p ? L_AKT : L_W1)), LDB, n0, m0, acc, lane);
        }
        LDS_BARRIER();
        {
            const int p = w >> 1, n0 = 32 * (w & 1), n = n0 + r32;
            const LAS bf16* Y = (const LAS bf16*)(L + (p < 2 ? L_ABR : L_BT)); const LAS bf16* X = (const LAS bf16*)(L + ((p & 1) ? L_AKT : L_W1));
            const float pc = ((const LAS float*)(L + L_PC))[n];
#pragma unroll 1
            for (int mt = 0; mt < 2; ++mt) { const int m0 = 32 * mt; f32x16 acc = zero16();
                if (p < 2) mma_lds<64>(acc, Y, LDB, n0, X, LDB, m0, lane); else mma_lds_t<64, true, false>(acc, Y, LDB, n0, X, LDB, m0, lane);
                if (p == 0) { add_tile_lds(acc, (const LAS bf16*)(L + L_RT), LDB, n0, m0, lane); st_tile_glb_frag(W2T + oidx * 4096, n0, m0, acc, lane); }
                else if (p == 1) { add_tile_lds(acc, (const LAS bf16*)(L + L_AKR), LDB, n0, m0, lane); st_tile_lds((LAS bf16*)(L + L_GT), LDB, n0, m0, acc, lane); }
                else if (p == 2) {
#pragma unroll
                    for (int i = 0; i < 16; ++i) { const int m = m0 + 8 * (i >> 2) + 4 * hh + (i & 3); acc[i] = (acc[i] + (m == n ? 1.f : 0.f)) * pc; }
                    st_tile_glb(MTg + oidx * 4096, 64, n0, m0, acc, lane); }
                else { add_tile_lds_t(acc, (const LAS bf16*)(L + L_KT), LDB, n0, m0, lane);
#pragma unroll
                    for (int i = 0; i < 16; ++i) acc[i] *= pc;
                    st_tile_lds((LAS bf16*)(L + L_NKT), LDB, n0, m0, acc, lane); } }
        }
        LDS_BARRIER();
        if (has_next) P3_REQ_ROWS(IN);
        {
            const int p = w >> 2, n0 = 32 * ((w >> 1) & 1), m0 = 32 * (w & 1);
            f32x16 acc = zero16();
            if (p) mma_lds_t<64, true, false>(acc, (const LAS bf16*)(L + L_VT), LDB, n0, (const LAS bf16*)(L + L_NKT), LDB, m0, lane);
            else mma_lds_t<64, false, true>(acc, (const LAS bf16*)(L + L_GT), LDB, n0, (const LAS bf16*)(L + L_VT), LDB, m0, lane);
            if (p) st_tile_glb(NBg + oidx * 4096, 64, n0, m0, acc, lane); else st_tile_glb_cl(YLT + oidx * 4096, n0, m0, acc, lane);
        }
    }
#undef P3_REQ_ROWS
}

constexpr int CH_GC = 4, CH_SLOT = (64 + 32) * LDB * 2, CH_NOFF = 64 * LDB * 2;
DI void p4_rwkv_chain(Frame& F, const Args& A) {
    const bf16* MTg = (const bf16*)(F.ws + WS_CH + CH_STRIDE); const bf16* NBg = (const bf16*)(F.ws + WS_CH + 3 * CH_STRIDE); bf16* S0g = (bf16*)(F.ws + WS_CH + 4 * CH_STRIDE);
    const int lane = F.lane, r32 = lane & 31, hh = lane >> 5, w = F.wave;
    for (int task = blockIdx.x; task < NB * 8 * 2; task += F.G) {
        const int bh = task >> 1, n0 = 32 * (task & 1), hd = bh & 7;
        f32x16 s[2];
        if (w == 0) { const bf16* Nm = NBg + (size_t)(NITEM + hd) * 4096 + (size_t)(n0 + r32) * 64 + 4 * hh;
#pragma unroll
            for (int mt = 0; mt < 2; ++mt)
#pragma unroll
                for (int g = 0; g < 4; ++g) { const v2u wv = *(const v2u*)(Nm + 32 * mt + 8 * g);
                    s[mt][4 * g] = __uint_as_float(wv.x << 16); s[mt][4 * g + 1] = __uint_as_float(wv.x & 0xffff0000u); s[mt][4 * g + 2] = __uint_as_float(wv.y << 16); s[mt][4 * g + 3] = __uint_as_float(wv.y & 0xffff0000u); } }
#define CH_STAGE(gi) do { if (w > 0) { v4u rg_[7]; \
            _Pragma("unroll") for (int u_ = 0; u_ < 7; ++u_) { const int pc_ = F.tid - 64 + u_ * 448; if (pc_ < CH_GC * 768) { const int sl_ = pc_ / 768, q_ = pc_ - sl_ * 768; const size_t o_ = (size_t)(bh * NCH + CH_GC * (gi) + sl_) * 4096; \
                rg_[u_] = q_ < 512 ? *(const v4u*)(MTg + o_ + (size_t)q_ * 8) : *(const v4u*)(NBg + o_ + (size_t)(n0 + ((q_ - 512) >> 3)) * 64 + ((q_ - 512) & 7) * 8); } } \
            _Pragma("unroll") for (int u_ = 0; u_ < 7; ++u_) { const int pc_ = F.tid - 64 + u_ * 448; if (pc_ < CH_GC * 768) { const int sl_ = pc_ / 768, q_ = pc_ - sl_ * 768; \
                LAS unsigned char* dst_ = F.lds + (((gi) & 1) * CH_GC + sl_) * CH_SLOT; \
                if (q_ < 512) *(LAS v4u*)(dst_ + (q_ >> 3) * (LDB * 2) + (q_ & 7) * 16) = rg_[u_]; \
                else { const int q2_ = q_ - 512; *(LAS v4u*)(dst_ + CH_NOFF + (q2_ >> 3) * (LDB * 2) + (q2_ & 7) * 16) = rg_[u_]; } } } } } while (0)
        CH_STAGE(0);
        LDS_BARRIER();
        for (int gi = 0; gi < NCH / CH_GC; ++gi) {
            if (gi + 1 < NCH / CH_GC) CH_STAGE(gi + 1);
            if (w == 0) {
#pragma unroll 1
                for (int sl = 0; sl < CH_GC; ++sl) { const int c = CH_GC * gi + sl;
                    const LAS bf16* Ms = (const LAS bf16*)(F.lds + ((gi & 1) * CH_GC + sl) * CH_SLOT); const LAS bf16* Ns = Ms + 64 * LDB;
                    bf16x8 am[2][4]; f32x16 acc[2];
#pragma unroll
                    for (int mt = 0; mt < 2; ++mt)
#pragma unroll
                        for (int q = 0; q < 4; ++q) { const LAS bf16* mr = Ms + (32 * mt + r32) * LDB + 16 * q + 4 * hh; const v2u lo = *(const LAS v2u*)mr, hi = *(const LAS v2u*)(mr + 8); const v2u nv = *(const LAS v2u*)(Ns + r32 * LDB + 32 * mt + 8 * q + 4 * hh);
                            v4u t4; t4.x = lo.x; t4.y = lo.y; t4.z = hi.x; t4.w = hi.y; am[mt][q] = __builtin_bit_cast(bf16x8, t4);
                            acc[mt][4 * q] = __uint_as_float(nv.x << 16); acc[mt][4 * q + 1] = __uint_as_float(nv.x & 0xffff0000u); acc[mt][4 * q + 2] = __uint_as_float(nv.y << 16); acc[mt][4 * q + 3] = __uint_as_float(nv.y & 0xffff0000u); }
                    bf16x8 sb[4];
                    { bf16* So = S0g + (size_t)(bh * NCH + c) * 4096 + (n0 >> 5) * 2048 + r32 * 8 + 4 * hh;
#pragma unroll
                        for (int q = 0; q < 4; ++q) { const int mt = q >> 1, i0 = 8 * (q & 1); v4u t4; t4.x = pk2(s[mt][i0], s[mt][i0 + 1]); t4.y = pk2(s[mt][i0 + 2], s[mt][i0 + 3]); t4.z = pk2(s[mt][i0 + 4], s[mt][i0 + 5]); t4.w = pk2(s[mt][i0 + 6], s[mt][i0 + 7]);
                            sb[q] = __builtin_bit_cast(bf16x8, t4);
                            v2u lo; lo.x = t4.x; lo.y = t4.y; v2u hi; hi.x = t4.z; hi.y = t4.w; *(v2u*)(So + 512 * q) = lo; *(v2u*)(So + 512 * q + 256) = hi; } }
#pragma unroll
                    for (int mt = 0; mt < 2; ++mt)
#pragma unroll
                        for (int q = 0; q < 4; ++q) acc[mt] = MFMA32(am[mt][q], sb[q], acc[mt]);
                    s[0] = acc[0]; s[1] = acc[1];
                }
            }
            LDS_BARRIER();
        }
#undef CH_STAGE
    }
}

DI void p5_rwkv_out(Frame& F, const Args& A) {
    const bf16* W2T = (const bf16*)(F.ws + WS_CH); const bf16* YLT = (const bf16*)(F.ws + WS_CH + 2 * CH_STRIDE); const bf16* S0g = (const bf16*)(F.ws + WS_CH + 4 * CH_STRIDE);
    const bf16* GB = (const bf16*)(F.ws + WS_GB); const bf16* PO = (const bf16*)(F.ws + WS_POST); bf16* RY = (bf16*)(F.ws + WS_AR) + 512;
    const int lane = F.lane, r32 = lane & 31, hh = lane >> 5;
    LAS bf16* stg = (LAS bf16*)(F.lds + F.wave * 8192);
    for (int pm = blockIdx.x; pm < M / 256; pm += F.G)
    for (int q = F.wave; q < 64; q += NWAVES) {
        const int b = pm >> 5, c = 4 * (pm & 31) + (q >> 4), h = (q >> 1) & 7, n0 = 32 * (q & 1), idx = (b * 8 + h) * NCH + c;
        const size_t o = (size_t)idx * 4096; const int row = b * SEQ + 64 * c + n0 + r32;
        const bf16* Yr = W2T + o + (n0 >> 5) * 2048 + lane * 8;
        v2u pwr[2][4], gvr[2][4]; f32x4 lgr[2][4];
#pragma unroll
        for (int mt = 0; mt < 2; ++mt)
#pragma unroll
            for (int g = 0; g < 4; ++g) { const int i0 = h * 64 + 32 * mt + 8 * g + 4 * hh; const size_t go = o + ((n0 >> 5) * 2 + mt) * 1024 + g * 256 + lane * 4; lgr[mt][g] = *(const f32x4*)(A.in[I_LNG] + i0); pwr[mt][g] = *(const v2u*)(PO + go); gvr[mt][g] = *(const v2u*)(GB + go); }
        f32x16 acc[2];
#pragma unroll
        for (int mt = 0; mt < 2; ++mt) { const bf16* Lr = YLT + o + ((n0 >> 5) * 2 + mt) * 1024 + lane * 4;
#pragma unroll
            for (int g = 0; g < 4; ++g) { const v2u wv = *(const v2u*)(Lr + 256 * g);
                acc[mt][4 * g] = __uint_as_float(wv.x << 16); acc[mt][4 * g + 1] = __uint_as_float(wv.x & 0xffff0000u); acc[mt][4 * g + 2] = __uint_as_float(wv.y << 16); acc[mt][4 * g + 3] = __uint_as_float(wv.y & 0xffff0000u); } }
#pragma unroll
        for (int k0 = 0; k0 < 64; k0 += 16) { const bf16x8 yb = *(const bf16x8*)(Yr + (k0 >> 4) * 512);
#pragma unroll
            for (int mt = 0; mt < 2; ++mt) { const bf16x8 xa = *(const bf16x8*)(S0g + o + (mt * 4 + (k0 >> 4)) * 512 + lane * 8); acc[mt] = MFMA32(xa, yb, acc[mt]); } }
        float sum = 0.f;
#pragma unroll
        for (int mt = 0; mt < 2; ++mt)
#pragma unroll
            for (int i = 0; i < 16; ++i) sum += acc[mt][i];
        sum += __shfl_xor(sum, 32); const float mean = sum * (1.0f / 64.0f);
        float sq = 0.f;
#pragma unroll
        for (int mt = 0; mt < 2; ++mt)
#pragma unroll
            for (int i = 0; i < 16; ++i) { acc[mt][i] -= mean; sq += acc[mt][i] * acc[mt][i]; }
        sq += __shfl_xor(sq, 32); const float rstd = 1.0f / sqrtf(sq * (1.0f / 64.0f) + 64e-5f);
#pragma unroll
        for (int mt = 0; mt < 2; ++mt)
#pragma unroll
            for (int g = 0; g < 4; ++g) { const int i0 = h * 64 + 32 * mt + 8 * g + 4 * hh; const size_t go = (size_t)row * 512 + i0;
                const f32x4 lg = lgr[mt][g]; const v2u pw = pwr[mt][g], gv = gvr[mt][g];
                const float o0 = (acc[mt][4 * g] * rstd * lg.x + __uint_as_float(pw.x << 16)) * __uint_as_float(gv.x << 16), o1 = (acc[mt][4 * g + 1] * rstd * lg.y + __uint_as_float(pw.x & 0xffff0000u)) * __uint_as_float(gv.x & 0xffff0000u);
                const float o2 = (acc[mt][4 * g + 2] * rstd * lg.z + __uint_as_float(pw.y << 16)) * __uint_as_float(gv.y << 16), o3 = (acc[mt][4 * g + 3] * rstd * lg.w + __uint_as_float(pw.y & 0xffff0000u)) * __uint_as_float(gv.y & 0xffff0000u);
                v2u ov; ov.x = pk2(o0, o1); ov.y = pk2(o2, o3); *(LAS v2u*)(stg + r32 * 72 + 32 * mt + 8 * g + 4 * hh) = ov; }
        LDS_WAIT();
        {
            const size_t rb = (size_t)(b * SEQ + 64 * c + n0) * 1024 + h * 64;
#pragma unroll
            for (int k = 0; k < 4; ++k) { const int p = lane + 64 * k, tk = p >> 3, c16 = p & 7; *(v4u*)(RY + rb + (size_t)tk * 1024 + c16 * 8) = *(const LAS v4u*)(stg + tk * 72 + c16 * 8); }
        }
        LDS_WAIT();
    }
}

constexpr int AT_LDK = 72, AT_LDV = 300, AT_VT = 288 * AT_LDK * 2;
DI void p2_attention_mfma(Frame& F, const Args& A) {
    LAS bf16* ostg = (LAS bf16*)(F.lds + 81920 + F.wave * 8192);
    LAS bf16* Ks = (LAS bf16*)F.lds; LAS bf16* Vt = (LAS bf16*)(F.lds + AT_VT);
    const bf16* Q = (const bf16*)(F.ws + WS_Q); const bf16* Kb = (const bf16*)(F.ws + WS_K); const bf16* Vb = (const bf16*)(F.ws + WS_V); bf16* AO = (bf16*)(F.ws + WS_AR);
    const int tid = F.tid, lane = F.lane, w = F.wave, r32 = lane & 31, hh = lane >> 5;
    for (int item = blockIdx.x; item < NB * 2 * (SEQ / 128); item += F.G) {
        const int b = item >> 7, kvh = (item >> 6) & 1, jb = item & 63, tok0 = 128 * (jb - 1);
        {
            v4u kvr[5], vvr[5];
#pragma unroll
            for (int u = 0; u < 5; ++u) { const int ch = tid + u * (NWAVES * 64), key = ch >> 3, c = ch & 7;
                const int tk = tok0 + key; int row = key < 256 ? (tk >= 0 ? b * SEQ + tk : -1) : (key < 272 ? M + key - 256 : -1);
                const unsigned msk = (unsigned)~(row >> 31); row = row < 0 ? 0 : row;
                kvr[u] = *(const v4u*)(Kb + (size_t)row * 128 + kvh * 64 + 8 * c); vvr[u] = *(const v4u*)(Vb + (size_t)row * 128 + kvh * 64 + 8 * c);
#pragma unroll
                for (int i = 0; i < 4; ++i) { kvr[u][i] &= msk; vvr[u][i] &= msk; } }
#pragma unroll
            for (int u = 0; u < 5; ++u) { const int ch = tid + u * (NWAVES * 64), key = ch >> 3, c = ch & 7;
                if (u < 4 || ch < 288 * 8) { *(LAS v4u*)(Ks + key * AT_LDK + 8 * c) = kvr[u];
#pragma unroll
                    for (int e2 = 0; e2 < 8; ++e2) Vt[(8 * c + e2) * AT_LDV + key] = (bf16)((e2 & 1) ? (vvr[u][e2 >> 1] >> 16) : (vvr[u][e2 >> 1] & 0xffffu)); } }
        }
        LDS_BARRIER();
        const int g = w & 3, qh = w >> 2, h = kvh * 4 + g;
        const float slope = exp2f(-(float)(h + 1)), sink = A.in[I_SINK][h];
#pragma unroll 1
        for (int qq = 0; qq < 2; ++qq) {
            const int qt = 2 * qh + qq, ql = 32 * qt + r32, t = 128 * jb + ql; const size_t row = (size_t)b * SEQ + t;
            bf16x8 qf[4];
#pragma unroll
            for (int ks = 0; ks < 4; ++ks) qf[ks] = *(const bf16x8*)(Q + row * 512 + h * 64 + 16 * ks + 8 * hh);
            f32x16 sc[6]; float mx = -INFINITY;
            const LAS bf16* kbase = Ks + (32 * qt + r32) * AT_LDK + 8 * hh; const LAS bf16* kmeta = Ks + (256 + r32) * AT_LDK + 8 * hh;
            const LAS bf16* vbase = Vt + r32 * AT_LDV + 32 * qt + 4 * hh; const LAS bf16* vmeta = Vt + r32 * AT_LDV + 256 + 4 * hh;
#pragma unroll
            for (int k6 = 0; k6 < 6; ++k6) { const int kta = k6 < 5 ? qt + k6 : 8; f32x16 acc = zero16(); const LAS bf16* kp = k6 < 5 ? kbase + 32 * k6 * AT_LDK : kmeta;
#pragma unroll
                for (int ks = 0; ks < 4; ++ks) { const bf16x8 a = *(const LAS bf16x8*)(kp + 16 * ks); acc = MFMA32(a, qf[ks], acc); }
#pragma unroll
                for (int i = 0; i < 16; ++i) { const int kr = 8 * (i >> 2) + 4 * hh + (i & 3); bool ok; float dist;
                    if (k6 < 5) { const int kb = 32 * kta + kr, diff = 128 + ql - kb; dist = (float)diff;
                        if (k6 >= 1 && k6 <= 3) ok = jb > 0 || tok0 + kb >= 0;
                        else ok = diff >= 0 && diff < 128 && tok0 + kb >= 0; }
                    else { const int dm = t + 16 - kr; ok = kr < 16; dist = (float)(dm < 128 ? dm : 128); }
                    const float v = ok ? acc[i] - slope * dist : -INFINITY; sc[k6][i] = v; mx = fmaxf(mx, v); } }
            mx = fmaxf(mx, __shfl_xor(mx, 32)); mx = fmaxf(mx, sink);
            float sum = 0.f;
#pragma unroll
            for (int k6 = 0; k6 < 6; ++k6)
#pragma unroll
                for (int i = 0; i < 16; ++i) { const float p = __expf(sc[k6][i] - mx); sc[k6][i] = p; sum += p; }
            sum += __shfl_xor(sum, 32); sum += __expf(sink - mx);
            const float inv = 1.0f / sum;
            f32x16 o[2]; o[0] = zero16(); o[1] = zero16();
#pragma unroll
            for (int k6 = 0; k6 < 6; ++k6) { const int kta = k6 < 5 ? qt + k6 : 8;
#pragma unroll
                for (int s = 0; s < 2; ++s) { v4u t4; t4.x = pk2(sc[k6][8 * s], sc[k6][8 * s + 1]); t4.y = pk2(sc[k6][8 * s + 2], sc[k6][8 * s + 3]); t4.z = pk2(sc[k6][8 * s + 4], sc[k6][8 * s + 5]); t4.w = pk2(sc[k6][8 * s + 6], sc[k6][8 * s + 7]);
                    const bf16x8 pb = __builtin_bit_cast(bf16x8, t4);
#pragma unroll
                    for (int dt = 0; dt < 2; ++dt) { const LAS bf16* vp = (k6 < 5 ? vbase + 32 * k6 : vmeta) + 32 * dt * AT_LDV + 16 * s; const v2u lo = *(const LAS v2u*)vp, hi = *(const LAS v2u*)(vp + 8);
                        v4u a4; a4.x = lo.x; a4.y = lo.y; a4.z = hi.x; a4.w = hi.y; o[dt] = MFMA32(__builtin_bit_cast(bf16x8, a4), pb, o[dt]); } } }
#pragma unroll
            for (int dt = 0; dt < 2; ++dt)
#pragma unroll
                for (int g4 = 0; g4 < 4; ++g4) { v2u ov; ov.x = pk2(o[dt][4 * g4] * inv, o[dt][4 * g4 + 1] * inv); ov.y = pk2(o[dt][4 * g4 + 2] * inv, o[dt][4 * g4 + 3] * inv);
                    *(LAS v2u*)(ostg + r32 * 72 + 32 * dt + 8 * g4 + 4 * hh) = ov; }
            LDS_WAIT();
            {
                const size_t rb = ((size_t)b * SEQ + 128 * jb + 32 * qt) * 1024 + h * 64;
#pragma unroll
                for (int k = 0; k < 4; ++k) { const int p = lane + 64 * k, tk = p >> 3, c16 = p & 7; *(v4u*)(AO + rb + (size_t)tk * 1024 + c16 * 8) = *(const LAS v4u*)(ostg + tk * 72 + c16 * 8); }
            }
            LDS_WAIT();
        }
        LDS_BARRIER();
    }
}
__global__ void __launch_bounds__(NWAVES * 64, 2) mk_fwd(Args args) {
    extern __shared__ __attribute__((aligned(16))) unsigned char lds[];
    Frame F;
    F.lds = (LAS unsigned char*)lds;
    F.tid = threadIdx.x; F.lane = F.tid & 63; F.wave = __builtin_amdgcn_readfirstlane(F.tid >> 6); F.G = gridDim.x;
    F.out = args.out; F.ws = args.ws; F.ctl = (unsigned*)(args.ws + WS_CTL);
    volatile LAS unsigned* MISC = (volatile LAS unsigned*)(F.lds + LDS_MISC);
    if (F.tid < 64) MISC[F.tid] = 0u;
    __syncthreads();
    const int lo = args.ph_lo, hi = args.ph_hi;
    XcdBarrier bar; bar.bar = (unsigned*)(F.ctl + CW_BAR); bar.x = 0; bar.st = nullptr;
    if (hi - lo > 1) bar = xcd_barrier_post((unsigned*)(F.ctl + CW_BAR), MISC + 8);
#ifdef ONLY_PHASE
#define IN(k) ((k) == ONLY_PHASE && lo <= (k) && (k) < hi)
#elif defined(SKIP_PHASE)
#define IN(k) ((k) != SKIP_PHASE && lo <= (k) && (k) < hi)
#else
#define IN(k) (lo <= (k) && (k) < hi)
#endif
#ifndef PROBE_MASK
#define PROBE_MASK 0
#endif
#define REPS(k) (1 + ((PROBE_MASK >> (k)) & 1))
#define SEAM(k) do { if (IN(k) && IN((k) + 1)) xcd_barrier(bar); } while (0)
#define LOCAL_SEAM(k) do { if (IN(k) && IN((k) + 1)) { asm volatile("s_waitcnt vmcnt(0)" ::: "memory"); __syncthreads(); __builtin_amdgcn_fence(__ATOMIC_ACQUIRE, "agent"); asm volatile("s_waitcnt vmcnt(0)" ::: "memory"); __syncthreads(); } } while (0)
    unsigned char* ws = args.ws;
    if (IN(0)) { _Pragma("unroll") for (int rep = 0; rep < REPS(0); ++rep) { p0_prologue(F, args); } SEAM(0); }
    if (IN(1)) {
        p1_meta_finish(F, args);
        pg8::Gemm g{(const pg8::bf16_t*)(ws + WS_XB), (const pg8::bf16_t*)(ws + WS_WIN), M, IN_COLS, D, 0}; pg8::StaticOrder S; S.init(M, IN_COLS, F.G, (int)blockIdx.x);
        pg8::EpiIn E{(bf16*)(ws + WS_Q), (bf16*)(ws + WS_K), (bf16*)(ws + WS_V), (bf16*)(ws + WS_RC), (bf16*)F.out};
        _Pragma("unroll") for (int rep = 0; rep < REPS(1); ++rep) { pg8::gemm_phase<pg8::EpiIn, pg8::StaticOrder, true, true>(F.lds, g, S, E); }
        SEAM(1);
    }
    if (IN(2)) { _Pragma("unroll") for (int rep = 0; rep < REPS(2); ++rep) { p2a_lora_inputs(F, args); p2_attention_mfma(F, args); } SEAM(2); }
    if (IN(3)) { _Pragma("unroll") for (int rep = 0; rep < REPS(3); ++rep) { p3_rwkv_chunk(F, args); } SEAM(3); }
    if (IN(4)) { _Pragma("unroll") for (int rep = 0; rep < REPS(4); ++rep) { if (F.G >= 2 * NB * 8 * 2) expert_weights(F, args, NB * 8 * 2); else { expert_weights(F, args, 0); LDS_BARRIER(); } p4_rwkv_chain(F, args); } SEAM(4); }
    if (IN(5)) { _Pragma("unroll") for (int rep = 0; rep < REPS(5); ++rep) { p5_rwkv_out(F, args); } LOCAL_SEAM(5); }
    if (IN(6)) {
        pg8::Gemm g{(const pg8::bf16_t*)(ws + WS_AR), (const pg8::bf16_t*)(ws + WS_WOA), M, D, D, 512}; pg8::PairOrder<pg8::PanelOrder> S; S.base.init(M, D, F.G, (int)blockIdx.x); S.koff_bytes = 1024;
        pg8::EpiGate2 E{(const bf16*)F.out, (bf16*)(ws + WS_MG)};
        _Pragma("unroll") for (int rep = 0; rep < REPS(6); ++rep) { pg8::gemm_phase<pg8::EpiGate2, pg8::PairOrder<pg8::PanelOrder>, true, true>(F.lds, g, S, E); }
        LOCAL_SEAM(6);
    }
    if (IN(7)) {
        pg8::Gemm g{(const pg8::bf16_t*)(ws + WS_MG), (const pg8::bf16_t*)(ws + WS_WOUT), M, D, D, 0}; pg8::PanelOrder S; S.init(M, D, F.G, (int)blockIdx.x);
        pg8::EpiRes E{args.in[I_X], (bf16*)(ws + WS_AR)};
        _Pragma("unroll") for (int rep = 0; rep < REPS(7); ++rep) { pg8::gemm_phase<pg8::EpiRes, pg8::PanelOrder, true, true>(F.lds, g, S, E); }
        LOCAL_SEAM(7);
    }
    if (IN(8)) { _Pragma("unroll") for (int rep = 0; rep < REPS(8); ++rep) { p8_router(F, args); } SEAM(8); }
    if (IN(9)) {
        const int TT = moe_table(F);
        const LAS int* tile_e = (const LAS int*)(F.lds + LDS_TBL); const LAS int* tb = tile_e + TT_MAX;
        LAS int* ldd = (LAS int*)(F.lds + 131072); LAS float* ldw = (LAS float*)(F.lds + 131072 + 8 * 1024);
        pg8::Gemm g{(const pg8::bf16_t*)(ws + WS_XN2), (const pg8::bf16_t*)(ws + WS_WGU), CAP, NE * 512, D, 0};
        pg8::GroupedOrder<true> S{tile_e, tb, TT, 2, F.G, (int)blockIdx.x, ldd, (unsigned)(D * 2)};
        { const int* LD = (const int*)(ws + WS_LISTD); const float* LW = (const float*)(ws + WS_LISTW);
          for (int idx = F.tid; idx < 8 * 256; idx += NWAVES * 64) { pg8::Unit u; const int i = idx >> 8, r = idx & 255;
              if (S.next(i, u)) { const int li = u.r0 + r; const bool ok = li < u.cnt; const int e = u.pn >> 1; ldd[idx] = ok ? LD[e * LCAP + li] : -1; ldw[idx] = ok ? LW[e * LCAP + li] : 0.f; } }
          __syncthreads(); }
        pg8::EpiSwiglu E{(bf16*)(ws + WS_HMID), ldd, ldw, (int*)(ws + WS_SLOTD)};
        _Pragma("unroll") for (int rep = 0; rep < REPS(9); ++rep) { pg8::gemm_phase<pg8::EpiSwiglu, pg8::GroupedOrder<true>, true, true>(F.lds, g, S, E); }
        SEAM(9);
    }
    if (IN(10)) {
        const int TT = moe_table(F);
        const LAS int* tile_e = (const LAS int*)(F.lds + LDS_TBL); const LAS int* tb = tile_e + TT_MAX;
        LAS int* lsl = (LAS int*)(F.lds + 131072);
        pg8::Gemm g{(const pg8::bf16_t*)(ws + WS_HMID), (const pg8::bf16_t*)(ws + WS_WDN), CAP, NE * 1024, 256, 0};
        pg8::GroupedOrder<false> S{tile_e, tb, TT, 4, F.G, (int)blockIdx.x, nullptr, 0u};
        { const int* SD = (const int*)(ws + WS_SLOTD);
          for (int idx = F.tid; idx < 12 * 256; idx += NWAVES * 64) { pg8::Unit u; const int i = idx >> 8, r = idx & 255; if (S.next(i, u)) lsl[idx] = SD[u.pm * 256 + r]; }
          __syncthreads(); }
        pg8::EpiDown E{(unsigned char*)(ws + WS_Y), lsl};
        _Pragma("unroll") for (int rep = 0; rep < REPS(10); ++rep) { pg8::gemm_phase<pg8::EpiDown, pg8::GroupedOrder<false>, true, true>(F.lds, g, S, E); }
        SEAM(10);
    }
    if (IN(11)) { _Pragma("unroll") for (int rep = 0; rep < REPS(11); ++rep) { p12_final(F, args); } }
#undef IN
#undef SEAM
}

extern "C" void kernel_launch(void* const* d_in, const int* in_sizes, int n_in, void* d_out, int out_size, void* d_ws, size_t ws_size, hipStream_t stream) {
    static int grid = 0;
    if (grid == 0) {
        if (n_in != 28 || in_sizes[0] != M * D || out_size != M * D || ws_size < WS_END) { fprintf(stderr, "kernel_launch: unexpected shapes (n_in %d, in0 %d, out %d, ws %zu)\n", n_in, n_in > 0 ? in_sizes[0] : -1, out_size, ws_size); grid = -1; return; }
        int dev = 0, cus = 0, per_cu = 0;
        if (hipGetDevice(&dev) != hipSuccess || hipDeviceGetAttribute(&cus, hipDeviceAttributeMultiprocessorCount, dev) != hipSuccess) { grid = -1; return; }
        if (hipFuncSetAttribute((const void*)mk_fwd, hipFuncAttributeMaxDynamicSharedMemorySize, LDS_BYTES) != hipSuccess) { fprintf(stderr, "kernel_launch: hipFuncSetAttribute failed\n"); grid = -1; return; }
        if (hipOccupancyMaxActiveBlocksPerMultiprocessor(&per_cu, (const void*)mk_fwd, NWAVES * 64, LDS_BYTES) != hipSuccess || per_cu < 1) fprintf(stderr, "kernel_launch: occupancy query reports %d\n", per_cu);
        (void)hipGetLastError();
        grid = cus;
    }
    if (grid < 0) return;
    if (hipMemsetAsync((char*)d_ws + WS_CTL, 0, CTL_ZERO_BYTES, stream) != hipSuccess) return;
    Args a{};
    for (int i = 0; i < 28; ++i) a.in[i] = (const float*)d_in[i];
    a.out = (float*)d_out; a.ws = (unsigned char*)d_ws;
#if MK_ONE_LAUNCH
    a.ph_lo = 0; a.ph_hi = N_PHASES; a.li = 0;
    hipLaunchKernelGGL(mk_fwd, dim3(grid), dim3(NWAVES * 64), LDS_BYTES, stream, a);
#else
    for (int p = 0; p < N_PHASES; ++p) { a.ph_lo = p; a.ph_hi = p + 1; a.li = p; hipLaunchKernelGGL(mk_fwd, dim3(grid), dim3(NWAVES * 64), LDS_BYTES, stream, a); }
#endif
}
```

```cpp
#include <hip/hip_runtime.h>
#include <cstdio>
#include <cstdint>
#define PROBE_MASK 0
namespace pg8 {
#define PG8_LAS __attribute__((address_space(3)))
typedef unsigned short bf16_t;
typedef short bf16x8 __attribute__((ext_vector_type(8)));
typedef float f32x4 __attribute__((ext_vector_type(4)));
typedef unsigned u32x4 __attribute__((ext_vector_type(4)));
constexpr int BM = 256, BK = 64, HALF = 128, HTB = HALF * BK * 2  , STAGE_BYTES = 8 * HTB, NXCD = 8, WGM = 8;

__host__ __device__ __forceinline__ int lds_byte(int r, int c) { const int st = (r >> 4) * 2 + (c >> 5), rr = r & 15, cc = c & 31, ob = rr * 64 + cc * 2; return st * 1024 + (ob ^ (((ob >> 9) & 1) << 5)); }
__host__ __device__ __forceinline__ void stage_rc(int b, int& R, int& C) { const int st = b / 1024, sb = b % 1024, swz = sb ^ (((sb >> 9) & 1) << 5); R = (st >> 1) * 16 + swz / 64; C = (st & 1) * 32 + (swz % 64) / 2; }
__host__ __device__ __forceinline__ int perm32(int rho) { const int n = rho >> 4, i = rho & 15; return 8 * (i >> 2) + 4 * n + (i & 3); }

struct Unit { int pm, pn, r0, cnt, ord; };
struct Gemm { const bf16_t* A; const bf16_t* Bt; int M, N, K, kext; };

struct StaticOrder {
    static constexpr bool GATHER = false;
    __device__ __forceinline__ unsigned a_off(const Unit&, int) const { return 0u; }
    __device__ __forceinline__ size_t koff(const Unit&) const { return 0; }
    __device__ __forceinline__ bool is_mid(const Unit&) const { return false; }
    int nM, nN, nwg, G, c;
    __host__ __device__ void init(int M, int N, int G_, int c_) { nM = M / BM; nN = N / BM; nwg = nM * nN; G = G_; c = c_; }
    __host__ __device__ bool next(int i, Unit& u) const {
        const long L = (long)i * G + c; if (L >= nwg) return false;
        int wgid = (int)L; { const int q = nwg / NXCD, r = nwg % NXCD, xcd = wgid % NXCD, off = wgid / NXCD; wgid = (xcd < r ? xcd * (q + 1) : r * (q + 1) + (xcd - r) * q) + off; }
        const int nig = WGM * nN, gid = wgid / nig, fm = gid * WGM, gsz = (nM - fm) < WGM ? (nM - fm) : WGM;
        u.pm = fm + ((wgid % nig) % gsz); u.pn = (wgid % nig) / gsz; u.r0 = 0; u.cnt = 0; u.ord = i; return true;
    }
    __device__ __forceinline__ void a_ready(const Unit&) const {}
    __device__ __forceinline__ void done(const Unit&) const {}
};

__device__ __forceinline__ unsigned cvt_pk_bf16(float lo, float hi) { unsigned r; asm volatile("v_cvt_pk_bf16_f32 %0, %1, %2" : "=v"(r) : "v"(lo), "v"(hi)); return r; }
typedef float f32x2 __attribute__((ext_vector_type(2)));

struct PanelOrder {
    static constexpr bool GATHER = false;
    int nM, nN, G, c;
    __host__ __device__ void init(int M, int N, int G_, int c_) { nM = M / BM; nN = N / BM; G = G_; c = c_; }
    __device__ __forceinline__ bool next(int i, Unit& u) const { const int p = c + (i / nN) * G; if (p >= nM) return false; u.pm = p; u.pn = i % nN; u.r0 = 0; u.cnt = 0; u.ord = i; return true; }
    __device__ __forceinline__ unsigned a_off(const Unit&, int) const { return 0u; }
    __device__ __forceinline__ size_t koff(const Unit&) const { return 0; }
    __device__ __forceinline__ bool is_mid(const Unit&) const { return false; }
    __device__ __forceinline__ void a_ready(const Unit&) const {}
    __device__ __forceinline__ void done(const Unit&) const {}
};
template <class Base> struct PairOrder {
    static constexpr bool GATHER = false;
    Base base; size_t koff_bytes;
    __device__ __forceinline__ bool next(int i, Unit& u) const { if (!base.next(i >> 1, u)) return false; u.r0 = i & 1; u.cnt = 0; u.ord = i; return true; }
    __device__ __forceinline__ unsigned a_off(const Unit&, int) const { return 0u; }
    __device__ __forceinline__ size_t koff(const Unit& u) const { return u.r0 ? koff_bytes : (size_t)0; }
    __device__ __forceinline__ bool is_mid(const Unit& u) const { return u.r0 == 0; }
    __device__ __forceinline__ void a_ready(const Unit&) const {}
    __device__ __forceinline__ void done(const Unit&) const {}
};
template <class Epi, class Sched, bool ALIGN_EPI = false, bool SP2 = false>
__device__ __forceinline__ void gemm_phase(PG8_LAS unsigned char* lds, const Gemm g, const Sched& S, const Epi& E) {
    const int tid = threadIdx.x, wid = __builtin_amdgcn_readfirstlane(tid >> 6), lane = tid & 63, wr = wid >> 2, wc = wid & 3, fr = lane & 15, fq = lane >> 4;
    const int K = g.K, nt = (g.kext ? g.kext : K) / BK;
    unsigned voffA[2], voffB[2];
#pragma unroll
    for (int i = 0; i < 2; ++i) { int R, C; stage_rc(tid * 16 + i * 8192, R, C); const int Rb = Epi::PERM ? ((R & ~31) + perm32(R & 31)) : R;
        voffA[i] = (unsigned)(R * K + C) * 2u; voffB[i] = (unsigned)(Rb * K + C) * 2u; }
    unsigned gAc[2][2], gAn[2][2]; int gR[2], gC[2];
#pragma unroll
    for (int i = 0; i < 2; ++i) { int R, C; stage_rc(tid * 16 + i * 8192, R, C); gR[i] = R; gC[i] = C * 2; gAc[0][i] = gAc[1][i] = gAn[0][i] = gAn[1][i] = 0u; }
    const size_t kstep = (size_t)(BK * 2);
    const size_t hstep = (size_t)HALF * K * 2;
    const size_t hstepA = Sched::GATHER ? (size_t)0 : hstep;
    const size_t tstep = 2 * hstep;
    const unsigned ldsw = (unsigned)wid * 1024u;
    const int aoff = lds_byte(wr * 64 + fr, fq * 8), boff = lds_byte(wc * 32 + fr, fq * 8);
#define PG8_SA(b, h) (((b) * 2 + (h)) * HTB)
#define PG8_SB(b, h) ((4 + (b) * 2 + (h)) * HTB)
#define PG8_STAGE(bufoff, gbase, voff) do { _Pragma("unroll") for (int _i = 0; _i < 2; ++_i) \
        __builtin_amdgcn_global_load_lds((const unsigned*)((const char*)(gbase) + (voff)[_i]), (PG8_LAS unsigned*)(lds + (bufoff) + ldsw + _i * 8192), 16, 0, 0); } while (0)
#define PG8_LDA(dst, b, h) do { _Pragma("unroll") for (int m = 0; m < 4; ++m) _Pragma("unroll") for (int k = 0; k < 2; ++k) dst[m][k] = *(const PG8_LAS bf16x8*)(lds + PG8_SA(b, h) + aoff + m * 2048 + k * 1024); } while (0)
#define PG8_LDB(dst, b, h) do { _Pragma("unroll") for (int n = 0; n < 2; ++n) _Pragma("unroll") for (int k = 0; k < 2; ++k) dst[n][k] = *(const PG8_LAS bf16x8*)(lds + PG8_SB(b, h) + boff + n * 2048 + k * 1024); } while (0)
#define PG8_MMA(ai, bj, At, Bt) do { __builtin_amdgcn_s_setprio(1); _Pragma("unroll") for (int m = 0; m < 4; ++m) _Pragma("unroll") for (int n = 0; n < 2; ++n) _Pragma("unroll") for (int k = 0; k < 2; ++k) \
        acc[ai][bj][m][n] = __builtin_amdgcn_mfma_f32_16x16x32_bf16(Bt[n][k], At[m][k], acc[ai][bj][m][n], 0, 0, 0); __builtin_amdgcn_s_setprio(0); } while (0)
#define PG8_WAIT_V(n) asm volatile("s_waitcnt vmcnt(" #n ")" ::: "memory")
#define PG8_WAIT_L(n) asm volatile("s_waitcnt lgkmcnt(" #n ")" ::: "memory")
#define PG8_BAR __builtin_amdgcn_s_barrier()
#define PG8_SCHED __builtin_amdgcn_sched_barrier(0)
    Unit cur, nxt; int ui = 0;
    if (!S.next(0, cur)) return;
    f32x4 acc[2][2][4][2];
#pragma unroll
    for (int a = 0; a < 2; ++a)
#pragma unroll
        for (int b = 0; b < 2; ++b)
#pragma unroll
            for (int m = 0; m < 4; ++m)
#pragma unroll
                for (int n = 0; n < 2; ++n) acc[a][b][m][n] = (f32x4){0.f, 0.f, 0.f, 0.f};
    bf16x8 At[4][2], B0[2][2], B1[2][2];
    const char* cA = (const char*)g.A + (Sched::GATHER ? (size_t)0 : (size_t)cur.pm * tstep) + S.koff(cur); const char* cB = (const char*)g.Bt + (size_t)cur.pn * tstep + S.koff(cur);
    if constexpr (Sched::GATHER) {
#pragma unroll
        for (int h = 0; h < 2; ++h)
#pragma unroll
            for (int i = 0; i < 2; ++i) gAc[h][i] = S.a_off(cur, h * HALF + gR[i]) + (unsigned)gC[i]; }
#define PG8_VA(sel, h) (Sched::GATHER ? (sel)[h] : voffA)
    S.a_ready(cur);
    if constexpr (SP2) {
        PG8_STAGE(PG8_SB(0, 0), cB, voffB); PG8_STAGE(PG8_SB(0, 1), cB + hstep, voffB); PG8_STAGE(PG8_SA(0, 0), cA, PG8_VA(gAc, 0)); PG8_STAGE(PG8_SA(0, 1), cA + hstepA, PG8_VA(gAc, 1));
        if (wr == 1) PG8_BAR;
        PG8_WAIT_V(2); PG8_BAR;
        PG8_STAGE(PG8_SB(1, 0), cB + kstep, voffB); PG8_STAGE(PG8_SA(1, 0), cA + kstep, PG8_VA(gAc, 0)); PG8_STAGE(PG8_SB(1, 1), cB + hstep + kstep, voffB);
        PG8_WAIT_V(6); PG8_BAR;
    } else {
        PG8_STAGE(PG8_SB(0, 0), cB, voffB); PG8_STAGE(PG8_SA(0, 0), cA, voffA); PG8_STAGE(PG8_SB(0, 1), cB + hstep, voffB); PG8_STAGE(PG8_SA(0, 1), cA + hstep, voffA);
        if (wr == 1) PG8_BAR;
        PG8_WAIT_V(4); PG8_BAR;
        PG8_STAGE(PG8_SB(1, 0), cB + kstep, voffB); PG8_STAGE(PG8_SA(1, 0), cA + kstep, voffA); PG8_STAGE(PG8_SB(1, 1), cB + hstep + kstep, voffB);
        PG8_WAIT_V(6); PG8_BAR;
    }
    for (;;) {
        const bool has_next = S.next(ui + 1, nxt);
        const char* nA = (has_next && !Sched::GATHER) ? (const char*)g.A + (size_t)nxt.pm * tstep + S.koff(nxt) : cA; const char* nB = has_next ? (const char*)g.Bt + (size_t)nxt.pn * tstep + S.koff(nxt) : cB;
        if constexpr (Sched::GATHER) {
#pragma unroll
            for (int h = 0; h < 2; ++h)
#pragma unroll
                for (int i = 0; i < 2; ++i) gAn[h][i] = has_next ? S.a_off(nxt, h * HALF + gR[i]) + (unsigned)gC[i] : gAc[h][i]; }
#pragma unroll 1
        for (int t = 0; t < nt; t += 2) {
            const bool last = (t == nt - 2);
            const char* a1 = cA + (size_t)(t + 1) * kstep;
            const char* a2 = last ? nA : cA + (size_t)(t + 2) * kstep; const char* b2 = last ? nB : cB + (size_t)(t + 2) * kstep;
            const char* a3 = a2 + kstep; const char* b3 = b2 + kstep;
            if (last && has_next) S.a_ready(nxt);
            unsigned g2[2][2];
#pragma unroll
            for (int h = 0; h < 2; ++h)
#pragma unroll
                for (int i = 0; i < 2; ++i) g2[h][i] = last ? gAn[h][i] : gAc[h][i];
            if constexpr (SP2) {
            PG8_LDB(B0, 0, 0); PG8_LDB(B1, 0, 1); PG8_SCHED; PG8_LDA(At, 0, 0); PG8_STAGE(PG8_SA(1, 1), a1 + hstepA, PG8_VA(gAc, 1));
            PG8_WAIT_V(8); PG8_WAIT_L(0); PG8_BAR; PG8_MMA(0, 0, At, B0); PG8_MMA(0, 1, At, B1); PG8_BAR; PG8_SCHED;
            PG8_LDA(At, 0, 1); PG8_STAGE(PG8_SB(0, 0), b2, voffB); PG8_STAGE(PG8_SB(0, 1), b2 + hstep, voffB); PG8_STAGE(PG8_SA(0, 0), a2, PG8_VA(g2, 0));
            PG8_WAIT_V(8); PG8_WAIT_L(0); PG8_BAR; PG8_MMA(1, 0, At, B0); PG8_MMA(1, 1, At, B1); PG8_BAR; PG8_SCHED;
            PG8_LDB(B0, 1, 0); PG8_LDB(B1, 1, 1); PG8_SCHED; PG8_LDA(At, 1, 0); PG8_STAGE(PG8_SA(0, 1), a2 + hstepA, PG8_VA(g2, 1));
            PG8_WAIT_V(8); PG8_WAIT_L(0); PG8_BAR; PG8_MMA(0, 0, At, B0); PG8_MMA(0, 1, At, B1); PG8_BAR; PG8_SCHED;
            PG8_LDA(At, 1, 1); PG8_STAGE(PG8_SB(1, 0), b3, voffB); PG8_STAGE(PG8_SB(1, 1), b3 + hstep, voffB); PG8_STAGE(PG8_SA(1, 0), a3, PG8_VA(g2, 0));
            PG8_WAIT_V(8); PG8_WAIT_L(0); PG8_BAR; PG8_MMA(1, 0, At, B0); PG8_MMA(1, 1, At, B1); PG8_BAR; PG8_SCHED;
            } else {
            PG8_LDB(B0, 0, 0); PG8_SCHED; PG8_LDA(At, 0, 0); PG8_STAGE(PG8_SA(1, 1), a1 + hstep, voffA);
            PG8_WAIT_L(8); PG8_BAR; PG8_WAIT_L(0); PG8_MMA(0, 0, At, B0); PG8_BAR; PG8_SCHED;
            PG8_LDB(B1, 0, 1); PG8_STAGE(PG8_SB(0, 0), b2, voffB);
            PG8_BAR; PG8_WAIT_L(0); PG8_MMA(0, 1, At, B1); PG8_BAR;
            PG8_LDA(At, 0, 1); PG8_STAGE(PG8_SA(0, 0), a2, voffA);
            PG8_BAR; PG8_WAIT_L(0); PG8_MMA(1, 0, At, B0); PG8_BAR; PG8_SCHED;
            PG8_STAGE(PG8_SB(0, 1), b2 + hstep, voffB);
            PG8_WAIT_V(6); PG8_BAR; PG8_MMA(1, 1, At, B1); PG8_BAR;
            PG8_LDB(B0, 1, 0); PG8_SCHED; PG8_LDA(At, 1, 0); PG8_STAGE(PG8_SA(0, 1), a2 + hstep, voffA);
            PG8_WAIT_L(8); PG8_BAR; PG8_WAIT_L(0); PG8_MMA(0, 0, At, B0); PG8_BAR; PG8_SCHED;
            PG8_LDB(B1, 1, 1); PG8_STAGE(PG8_SB(1, 0), b3, voffB);
            PG8_BAR; PG8_WAIT_L(0); PG8_MMA(0, 1, At, B1); PG8_BAR;
            PG8_LDA(At, 1, 1); PG8_STAGE(PG8_SA(1, 0), a3, voffA);
            PG8_BAR; PG8_WAIT_L(0); PG8_MMA(1, 0, At, B0); PG8_BAR; PG8_SCHED;
            PG8_STAGE(PG8_SB(1, 1), b3 + hstep, voffB);
            PG8_WAIT_V(6); PG8_BAR; PG8_MMA(1, 1, At, B1); PG8_BAR;
            }
        }
        if constexpr (ALIGN_EPI) { if (wr == 0) PG8_BAR; }
        bool keep_acc = false;
        if constexpr (Epi::MIDK) { if (S.is_mid(cur)) { E.mid(acc, cur, wr, wc, fr, fq); keep_acc = true; } else E(acc, cur, wr, wc, fr, fq); }
        else if constexpr (!Epi::AFTER_DRAIN) { E(acc, cur, wr, wc, fr, fq);
#ifdef PROBE_EPI2
            if constexpr (Epi::PROBE2) { asm volatile("" ::: "memory"); E(acc, cur, wr, wc, fr, fq); }
#endif
            S.done(cur); }
        if (!has_next) break;
        if (!keep_acc)
#pragma unroll
        for (int a = 0; a < 2; ++a)
#pragma unroll
            for (int b = 0; b < 2; ++b)
#pragma unroll
                for (int m = 0; m < 4; ++m)
#pragma unroll
                    for (int n = 0; n < 2; ++n) acc[a][b][m][n] = (f32x4){0.f, 0.f, 0.f, 0.f};
        cur = nxt; cA = nA; cB = nB; ++ui;
        if constexpr (Sched::GATHER) {
#pragma unroll
            for (int h = 0; h < 2; ++h)
#pragma unroll
                for (int i = 0; i < 2; ++i) gAc[h][i] = gAn[h][i]; }
        if constexpr (ALIGN_EPI) { if (wr == 1) PG8_BAR; }
    }
    PG8_WAIT_V(0);
    if constexpr (!ALIGN_EPI) { if (wr == 0) PG8_BAR; }
    PG8_BAR;
    if constexpr (Epi::AFTER_DRAIN) { E.fused(acc, cur, wr, wc, fr, fq, lds, wid, lane); S.done(cur); }
#undef PG8_SA
#undef PG8_VA
#undef PG8_SB
#undef PG8_STAGE
#undef PG8_LDA
#undef PG8_LDB
#undef PG8_MMA
#undef PG8_WAIT_V
#undef PG8_WAIT_L
#undef PG8_BAR
#undef PG8_SCHED
}

__device__ __forceinline__ float sigm(float x) { return __builtin_amdgcn_rcpf(1.0f + __builtin_amdgcn_exp2f(-1.44269504089f * x)); }
__device__ __forceinline__ f32x4 up_lo(u32x4 w) { f32x4 r; r[0] = __uint_as_float(w[0] << 16); r[1] = __uint_as_float(w[0] & 0xffff0000u); r[2] = __uint_as_float(w[1] << 16); r[3] = __uint_as_float(w[1] & 0xffff0000u); return r; }
__device__ __forceinline__ f32x4 up_hi(u32x4 w) { f32x4 r; r[0] = __uint_as_float(w[2] << 16); r[1] = __uint_as_float(w[2] & 0xffff0000u); r[2] = __uint_as_float(w[3] << 16); r[3] = __uint_as_float(w[3] & 0xffff0000u); return r; }
__device__ __forceinline__ u32x4 pack8(f32x4 v0, f32x4 v1) { u32x4 w; w.x = cvt_pk_bf16(v0[0], v0[1]); w.y = cvt_pk_bf16(v0[2], v0[3]); w.z = cvt_pk_bf16(v1[0], v1[1]); w.w = cvt_pk_bf16(v1[2], v1[3]); return w; }

struct EpiIn {
    static constexpr bool PERM = true, AFTER_DRAIN = false, MIDK = false, PROBE2 = true;
    bf16_t *Q, *Kb, *Vb, *RC, *G;
    __device__ __forceinline__ void operator()(const f32x4 (&acc)[2][2][4][2], const Unit& u, int wr, int wc, int fr, int fq) const {
        const int row0 = u.pm * BM + wr * 64 + fr, cl = wc * 32 + 8 * fq;
        bf16_t* b0; bf16_t* b1; int ld; const int pn = u.pn;
        if (pn < 2) { ld = 512; b0 = Q + pn * 256 + cl; b1 = b0 + 128; }
        else if (pn == 2) { ld = 128; b0 = Kb + cl; b1 = Vb + cl; }
        else if (pn < 10) { ld = 1792; b0 = RC + (pn - 3) * 256 + cl; b1 = b0 + 128; }
        else { ld = 2048; b0 = G + (pn - 10) * 128 + cl; b1 = b0 + 1024; }
        const bool sg = pn >= 10;
#pragma unroll
        for (int ai = 0; ai < 2; ++ai)
#pragma unroll
            for (int m = 0; m < 4; ++m) { const int row = row0 + ai * HALF + m * 16;
                f32x4 a0 = acc[ai][0][m][0], a1 = acc[ai][0][m][1], c0 = acc[ai][1][m][0], c1 = acc[ai][1][m][1];
                if (sg) {
#pragma unroll
                    for (int j = 0; j < 4; ++j) { const float ea0 = __builtin_amdgcn_exp2f(-1.44269504089f * a0[j]), ea1 = __builtin_amdgcn_exp2f(-1.44269504089f * a1[j]), eb0 = __builtin_amdgcn_exp2f(-1.44269504089f * c0[j]), eb1 = __builtin_amdgcn_exp2f(-1.44269504089f * c1[j]);
                        a0[j] = (1.0f + eb0) * __builtin_amdgcn_rcpf(1.0f + ea0); a1[j] = (1.0f + eb1) * __builtin_amdgcn_rcpf(1.0f + ea1); c0[j] = __builtin_amdgcn_rcpf(1.0f + eb0); c1[j] = __builtin_amdgcn_rcpf(1.0f + eb1); } }
                *(u32x4*)(b0 + (size_t)row * ld) = pack8(a0, a1); *(u32x4*)(b1 + (size_t)row * ld) = pack8(c0, c1); }
    }
};
struct EpiGate2 {
    static constexpr bool PERM = true, AFTER_DRAIN = false, MIDK = true;
    const bf16_t* G; bf16_t* O;
    __device__ __forceinline__ void mid(f32x4 (&acc)[2][2][4][2], const Unit& u, int wr, int wc, int fr, int fq) const {
        const int row0 = u.pm * BM + wr * 64 + fr, col0 = u.pn * BM + wc * 32 + 8 * fq;
        u32x4 g0w[2][4][2];
#pragma unroll
        for (int ai = 0; ai < 2; ++ai)
#pragma unroll
            for (int m = 0; m < 4; ++m)
#pragma unroll
                for (int bj = 0; bj < 2; ++bj) g0w[ai][m][bj] = *(const u32x4*)(G + (size_t)(row0 + ai * HALF + m * 16) * 2048 + col0 + bj * HALF);
#pragma unroll
        for (int ai = 0; ai < 2; ++ai)
#pragma unroll
            for (int m = 0; m < 4; ++m)
#pragma unroll
                for (int bj = 0; bj < 2; ++bj)
#pragma unroll
                    for (int j = 0; j < 4; ++j) { const unsigned gn = g0w[ai][m][bj][j];
                        acc[ai][bj][m][j >> 1][2 * (j & 1)] *= __uint_as_float(gn << 16); acc[ai][bj][m][j >> 1][2 * (j & 1) + 1] *= __uint_as_float(gn & 0xffff0000u); }
    }
    __device__ __forceinline__ void operator()(const f32x4 (&acc)[2][2][4][2], const Unit& u, int wr, int wc, int fr, int fq) const {
        const int row0 = u.pm * BM + wr * 64 + fr, col0 = u.pn * BM + wc * 32 + 8 * fq;
        u32x4 gw[2][4][2];
#pragma unroll
        for (int ai = 0; ai < 2; ++ai)
#pragma unroll
            for (int m = 0; m < 4; ++m)
#pragma unroll
                for (int bj = 0; bj < 2; ++bj) gw[ai][m][bj] = *(const u32x4*)(G + (size_t)(row0 + ai * HALF + m * 16) * 2048 + 1024 + col0 + bj * HALF);
#pragma unroll
        for (int ai = 0; ai < 2; ++ai)
#pragma unroll
            for (int m = 0; m < 4; ++m)
#pragma unroll
                for (int bj = 0; bj < 2; ++bj) *(u32x4*)(O + (size_t)(row0 + ai * HALF + m * 16) * 1024 + col0 + bj * HALF) = pack8(acc[ai][bj][m][0] * up_lo(gw[ai][m][bj]), acc[ai][bj][m][1] * up_hi(gw[ai][m][bj]));
    }
};
struct EpiRes {
    static constexpr bool PERM = true, AFTER_DRAIN = false, MIDK = false, PROBE2 = false;
    const float* X; bf16_t* O;
    __device__ __forceinline__ void operator()(const f32x4 (&acc)[2][2][4][2], const Unit& u, int wr, int wc, int fr, int fq) const {
        const int row0 = u.pm * BM + wr * 64 + fr, col0 = u.pn * BM + wc * 32 + 8 * fq;
#pragma unroll
        for (int ai = 0; ai < 2; ++ai) { f32x4 xv[4][2][2];
#pragma unroll
            for (int m = 0; m < 4; ++m)
#pragma unroll
                for (int bj = 0; bj < 2; ++bj)
#pragma unroll
                    for (int n = 0; n < 2; ++n) xv[m][bj][n] = *(const f32x4*)(X + (size_t)(row0 + ai * HALF + m * 16) * 1024 + col0 + bj * HALF + 4 * n);
#pragma unroll
            for (int m = 0; m < 4; ++m)
#pragma unroll
                for (int bj = 0; bj < 2; ++bj) *(u32x4*)(O + (size_t)(row0 + ai * HALF + m * 16) * 1024 + col0 + bj * HALF) = pack8(xv[m][bj][0] + acc[ai][bj][m][0], xv[m][bj][1] + acc[ai][bj][m][1]);
            asm volatile("" ::: "memory"); }
    }
};
template <bool GATHER_> struct GroupedOrder {
    static constexpr bool GATHER = GATHER_;
    const PG8_LAS int* tile_e; const PG8_LAS int* tb; int ntiles, ntn, G, c; const PG8_LAS int* lds_d; unsigned rowbytes;
    __device__ __forceinline__ bool next(int i, Unit& u) const {
        const int L = i * G + c; if (L >= ntiles * ntn) return false;
        const int mt = L / ntn, nl = L - mt * ntn; const int e = __builtin_amdgcn_readfirstlane(tile_e[mt]);
        u.pm = mt; u.pn = e * ntn + nl; u.r0 = __builtin_amdgcn_readfirstlane((mt - tb[e]) * BM); u.cnt = __builtin_amdgcn_readfirstlane(tb[33 + e]); u.ord = i; return true;
    }
    __device__ __forceinline__ unsigned a_off(const Unit& u, int r) const {
        const int d = lds_d[u.ord * BM + r]; const int tok = d >= 0 ? (d >> 1) : 0;
        return (unsigned)tok * rowbytes;
    }
    __device__ __forceinline__ size_t koff(const Unit&) const { return 0; }
    __device__ __forceinline__ bool is_mid(const Unit&) const { return false; }
    __device__ __forceinline__ void a_ready(const Unit&) const {}
    __device__ __forceinline__ void done(const Unit&) const {}
};
struct EpiSwiglu {
    static constexpr bool PERM = true, AFTER_DRAIN = false, MIDK = false, PROBE2 = false;
    bf16_t* H; const PG8_LAS int* lds_d; const PG8_LAS float* lds_w; const PG8_LAS float* lds_r; int* slot_dst;
    __device__ __forceinline__ void operator()(const f32x4 (&acc)[2][2][4][2], const Unit& u, int wr, int wc, int fr, int fq) const {
        const int rl0 = wr * 64 + fr, row0 = u.pm * BM + rl0, col0 = (u.pn & 1) * 128 + wc * 32 + 8 * fq;
        const bool slots = (u.pn & 1) == 0 && wc == 0 && fq == 0;
        int ld8[2][4]; float lw8[2][4], lr8[2][4];
#pragma unroll
        for (int ai = 0; ai < 2; ++ai)
#pragma unroll
            for (int m = 0; m < 4; ++m) { const int rl = u.ord * BM + rl0 + ai * HALF + m * 16; ld8[ai][m] = lds_d[rl]; lw8[ai][m] = lds_w[rl]; lr8[ai][m] = lds_r[rl]; }
        if (slots) {
#pragma unroll
            for (int ai = 0; ai < 2; ++ai)
#pragma unroll
                for (int m = 0; m < 4; ++m) slot_dst[row0 + ai * HALF + m * 16] = ld8[ai][m]; }
#pragma unroll
        for (int ai = 0; ai < 2; ++ai)
#pragma unroll
            for (int m = 0; m < 4; ++m) { const int row = row0 + ai * HALF + m * 16;
                if (ld8[ai][m] >= 0) { f32x4 v0, v1; const float w = lw8[ai][m], rs = lr8[ai][m];
#pragma unroll
                    for (int j = 0; j < 4; ++j) { const float g0 = acc[ai][0][m][0][j], g1 = acc[ai][0][m][1][j]; v0[j] = w * g0 * sigm(rs * g0) * acc[ai][1][m][0][j]; v1[j] = w * g1 * sigm(rs * g1) * acc[ai][1][m][1][j]; }
                    *(u32x4*)(H + (size_t)row * 256 + col0) = pack8(v0, v1); } }
    }
};
struct EpiDown {
    static constexpr bool PERM = true, AFTER_DRAIN = false, MIDK = false, PROBE2 = false;
    unsigned char* Y; const PG8_LAS int* lds_slot;
    __device__ __forceinline__ static unsigned pk4(float a, float b, float c, float d) { int w = 0; w = __builtin_amdgcn_cvt_pk_fp8_f32(a * 16.f, b * 16.f, w, false); w = __builtin_amdgcn_cvt_pk_fp8_f32(c * 16.f, d * 16.f, w, true); return (unsigned)w; }
    __device__ __forceinline__ void operator()(const f32x4 (&acc)[2][2][4][2], const Unit& u, int wr, int wc, int fr, int fq) const {
        const int row0 = u.pm * BM + wr * 64 + fr, col0 = (u.pn & 3) * 256 + wc * 32 + 8 * fq;
        int dsts[2][4];
#pragma unroll
        for (int ai = 0; ai < 2; ++ai)
#pragma unroll
            for (int m = 0; m < 4; ++m) dsts[ai][m] = lds_slot[u.ord * BM + wr * 64 + fr + ai * HALF + m * 16];
        typedef unsigned u32x2 __attribute__((ext_vector_type(2)));
#pragma unroll
        for (int ai = 0; ai < 2; ++ai)
#pragma unroll
            for (int m = 0; m < 4; ++m) { const int dst = dsts[ai][m];
                if (dst >= 0) {
#pragma unroll
                    for (int bj = 0; bj < 2; ++bj) { const f32x4 v0 = acc[ai][bj][m][0], v1 = acc[ai][bj][m][1]; u32x2 w; w.x = pk4(v0[0], v0[1], v0[2], v0[3]); w.y = pk4(v1[0], v1[1], v1[2], v1[3]);
                        *(u32x2*)(Y + (size_t)dst * 1024 + col0 + bj * HALF) = w; } } }
    }
};
}

constexpr int NWAVES = 8;
constexpr int D = 1024, NB = 8, SEQ = 8192, M = NB * SEQ, NMETA = 16, MV = M + NMETA;
constexpr int IN_COLS = 4608, RCW = 1792;
constexpr int NE = 32, TT_MAX = 544, CAP = TT_MAX * 256, LCAP = 65536;
constexpr int N_PHASES = 12;
#ifndef MK_ONE_LAUNCH
#define MK_ONE_LAUNCH 1
#endif

constexpr size_t MiB = 1u << 20;
constexpr size_t WS_CTL = 0, CTL_ZERO_BYTES = 96 * 1024;
constexpr size_t WS_RSTD = 1 * MiB, WS_METAP = 1 * MiB + 512 * 1024, WS_SLOTD = 3 * MiB, WS_SLOTW = 4 * MiB;
constexpr size_t WS_WIN = 6 * MiB, WS_WOA = 15 * MiB, WS_WOR = 16 * MiB, WS_WOUT = 17 * MiB, WS_WGU = 19 * MiB, WS_WDN = 51 * MiB;
constexpr size_t WS_LISTD = 68 * MiB, WS_LISTW = 76 * MiB, WS_LISTR = 84 * MiB;
constexpr size_t WS_XB = 96 * MiB, WS_Q = 224 * MiB, WS_K = 288 * MiB, WS_V = 305 * MiB, WS_RC = 352 * MiB, WS_AR = 96 * MiB;
constexpr size_t WS_GB = 224 * MiB, WS_POST = 288 * MiB, WS_MG = 416 * MiB;
constexpr size_t WS_XN2 = 96 * MiB, WS_XG = 224 * MiB, WS_HMID = 496 * MiB, WS_Y = 611 * MiB, WS_END = 1024 * MiB;
static_assert(WS_Y + (size_t)2 * M * D * 2 <= WS_END && WS_HMID + (size_t)CAP * 256 * 2 <= 611 * MiB && WS_RC + (size_t)MV * RCW * 2 <= 611 * MiB, "ws map");
constexpr int CW_BAR = 4096;
constexpr int CW_GCNT = 16384;

constexpr int LDS_BYTES = 163840;
constexpr int LDS_RT = 147456, LDS_TBL = 159744, LDS_MISC = 163328;

#define LAS __attribute__((address_space(3)))
typedef unsigned short bf16;
typedef unsigned v4u __attribute__((ext_vector_type(4)));
typedef unsigned v2u __attribute__((ext_vector_type(2)));
typedef float f32x4 __attribute__((ext_vector_type(4)));
#define DI __device__ __forceinline__
#define LDS_WAIT() asm volatile("s_waitcnt lgkmcnt(0)" ::: "memory")
#define LDS_BARRIER() asm volatile("s_waitcnt lgkmcnt(0)\n\ts_barrier" ::: "memory")
typedef float f32x2_t __attribute__((ext_vector_type(2)));
typedef __bf16 bf16x2_t __attribute__((ext_vector_type(2)));
DI unsigned pk2(float lo, float hi) { const f32x2_t v = {lo, hi}; const bf16x2_t b = __builtin_convertvector(v, bf16x2_t); return __builtin_bit_cast(unsigned, b); }
DI unsigned f2bf(float f) { return pk2(f, 0.f) & 0xffffu; }
DI float bf2f(bf16 b) { return __uint_as_float((unsigned)b << 16); }
DI float wave_sum(float v) {
#pragma unroll
    for (int o = 1; o < 64; o <<= 1) v += __shfl_xor(v, o);
    return v;
}
DI float wave_max(float v) {
#pragma unroll
    for (int o = 1; o < 64; o <<= 1) v = fmaxf(v, __shfl_xor(v, o));
    return v;
}
DI float sigmoid_f(float x) { return __builtin_amdgcn_rcpf(1.0f + __builtin_amdgcn_exp2f(-1.44269504089f * x)); }

#define XB_TMO      128
#define XB_XCNT(j)  (256  + 64 * (j))
#define XB_XSUB(j)  (1280 + 64 * (j))
#define XB_XGEN(j)  (2304 + 64 * (j))
#define XB_TOP      3328
#define XB_TOPGEN   3392
#define XCD_BAR_WORDS 3456
#define XB_SPIN_CAP (1u << 20)
DI unsigned xb_ld(unsigned* p)              { return __hip_atomic_load(p, __ATOMIC_RELAXED, __HIP_MEMORY_SCOPE_AGENT); }
DI unsigned xb_add(unsigned* p, unsigned v) { return __hip_atomic_fetch_add(p, v, __ATOMIC_RELAXED, __HIP_MEMORY_SCOPE_AGENT); }
DI unsigned xb_xcc_id() { return (unsigned)__builtin_amdgcn_s_getreg((3 << 11) | 20) & 0xFu; }
#define XB_SPIN(cond, bar) do { unsigned _sp = 0; while (cond) { __builtin_amdgcn_s_sleep(1); \
    if ((++_sp & 255u) == 0u) { if (xb_ld(&(bar)[XB_TMO])) break; if (_sp > XB_SPIN_CAP) { atomicAdd(&(bar)[XB_TMO], 1u); break; } } } } while (0)
struct XcdBarrier { unsigned* bar; unsigned x; volatile LAS unsigned* st; };
DI XcdBarrier xcd_barrier_post(unsigned* bar, volatile LAS unsigned* st) {
    XcdBarrier b; b.bar = bar; b.x = xb_xcc_id(); b.st = st;
    if (threadIdx.x == 0) (void)xb_add(&bar[XB_XCNT(b.x)], 1u);
    return b;
}
DI void xcd_barrier_complete(unsigned* bar, unsigned x, unsigned& nloc, unsigned& nx) {
    const unsigned G = gridDim.x * gridDim.y * gridDim.z;
    unsigned sum, cnt, mine, sp = 0u;
    for (;;) {
        sum = 0u; cnt = 0u; mine = 0u;
#pragma unroll
        for (unsigned j = 0; j < 16; ++j) { const unsigned c = xb_ld(&bar[XB_XCNT(j)]); sum += c; cnt += (c > 0u) ? 1u : 0u; mine = (j == x) ? c : mine; }
        if (sum == G) break;
        __builtin_amdgcn_s_sleep(1);
        if ((++sp & 255u) == 0u) { if (xb_ld(&bar[XB_TMO])) break; if (sp > XB_SPIN_CAP) { atomicAdd(&bar[XB_TMO], 1u); break; } }
    }
    nloc = mine > 0u ? mine : 1u; nx = cnt > 0u ? cnt : 1u;
}
DI void xcd_barrier(const XcdBarrier& b) {
    asm volatile("s_waitcnt vmcnt(0)" ::: "memory");
    __syncthreads();
    if (threadIdx.x == 0) {
        unsigned* bar = b.bar;
        __builtin_amdgcn_s_waitcnt(0);
        unsigned nloc = b.st[0], nx = b.st[1];
        if (nloc == 0u) { xcd_barrier_complete(bar, b.x, nloc, nx); b.st[0] = nloc; b.st[1] = nx; }
        const unsigned old = xb_add(&bar[XB_XSUB(b.x)], 1u);
        const unsigned gen = old / nloc;
        if (old + 1u == (gen + 1u) * nloc) {
            __builtin_amdgcn_fence(__ATOMIC_RELEASE, "agent");
            asm volatile("s_waitcnt vmcnt(0)" ::: "memory");
            const unsigned og = xb_add(&bar[XB_TOP], 1u);
            const unsigned tg = og / nx;
            if (og + 1u == (tg + 1u) * nx) xb_add(&bar[XB_TOPGEN], 1u);
            else XB_SPIN(xb_ld(&bar[XB_TOPGEN]) == tg, bar);
            __builtin_amdgcn_fence(__ATOMIC_ACQUIRE, "agent");
            xb_add(&bar[XB_XGEN(b.x)], 1u);
            asm volatile("s_waitcnt vmcnt(0)" ::: "memory");
        } else {
            XB_SPIN(xb_ld(&bar[XB_XGEN(b.x)]) == gen, bar);
            __builtin_amdgcn_fence(__ATOMIC_ACQUIRE, "agent");
            asm volatile("s_waitcnt vmcnt(0)" ::: "memory");
        }
    }
    __syncthreads();
}

struct Args { const float* in[28]; float* out; unsigned char* ws; int ph_lo, ph_hi, li, pad; };
struct Frame {
    LAS unsigned char* lds;
    unsigned* ctl;
    int tid, lane, wave, G;
    float* out; unsigned char* ws;
};
enum { I_X = 0, I_META, I_NMG, I_WIN, I_MU, I_W0, I_WD, I_A0, I_WA, I_WG, I_KK, I_KA, I_RK, I_LNG, I_LNB, I_SINK, I_WOA, I_WOR, I_WOUT, I_NFG, I_WGRP, I_BGRP, I_WEXP, I_BEXP, I_EG, I_EU, I_ED, I_NFIN };

DI void transpose_item(const float* W, int ldw, int K, bf16* WT, int k0, int n0, int drow0, const float* kscale, float nscale, LAS float* scr, int lane) {
    float wv[32];
#pragma unroll
    for (int i = 0; i < 32; ++i) { const int kk = 2 * i + (lane >> 5); wv[i] = W[(size_t)(k0 + kk) * ldw + n0 + (lane & 31)]; }
#pragma unroll
    for (int i = 0; i < 32; ++i) { const int kk = 2 * i + (lane >> 5); float v = wv[i]; if (kscale) v *= kscale[k0 + kk]; scr[kk * 33 + (lane & 31)] = v * nscale; }
    LDS_WAIT(); asm volatile("" ::: "memory");
    const int c = lane & 7;
#pragma unroll
    for (int j = 0; j < 4; ++j) { const int n = (lane >> 3) + 8 * j; const LAS float* s = scr + (8 * c) * 33 + n;
        v4u o; o.x = pk2(s[0 * 33], s[1 * 33]); o.y = pk2(s[2 * 33], s[3 * 33]); o.z = pk2(s[4 * 33], s[5 * 33]); o.w = pk2(s[6 * 33], s[7 * 33]);
        *(v4u*)(WT + (size_t)(drow0 + n) * K + k0 + 8 * c) = o; }
    LDS_WAIT(); asm volatile("" ::: "memory");
}
DI void expert_weights(Frame& F, const Args& A, int wg0) {
    if ((int)blockIdx.x < wg0) return;
    LAS float* scr = (LAS float*)(F.lds + F.wave * 16384);
    unsigned char* ws = F.ws;
    constexpr int I_G = 32 * 16 * 8, I_U = I_G, I_DN = 32 * 4 * 32;
    const int gw = ((int)blockIdx.x - wg0) * NWAVES + F.wave, NGW = (F.G - wg0) * NWAVES;
    for (int it = gw; it < I_G + I_U + I_DN; it += NGW) {
        int r = it;
        if (r < I_G + I_U) { const int up = r >= I_G; if (up) r -= I_G; const int e = r / 128, q = r % 128, kb = q / 8, nb = q % 8, n0 = 32 * nb;
            transpose_item(A.in[up ? I_EU : I_EG] + (size_t)e * 1024 * 256, 256, 1024, (bf16*)(ws + WS_WGU), 64 * kb, n0, e * 512 + (n0 >> 7) * 256 + up * 128 + (n0 & 127), A.in[I_NFG], 1.0f, scr, F.lane); continue; } r -= I_G + I_U;
        { const int e = r / 128, q = r % 128, kb = q / 32, nb = q % 32; transpose_item(A.in[I_ED] + (size_t)e * 256 * 1024, 1024, 256, (bf16*)(ws + WS_WDN), 64 * kb, 32 * nb, e * 1024 + 32 * nb, nullptr, 1.0f, scr, F.lane); }
    }
}
DI void p0_prologue(Frame& F, const Args& A) {
    LAS float* scr = (LAS float*)(F.lds + F.wave * 16384);
    const int gw = blockIdx.x * NWAVES + F.wave, NGW = F.G * NWAVES;
    unsigned char* ws = F.ws;
    constexpr int I_IN = 16 * 144, I_OA = 8 * 32, I_OR = 8 * 32, I_OUT = 16 * 32, I_LD = 16, I_LA = 16, I_LG = 32;
    constexpr int NITEMS = I_IN + I_OA + I_OR + I_OUT + I_LD + I_LA + I_LG;
    for (int it = gw; it < NITEMS; it += NGW) {
        int r = it;
        if (r < I_IN) { const int kb = r / 144, nb = r % 144, n0 = 32 * nb; int dr = n0;
            if (n0 >= 2560) { const int ng = n0 - 2560, which = ng >> 10, c = ng & 1023; dr = 2560 + (c >> 7) * 256 + which * 128 + (c & 127); }
            transpose_item(A.in[I_WIN], IN_COLS, 1024, (bf16*)(ws + WS_WIN), 64 * kb, n0, dr, A.in[I_NMG], nb < 16 ? 0.125f : 1.0f, scr, F.lane); continue; } r -= I_IN;
        if (r < I_OA) { const int kb = r / 32, nb = r % 32; transpose_item(A.in[I_WOA], 1024, 1024, (bf16*)(ws + WS_WOA), 64 * kb, 32 * nb, 32 * nb, nullptr, 1.0f, scr, F.lane); continue; } r -= I_OA;
        if (r < I_OR) { const int kb = r / 32, nb = r % 32; transpose_item(A.in[I_WOR], 1024, 1024, (bf16*)(ws + WS_WOA) + 512, 64 * kb, 32 * nb, 32 * nb, nullptr, 1.0f, scr, F.lane); continue; } r -= I_OR;
        if (r < I_OUT) { const int kb = r / 32, nb = r % 32; transpose_item(A.in[I_WOUT], 1024, 1024, (bf16*)(ws + WS_WOUT), 64 * kb, 32 * nb, 32 * nb, nullptr, 1.0f, scr, F.lane); continue; } r -= I_OUT;
        if (r < I_LD) { transpose_item(A.in[I_WD], 512, 64, (bf16*)(ws + 5 * MiB), 0, 32 * r, 32 * r, nullptr, 1.0f, scr, F.lane); continue; } r -= I_LD;
        if (r < I_LA) { transpose_item(A.in[I_WA], 512, 64, (bf16*)(ws + 5 * MiB) + 512 * 64, 0, 32 * r, 32 * r, nullptr, 1.0f, scr, F.lane); continue; } r -= I_LA;
        { const int kb = r / 16, nb = r % 16; transpose_item(A.in[I_WG], 512, 128, (bf16*)(ws + 5 * MiB) + 2 * 512 * 64, 64 * kb, 32 * nb, 32 * nb, nullptr, 1.0f, scr, F.lane); }
    }
    {
        bf16* XB = (bf16*)(ws + WS_XB);
        for (int m0 = gw; m0 < M; m0 += 4 * NGW) {
            f32x4 v[4][4];
#pragma unroll
            for (int q = 0; q < 4; ++q) { const int m = m0 + q * NGW < M ? m0 + q * NGW : m0; const f32x4* xr = (const f32x4*)(A.in[I_X] + (size_t)m * D) + F.lane;
#pragma unroll
                for (int j = 0; j < 4; ++j) v[q][j] = xr[64 * j]; }
#pragma unroll
            for (int q = 0; q < 4; ++q) { const int m = m0 + q * NGW; if (m < M) { float s = 0.f;
#pragma unroll
                for (int j = 0; j < 4; ++j) s += (v[q][j].x * v[q][j].x + v[q][j].y * v[q][j].y) + (v[q][j].z * v[q][j].z + v[q][j].w * v[q][j].w);
                const float rs = 1.0f / sqrtf(wave_sum(s) * (1.0f / D) + 1e-6f);
                v2u* o8 = (v2u*)(XB + (size_t)m * D) + F.lane;
#pragma unroll
                for (int j = 0; j < 4; ++j) { v2u o; o.x = pk2(v[q][j].x * rs, v[q][j].y * rs); o.y = pk2(v[q][j].z * rs, v[q][j].w * rs); o8[64 * j] = o; } } }
        }
    }
    __syncthreads();
    {
        LAS float* xnm = (LAS float*)F.lds;
        LAS float* red = (LAS float*)(F.lds + 65536);
        bool have = false;
        for (int it = blockIdx.x; it < 256; it += F.G) {
            if (!have) {
                for (int rr = 0; rr < 2; ++rr) { const int row = 2 * F.wave + rr; const f32x4* xr = (const f32x4*)(A.in[I_META] + row * D) + F.lane; const f32x4* gr = (const f32x4*)(A.in[I_NMG]) + F.lane;
                    f32x4 v[4]; float s = 0.f;
#pragma unroll
                    for (int j = 0; j < 4; ++j) { v[j] = xr[64 * j]; s += (v[j].x * v[j].x + v[j].y * v[j].y) + (v[j].z * v[j].z + v[j].w * v[j].w); }
                    const float rs = 1.0f / sqrtf(wave_sum(s) * (1.0f / D) + 1e-6f);
#pragma unroll
                    for (int j = 0; j < 4; ++j) { const f32x4 g = gr[64 * j]; *(LAS f32x4*)(xnm + row * D + 256 * j + 4 * F.lane) = v[j] * rs * g; } }
                __syncthreads(); have = true;
            }
            const int cg = it >> 3, ks = it & 7, col = 512 + cg * 64 + F.lane, kbase = ks * 128 + F.wave * 16;
            float acc[16];
#pragma unroll
            for (int r = 0; r < 16; ++r) acc[r] = 0.f;
#pragma unroll 4
            for (int k = 0; k < 16; ++k) { const float w = A.in[I_WIN][(size_t)(kbase + k) * IN_COLS + col];
#pragma unroll
                for (int r = 0; r < 16; ++r) acc[r] += xnm[r * D + kbase + k] * w; }
#pragma unroll
            for (int r = 0; r < 16; ++r) red[(F.wave * 16 + r) * 64 + F.lane] = acc[r];
            __syncthreads();
            float* MP = (float*)(ws + WS_METAP);
            for (int e = F.tid; e < 16 * 64; e += NWAVES * 64) { const int r = e >> 6, c = e & 63; float s = 0.f;
#pragma unroll
                for (int w = 0; w < 8; ++w) s += red[(w * 16 + r) * 64 + c];
                MP[(size_t)(ks * 16 + r) * 2048 + cg * 64 + c] = s; }
            __syncthreads();
        }
    }
}
DI void p1_meta_finish(Frame& F, const Args& A) {
    const float* MP = (const float*)(F.ws + WS_METAP);
    bf16* Kb = (bf16*)(F.ws + WS_K); bf16* Vb = (bf16*)(F.ws + WS_V); bf16* RC = (bf16*)(F.ws + WS_RC);
    for (int e = blockIdx.x * 512 + F.tid; e < 16 * 2048; e += F.G * 512) { const int r = e >> 11, c = e & 2047; float s = 0.f;
#pragma unroll
        for (int k = 0; k < 8; ++k) s += MP[(size_t)(k * 16 + r) * 2048 + c];
        const bf16 v = (bf16)f2bf(s);
        if (c < 128) Kb[(size_t)(M + r) * 128 + c] = v; else if (c < 256) Vb[(size_t)(M + r) * 128 + c - 128] = v; else RC[(size_t)(M + r) * RCW + c - 256] = v; }
}

DI int moe_table(Frame& F) {
    LAS int* tile_e = (LAS int*)(F.lds + LDS_TBL); LAS int* tb = tile_e + TT_MAX;
    if (F.wave == 0) {
        const int e = F.lane & 31; const int c = (int)__hip_atomic_load(F.ctl + CW_GCNT + 64 * e, __ATOMIC_RELAXED, __HIP_MEMORY_SCOPE_AGENT); const int nt = (c + 255) >> 8;
        int incl = nt;
#pragma unroll
        for (int d = 1; d < 32; d <<= 1) { const int y = __shfl_up(incl, d); if ((F.lane & 31) >= d) incl += y; }
        const int first = incl - nt;
        if (F.lane < 32) { tb[e] = first; tb[33 + e] = c; for (int t = 0; t < nt; ++t) tile_e[first + t] = e; if (e == 31) { tb[32] = incl; tb[65] = incl; } }
    }
    __syncthreads();
    return tb[65];
}
DI void p12_final(Frame& F, const Args& A) {
    const unsigned char* Y = (const unsigned char*)(F.ws + WS_Y); const bf16* H1 = (const bf16*)(F.ws + WS_AR);
    const int gw = blockIdx.x * NWAVES + F.wave, NGW = F.G * NWAVES, lane = F.lane;
    f32x4 gf[4];
#pragma unroll
    for (int j = 0; j < 4; ++j) gf[j] = ((const f32x4*)A.in[I_NFIN])[64 * j + lane];
    for (int m0 = gw; m0 < M; m0 += 2 * NGW) {
        v2u xh[2][4]; unsigned ya[2][4], yb[2][4];
#pragma unroll
        for (int q = 0; q < 2; ++q) { const int m = m0 + q * NGW < M ? m0 + q * NGW : m0; const v2u* hr = (const v2u*)(H1 + (size_t)m * D) + lane; const unsigned* y0 = (const unsigned*)(Y + (size_t)(2 * m) * D) + lane; const unsigned* y1 = (const unsigned*)(Y + (size_t)(2 * m + 1) * D) + lane;
#pragma unroll
            for (int j = 0; j < 4; ++j) { xh[q][j] = hr[64 * j]; ya[q][j] = y0[64 * j]; yb[q][j] = y1[64 * j]; } }
#pragma unroll
        for (int q = 0; q < 2; ++q) { const int m = m0 + q * NGW; if (m < M) { float s = 0.f; f32x4 v[4];
#pragma unroll
            for (int j = 0; j < 4; ++j) { const v2u h = xh[q][j]; const int a = (int)ya[q][j], c = (int)yb[q][j];
                v[j].x = __uint_as_float(h.x << 16) + 0.0625f * (__builtin_amdgcn_cvt_f32_fp8(a, 0) + __builtin_amdgcn_cvt_f32_fp8(c, 0)); v[j].y = __uint_as_float(h.x & 0xffff0000u) + 0.0625f * (__builtin_amdgcn_cvt_f32_fp8(a, 1) + __builtin_amdgcn_cvt_f32_fp8(c, 1));
                v[j].z = __uint_as_float(h.y << 16) + 0.0625f * (__builtin_amdgcn_cvt_f32_fp8(a, 2) + __builtin_amdgcn_cvt_f32_fp8(c, 2)); v[j].w = __uint_as_float(h.y & 0xffff0000u) + 0.0625f * (__builtin_amdgcn_cvt_f32_fp8(a, 3) + __builtin_amdgcn_cvt_f32_fp8(c, 3));
                s += (v[j].x * v[j].x + v[j].y * v[j].y) + (v[j].z * v[j].z + v[j].w * v[j].w); }
            const float rs = 1.0f / sqrtf(wave_sum(s) * (1.0f / D) + 1e-6f);
            f32x4* ho = (f32x4*)(F.out + (size_t)m * D) + lane;
#pragma unroll
            for (int j = 0; j < 4; ++j) ho[64 * j] = v[j] * rs * gf[j]; } }
    }
}

typedef short bf16x8 __attribute__((ext_vector_type(8)));
typedef float f32x16 __attribute__((ext_vector_type(16)));
#define MFMA32(a, b, c) __builtin_amdgcn_mfma_f32_32x32x16_bf16((a), (b), (c), 0, 0, 0)
constexpr int LDB = 72;
constexpr int LDF = 68;
constexpr int NCH = SEQ / 64, NITEM = NB * 8 * NCH, NITEM_ALL = NITEM + 8;
constexpr size_t CH_STRIDE = 65 * MiB;
constexpr size_t WS_CH = 611 * MiB;
constexpr size_t WS_LORA = 5 * MiB;
static_assert(WS_CH + 5 * CH_STRIDE <= WS_END && (size_t)NITEM_ALL * 8192 <= CH_STRIDE, "chunk map");

template <int KK> DI void mma_lds(f32x16& acc, const LAS bf16* Y, int ldy, int n0, const LAS bf16* X, int ldx, int m0, int lane) {
    const int r = lane & 31, hh = lane >> 5;
    const LAS bf16* yp = Y + (n0 + r) * ldy + 8 * hh; const LAS bf16* xp = X + (m0 + r) * ldx + 8 * hh;
#pragma unroll
    for (int k0 = 0; k0 < KK; k0 += 16) { const bf16x8 a = *(const LAS bf16x8*)(xp + k0), b = *(const LAS bf16x8*)(yp + k0); acc = MFMA32(a, b, acc); }
}
DI bf16x8 col_frag(const LAS bf16* Mx, int ld, int row0, int col) {
    const LAS bf16* p = Mx + row0 * ld + col; v4u t4;
#pragma unroll
    for (int i = 0; i < 4; ++i) t4[i] = (unsigned)p[(2 * i) * ld] | ((unsigned)p[(2 * i + 1) * ld] << 16);
    return __builtin_bit_cast(bf16x8, t4);
}
template <int KK, bool YT, bool XT> DI void mma_lds_t(f32x16& acc, const LAS bf16* Y, int ldy, int n0, const LAS bf16* X, int ldx, int m0, int lane) {
    const int r = lane & 31, hh = lane >> 5;
#pragma unroll
    for (int k0 = 0; k0 < KK; k0 += 16) {
        const bf16x8 a = XT ? col_frag(X, ldx, k0 + 8 * hh, m0 + r) : *(const LAS bf16x8*)(X + (m0 + r) * ldx + 8 * hh + k0);
        const bf16x8 b = YT ? col_frag(Y, ldy, k0 + 8 * hh, n0 + r) : *(const LAS bf16x8*)(Y + (n0 + r) * ldy + 8 * hh + k0);
        acc = MFMA32(a, b, acc); }
}
DI void add_tile_lds_t(f32x16& acc, const LAS bf16* Rm, int ld, int n0, int m0, int lane) {
    const int r = lane & 31, hh = lane >> 5;
#pragma unroll
    for (int i = 0; i < 16; ++i) acc[i] += __uint_as_float((unsigned)Rm[(m0 + 8 * (i >> 2) + 4 * hh + (i & 3)) * ld + n0 + r] << 16);
}
DI f32x16 zero16() { f32x16 z;
#pragma unroll
    for (int i = 0; i < 16; ++i) z[i] = 0.f; return z; }
DI void st_tile_lds(LAS bf16* Dm, int ld, int n0, int m0, const f32x16& acc, int lane) {
    const int r = lane & 31, hh = lane >> 5;
#pragma unroll
    for (int g = 0; g < 4; ++g) { v2u o; o.x = pk2(acc[4 * g], acc[4 * g + 1]); o.y = pk2(acc[4 * g + 2], acc[4 * g + 3]); *(LAS v2u*)(Dm + (n0 + r) * ld + m0 + 8 * g + 4 * hh) = o; }
}
DI void st_tile_glb(bf16* Dm, int ld, int n0, int m0, const f32x16& acc, int lane) {
    const int r = lane & 31, hh = lane >> 5;
#pragma unroll
    for (int g = 0; g < 4; ++g) { v2u o; o.x = pk2(acc[4 * g], acc[4 * g + 1]); o.y = pk2(acc[4 * g + 2], acc[4 * g + 3]); *(v2u*)(Dm + (size_t)(n0 + r) * ld + m0 + 8 * g + 4 * hh) = o; }
}
DI void st_tile_glb_frag(bf16* Dm, int n0, int m0, const f32x16& acc, int lane) {
    const int r = lane & 31, hh = lane >> 5;
#pragma unroll
    for (int g = 0; g < 4; ++g) { v2u o; o.x = pk2(acc[4 * g], acc[4 * g + 1]); o.y = pk2(acc[4 * g + 2], acc[4 * g + 3]);
        *(v2u*)(Dm + ((n0 >> 5) * 4 + (m0 >> 4) + (g >> 1)) * 512 + ((g & 1) * 32 + r) * 8 + 4 * hh) = o; }
}
DI void st_tile_glb_cl(bf16* Dm, int n0, int m0, const f32x16& acc, int lane) {
#pragma unroll
    for (int g = 0; g < 4; ++g) { v2u o; o.x = pk2(acc[4 * g], acc[4 * g + 1]); o.y = pk2(acc[4 * g + 2], acc[4 * g + 3]); *(v2u*)(Dm + ((n0 >> 5) * 2 + (m0 >> 5)) * 1024 + g * 256 + lane * 4) = o; }
}
DI void add_tile_lds(f32x16& acc, const LAS bf16* R, int ld, int n0, int m0, int lane) {
    const int r = lane & 31, hh = lane >> 5;
#pragma unroll
    for (int g = 0; g < 4; ++g) { const v2u w = *(const LAS v2u*)(R + (n0 + r) * ld + m0 + 8 * g + 4 * hh);
        acc[4 * g] += __uint_as_float(w.x << 16); acc[4 * g + 1] += __uint_as_float(w.x & 0xffff0000u); acc[4 * g + 2] += __uint_as_float(w.y << 16); acc[4 * g + 3] += __uint_as_float(w.y & 0xffff0000u); }
}
DI void up8(const v4u w, float* f) {
#pragma unroll
    for (int i = 0; i < 4; ++i) { f[2 * i] = __uint_as_float(w[i] << 16); f[2 * i + 1] = __uint_as_float(w[i] & 0xffff0000u); }
}
DI v4u pk8(const float* f) { v4u o; o.x = pk2(f[0], f[1]); o.y = pk2(f[2], f[3]); o.z = pk2(f[4], f[5]); o.w = pk2(f[6], f[7]); return o; }


constexpr size_t WS_XA = 936 * MiB;
DI int prev_row_of(int vt) { if (vt < M) return (vt % SEQ) > 0 ? vt - 1 : M + 15; return vt > M ? vt - 1 : -1; }
DI void p2a_lora_inputs(Frame& F, const Args& A) {
    const bf16* RC = (const bf16*)(F.ws + WS_RC); const float* mu = A.in[I_MU]; bf16* XA = (bf16*)(F.ws + WS_XA);
    const int stride = F.G * NWAVES * 64;
    for (int e0 = blockIdx.x * (NWAVES * 64) + F.tid; e0 < MV * 32; e0 += 4 * stride) {
        v4u cur[4], prv[4]; bool hp[4];
#pragma unroll
        for (int u = 0; u < 4; ++u) { const int e = e0 + u * stride < MV * 32 ? e0 + u * stride : e0; const int vt = e >> 5, col = 1536 + (e & 31) * 8, prow = prev_row_of(vt);
            hp[u] = prow >= 0; cur[u] = *(const v4u*)(RC + (size_t)vt * RCW + col); prv[u] = *(const v4u*)(RC + (size_t)(prow >= 0 ? prow : vt) * RCW + col); }
#pragma unroll
        for (int u = 0; u < 4; ++u) { const int e = e0 + u * stride; if (e < MV * 32) { const int vt = e >> 5, cg = e & 31, cl = cg * 8, col = 1536 + cl;
            float cu[8], pv[8], o[8]; up8(cur[u], cu); up8(prv[u], pv);
            if (!hp[u]) {
#pragma unroll
                for (int i = 0; i < 8; ++i) pv[i] = 0.f; }
            const f32x4 m0 = *(const f32x4*)(mu + col), m1 = *(const f32x4*)(mu + col + 4);
#pragma unroll
            for (int i = 0; i < 8; ++i) { const float mm = i < 4 ? m0[i] : m1[i - 4]; const float v = cu[i] + mm * (pv[i] - cu[i]);
                const float ex = __expf(-2.0f * fabsf(v)), th = copysignf((1.0f - ex) * __builtin_amdgcn_rcpf(1.0f + ex), v);
                o[i] = cg < 8 ? th : (cg < 16 ? v : sigmoid_f(v)); }
            *(v4u*)(XA + (size_t)vt * 256 + cl) = pk8(o); } }
    }
}

constexpr int L_AT = 0, L_ATT = 9216, L_RT = 18432, L_BT = 27648, L_BTT = 36864, L_KT = 46080, L_KTT = 55296, L_VT = 64512;
constexpr int L_AF = 73728, L_AP = 91136, L_AAK = 100352, L_ABR = 109568, L_AKR = 118784, L_TP = 128000, L_D1T = 137216, L_XT = 142336, L_PC = 146432;
constexpr int L_W1 = L_AF, L_AKT = L_AF + 9216, L_GT = L_AT, L_NKT = L_ATT;
constexpr int L_XL = 73728, L_LW = 73728, L_SEG = 91136, L_WL = 107520, L_AL = 124928;
constexpr int LDX = 264;

constexpr int L_WLN = 146688, L_ALN = L_WLN + 8192, L_TOT = L_LW;
struct ChunkItem { int h, row0, nvalid, prow0; bool meta; size_t oidx; };
DI ChunkItem chunk_item(int it, int npairs, int G) {
    ChunkItem I; I.meta = it >= npairs * 8;
    const int pair = I.meta ? 0 : (int)blockIdx.x + (it >> 3) * G; I.h = I.meta ? (int)blockIdx.x : (it & 7);
    const int b = I.meta ? 0 : pair / NCH, c = I.meta ? 0 : pair % NCH;
    I.row0 = I.meta ? M : b * SEQ + 64 * c; I.nvalid = I.meta ? 16 : 64; I.prow0 = I.meta ? -1 : (c > 0 ? I.row0 - 1 : M + 15);
    I.oidx = I.meta ? (size_t)(NITEM + I.h) : (size_t)((b * 8 + I.h) * NCH + c);
    return I;
}
DI void lora_tile(LAS unsigned char* L, const ChunkItem& I, int kind, int tq, const bf16* XA, const bf16* WdT, const bf16* WaT, const bf16* WgT, bf16* GB, int lane) {
    const int r32 = lane & 31, hh = lane >> 5, n0 = 32 * (tq >> 1), m0 = 32 * (tq & 1);
    const int tvx = (n0 + r32) < I.nvalid ? (n0 + r32) : I.nvalid - 1; const bf16* XLr = XA + (size_t)(I.row0 + tvx) * 256 + 8 * hh;
    f32x16 acc = zero16();
    if (kind < 2) { const bf16* Wt = (kind ? WaT : WdT) + (size_t)(I.h * 64 + m0 + r32) * 64 + 8 * hh;
#pragma unroll
        for (int k0 = 0; k0 < 64; k0 += 16) { const bf16x8 a = *(const bf16x8*)(Wt + k0), bb = *(const bf16x8*)(XLr + kind * 64 + k0); acc = MFMA32(a, bb, acc); }
        st_tile_lds((LAS bf16*)(L + (kind ? L_ALN : L_WLN)), 64, n0, m0, acc, lane);
    } else { const bf16* Wt = WgT + (size_t)(I.h * 64 + m0 + r32) * 128 + 8 * hh;
#pragma unroll
        for (int k0 = 0; k0 < 128; k0 += 16) { const bf16x8 a = *(const bf16x8*)(Wt + k0), bb = *(const bf16x8*)(XLr + 128 + k0); acc = MFMA32(a, bb, acc); }
        if (!I.meta) st_tile_glb_cl(GB + I.oidx * 4096, n0, m0, acc, lane); }
}
DI void stage1_tile(LAS unsigned char* L, int p, int n0, int m0, int lane) {
    const int r32 = lane & 31, hh = lane >> 5, n = n0 + r32;
    const LAS bf16* Y = (const LAS bf16*)(L + (p == 0 ? L_AT : p == 1 ? L_KT : L_RT));
    const LAS bf16* X = (const LAS bf16*)(L + (p == 0 ? L_BT : p == 1 ? L_AT : p == 2 ? L_BT : L_KT));
    f32x16 acc = zero16(); mma_lds<64>(acc, Y, LDB, n0, X, LDB, m0, lane);
#pragma unroll
    for (int i = 0; i < 16; ++i) { const int m = m0 + 8 * (i >> 2) + 4 * hh + (i & 3); const bool keep = p == 0 ? (m < n) : p == 1 ? (n < m) : (m <= n); if (!keep) acc[i] = 0.f; }
    if (p == 0) { LAS float* AFm = (LAS float*)(L + L_AF);
#pragma unroll
        for (int g = 0; g < 4; ++g) *(LAS f32x4*)(AFm + n * LDF + m0 + 8 * g + 4 * hh) = (f32x4){acc[4 * g], acc[4 * g + 1], acc[4 * g + 2], acc[4 * g + 3]};
        st_tile_lds((LAS bf16*)(L + L_AP), LDB, n0, m0, acc, lane); }
    else st_tile_lds((LAS bf16*)(L + (p == 1 ? L_AAK : p == 2 ? L_ABR : L_AKR)), LDB, n0, m0, acc, lane);
}
#ifndef P3I_REPS
#define P3I_REPS 1
#endif
DI void p3_rwkv_chunk(Frame& F, const Args& A) {
    LAS unsigned char* L = F.lds;
    const bf16* RC = (const bf16*)(F.ws + WS_RC); const float* mu = A.in[I_MU];
    bf16* GB = (bf16*)(F.ws + WS_GB); bf16* PO = (bf16*)(F.ws + WS_POST);
    const bf16* WdT = (const bf16*)(F.ws + WS_LORA); const bf16* WaT = WdT + 512 * 64; const bf16* WgT = WaT + 512 * 64;
    bf16* W2T = (bf16*)(F.ws + WS_CH); bf16* MTg = (bf16*)(F.ws + WS_CH + CH_STRIDE); bf16* YLT = (bf16*)(F.ws + WS_CH + 2 * CH_STRIDE); bf16* NBg = (bf16*)(F.ws + WS_CH + 3 * CH_STRIDE);
    const int tid = F.tid, lane = F.lane, w = F.wave, r32 = lane & 31, hh = lane >> 5;
    const bf16* XA = (const bf16*)(F.ws + WS_XA);
    const int npairs = (NB * NCH - (int)blockIdx.x + F.G - 1) / F.G, nmine = npairs * 8 + (blockIdx.x < 8 ? 1 : 0);
    if (nmine == 0) return;
    { LAS float* P1 = (LAS float*)(L + L_BTT); LAS float* P2 = (LAS float*)(L + L_KTT); const int i = tid;
        P1[i] = A.in[I_W0][i]; P1[512 + i] = A.in[I_A0][i]; P1[1024 + i] = A.in[I_KK][i]; P1[1536 + i] = A.in[I_KA][i]; ((LAS bf16*)(P1 + 2048))[i] = (bf16)f2bf(A.in[I_RK][i]);
        P2[i] = mu[i]; P2[512 + i] = mu[512 + i]; P2[1024 + i] = mu[1024 + i]; ((LAS bf16*)(P2 + 1536))[i] = (bf16)f2bf(A.in[I_LNB][i]); }
    const int t = tid >> 3, jg = tid & 7, j0 = 8 * jg;
    v4u rcu[3], rpv[3];
#define P3_REQ_ROWS(I_) do { const int tv_ = t < (I_).nvalid ? t : (I_).nvalid - 1, row_ = (I_).row0 + tv_, prow_ = tv_ > 0 ? row_ - 1 : (I_).prow0, ch_ = (I_).h * 64 + j0; \
        _Pragma("unroll") for (int which = 0; which < 3; ++which) { rcu[which] = *(const v4u*)(RC + (size_t)row_ * RCW + which * 512 + ch_); rpv[which] = *(const v4u*)(RC + (size_t)(prow_ >= 0 ? prow_ : row_) * RCW + which * 512 + ch_); } } while (0)
    {
        const ChunkItem I0 = chunk_item(0, npairs, F.G);
        P3_REQ_ROWS(I0);
        if (w < 4) { lora_tile(L, I0, 0, w, XA, WdT, WaT, WgT, GB, lane); lora_tile(L, I0, 1, w, XA, WdT, WaT, WgT, GB, lane); } else lora_tile(L, I0, 2, w - 4, XA, WdT, WaT, WgT, GB, lane);
    }
    LDS_BARRIER();
    for (int it = 0; it < nmine; ++it) {
        const ChunkItem I = chunk_item(it, npairs, F.G);
        const bool has_next = it + 1 < nmine; const ChunkItem IN = chunk_item(has_next ? it + 1 : it, npairs, F.G);
        const int h = I.h, row0 = I.row0, nvalid = I.nvalid, prow0 = I.prow0; const bool meta = I.meta; const size_t oidx = I.oidx;
        const int ch = h * 64 + j0;
        float rr[8], kp[8], vv[8], lw[8], aa[8], bb8[8], cum[8];
        {
            const bool valid = t < nvalid; const int tv = valid ? t : nvalid - 1;
            const int row = row0 + tv, prow = tv > 0 ? row - 1 : prow0;
            float cu[8], pv[8], kr[8];
#pragma unroll
            for (int which = 0; which < 3; ++which) { const int col = which * 512 + ch;
                up8(rcu[which], cu); up8(rpv[which], pv);
                if (prow < 0) {
#pragma unroll
                    for (int e = 0; e < 8; ++e) pv[e] = 0.f; }
                const f32x4 m0 = *(const LAS f32x4*)(L + L_KTT + (which * 512 + ch) * 4), m1 = *(const LAS f32x4*)(L + L_KTT + (which * 512 + ch + 4) * 4);
#pragma unroll
                for (int e = 0; e < 8; ++e) { const float mm = e < 4 ? m0[e] : m1[e - 4]; const float v = cu[e] + mm * (pv[e] - cu[e]); if (which == 0) rr[e] = v; else if (which == 1) kr[e] = v; else vv[e] = v; } }
            float wl8[8], al8[8]; up8(*(const LAS v4u*)(L + L_WLN + (t * 64 + j0) * 2), wl8); up8(*(const LAS v4u*)(L + L_ALN + (t * 64 + j0) * 2), al8);
            float s1 = 0.f, asg[8], pw0[8], pa0[8], pkk[8], pka[8], prk[8], plb[8];
#pragma unroll
            for (int q = 0; q < 2; ++q) { const LAS float* P1 = (const LAS float*)(L + L_BTT) + ch + 4 * q; const f32x4 v0 = *(const LAS f32x4*)P1, v1 = *(const LAS f32x4*)(P1 + 512), v2 = *(const LAS f32x4*)(P1 + 1024), v3 = *(const LAS f32x4*)(P1 + 1536);
#pragma unroll
                for (int i = 0; i < 4; ++i) { pw0[4 * q + i] = v0[i]; pa0[4 * q + i] = v1[i]; pkk[4 * q + i] = v2[i]; pka[4 * q + i] = v3[i]; } }
            up8(*(const LAS v4u*)(L + L_BTT + 8192 + ch * 2), prk); up8(*(const LAS v4u*)(L + L_KTT + 6144 + ch * 2), plb);
#pragma unroll
            for (int e = 0; e < 8; ++e) { lw[e] = -0.60653065971f * sigmoid_f(pw0[e] + wl8[e]);
                asg[e] = sigmoid_f(pa0[e] + al8[e]); aa[e] = kr[e] * pkk[e]; s1 += aa[e] * aa[e];
                kp[e] = kr[e] * (1.0f + (asg[e] - 1.0f) * pka[e]); }
            s1 += __shfl_xor(s1, 1); s1 += __shfl_xor(s1, 2); s1 += __shfl_xor(s1, 4);
            const float inv = __builtin_amdgcn_rcpf(fmaxf(__builtin_amdgcn_sqrtf(s1), 1e-12f));
            float s2 = 0.f;
#pragma unroll
            for (int e = 0; e < 8; ++e) { const float kkv = aa[e] * inv; aa[e] = -kkv; bb8[e] = kkv * asg[e]; s2 += rr[e] * kp[e] * prk[e]; }
            s2 += __shfl_xor(s2, 1); s2 += __shfl_xor(s2, 2); s2 += __shfl_xor(s2, 4);
            if (!meta) { float po[8];
#pragma unroll
                for (int e = 0; e < 8; ++e) po[e] = plb[e] + s2 * vv[e];
                const v4u pp = pk8(po); bf16* pd = PO + oidx * 4096 + ((t >> 5) * 2 + (jg >> 2)) * 1024 + (jg & 3) * 256 + (t & 31) * 4;
                v2u lo; lo.x = pp.x; lo.y = pp.y; v2u hi; hi.x = pp.z; hi.y = pp.w; *(v2u*)pd = lo; *(v2u*)(pd + 128) = hi; }
            if (!valid) {
#pragma unroll
                for (int e = 0; e < 8; ++e) { rr[e] = 0.f; kp[e] = 0.f; vv[e] = 0.f; lw[e] = 0.f; aa[e] = 0.f; bb8[e] = 0.f; } }
#pragma unroll
            for (int e = 0; e < 8; ++e) { float x = lw[e];
#pragma unroll
                for (int dlt = 8; dlt < 64; dlt <<= 1) { const float y = __shfl_up(x, dlt); if (lane >= dlt) x += y; }
                cum[e] = x; }
            if ((lane >> 3) == 7) { LAS float* TOT = (LAS float*)(L + L_TOT) + w * 64 + j0; *(LAS f32x4*)TOT = (f32x4){cum[0], cum[1], cum[2], cum[3]}; *(LAS f32x4*)(TOT + 4) = (f32x4){cum[4], cum[5], cum[6], cum[7]}; }
        }
        LDS_BARRIER();
        {
            const LAS float* TOT = (const LAS float*)(L + L_TOT) + j0;
            for (int q = 0; q < w; ++q) { const f32x4 a4 = *(const LAS f32x4*)(TOT + q * 64), b4 = *(const LAS f32x4*)(TOT + q * 64 + 4);
                cum[0] += a4.x; cum[1] += a4.y; cum[2] += a4.z; cum[3] += a4.w; cum[4] += b4.x; cum[5] += b4.y; cum[6] += b4.z; cum[7] += b4.w; }
            float at[8], rt[8], bt[8], kt[8];
#pragma unroll
            for (int e = 0; e < 8; ++e) { const float p = __builtin_amdgcn_exp2f(1.44269504089f * cum[e]), pprev = __builtin_amdgcn_exp2f(1.44269504089f * (cum[e] - lw[e])), pinv = __builtin_amdgcn_rcpf(p);
                at[e] = aa[e] * pprev; rt[e] = rr[e] * p; bt[e] = bb8[e] * pinv; kt[e] = kp[e] * pinv;
                if (t == 63) ((LAS float*)(L + L_PC))[j0 + e] = p; }
            *(LAS v4u*)(L + L_RT + (t * LDB + j0) * 2) = pk8(rt);
            const v4u pat = pk8(at), pbt = pk8(bt), pkt = pk8(kt), pvt = pk8(vv);
            *(LAS v4u*)(L + L_AT + (t * LDB + j0) * 2) = pat; *(LAS v4u*)(L + L_BT + (t * LDB + j0) * 2) = pbt; *(LAS v4u*)(L + L_KT + (t * LDB + j0) * 2) = pkt;
            *(LAS v4u*)(L + L_VT + (t * LDB + j0) * 2) = pvt;
        }
        LDS_BARRIER();
        stage1_tile(L, w >> 2, 32 * ((w >> 1) & 1), 32 * (w & 1), lane);
        LDS_BARRIER();
        _Pragma("unroll 1") for (int repi_ = 0; repi_ < P3I_REPS; ++repi_)
        if (w == 0) {
            LAS bf16* TP = (LAS bf16*)(L + L_TP); const LAS bf16* AP = (const LAS bf16*)(L + L_AP); LAS bf16* XT1 = (LAS bf16*)(L + L_D1T); LAS bf16* XT2 = (LAS bf16*)(L + L_XT);
            const int d4 = lane >> 4, cc = lane & 15; const LAS float* AFm = (const LAS float*)(L + L_AF) + (16 * d4) * LDF + 16 * d4;
#pragma unroll
            for (int i = 0; i < 9; ++i) *(LAS v4u*)(L + L_TP + (lane + 64 * i) * 16) = (v4u){0u, 0u, 0u, 0u};
            float x[16];
#pragma unroll
            for (int tt = 0; tt < 16; ++tt) x[tt] = 0.f;
            x[0] = cc == 0 ? 1.f : 0.f;
            {
                f32x4 ar[7][2];
#pragma unroll
                for (int tt = 1; tt < 8; ++tt)
#pragma unroll
                    for (int q = 0; q < 2; ++q) if (4 * q < tt) ar[tt - 1][q] = *(const LAS f32x4*)(AFm + tt * LDF + 4 * q);
#pragma unroll
                for (int tt = 1; tt < 8; ++tt) { float acc = (tt == cc) ? 1.f : 0.f;
#pragma unroll
                    for (int q = 0; q < 2; ++q) if (4 * q < tt) acc += (ar[tt - 1][q].x * x[4 * q] + ar[tt - 1][q].y * x[4 * q + 1]) + (ar[tt - 1][q].z * x[4 * q + 2] + ar[tt - 1][q].w * x[4 * q + 3]);
                    x[tt] = acc; }
            }
            {
                f32x4 ar[8][4];
#pragma unroll
                for (int tt = 8; tt < 16; ++tt)
#pragma unroll
                    for (int q = 0; q < 4; ++q) if (4 * q < tt) ar[tt - 8][q] = *(const LAS f32x4*)(AFm + tt * LDF + 4 * q);
#pragma unroll
                for (int tt = 8; tt < 16; ++tt) { float acc = (tt == cc) ? 1.f : 0.f;
#pragma unroll
                    for (int q = 0; q < 4; ++q) if (4 * q < tt) acc += (ar[tt - 8][q].x * x[4 * q] + ar[tt - 8][q].y * x[4 * q + 1]) + (ar[tt - 8][q].z * x[4 * q + 2] + ar[tt - 8][q].w * x[4 * q + 3]);
                    x[tt] = acc; }
            }
#pragma unroll
            for (int tt = 0; tt < 16; ++tt) TP[(16 * d4 + tt) * LDB + 16 * d4 + cc] = (bf16)f2bf(x[tt]);
            LDS_WAIT();
            f32x16 f0 = zero16(), f1 = zero16();
            mma_lds_t<32, true, false>(f0, TP, LDB, 0, AP, LDB, 0, lane); mma_lds_t<32, true, false>(f1, TP + 32 * LDB + 32, LDB, 0, AP + 32 * LDB + 32, LDB, 0, lane);
            st_tile_lds(XT1, 40, 0, 0, f0, lane); st_tile_lds(XT1 + 1280, 40, 0, 0, f1, lane);
            LDS_WAIT();
            f0 = zero16(); f1 = zero16();
            mma_lds<32>(f0, TP, LDB, 0, XT1, 40, 0, lane); mma_lds<32>(f1, TP + 32 * LDB + 32, LDB, 0, XT1 + 1280, 40, 0, lane);
            if (r32 >= 16) {
#pragma unroll
                for (int g = 0; g < 2; ++g) { v2u o0, o1; o0.x = pk2(f0[4 * g], f0[4 * g + 1]); o0.y = pk2(f0[4 * g + 2], f0[4 * g + 3]); o1.x = pk2(f1[4 * g], f1[4 * g + 1]); o1.y = pk2(f1[4 * g + 2], f1[4 * g + 3]);
                    *(LAS v2u*)(TP + r32 * LDB + 8 * g + 4 * hh) = o0; *(LAS v2u*)(TP + (32 + r32) * LDB + 32 + 8 * g + 4 * hh) = o1; } }
            LDS_WAIT();
            {
                f32x16 acc = zero16(); mma_lds_t<32, true, false>(acc, TP, LDB, 0, AP + 32 * LDB, LDB, 0, lane);
                st_tile_lds(XT2, 40, 0, 0, acc, lane);
            }
            LDS_WAIT();
            {
                f32x16 acc = zero16(); mma_lds<32>(acc, TP + 32 * LDB + 32, LDB, 0, XT2, 40, 0, lane);
                st_tile_lds(TP + 32 * LDB, LDB, 0, 0, acc, lane);
            }
        } else {
            if (w <= 4) { const int p = 2 + ((w - 1) >> 1), n0 = 32 * ((w - 1) & 1); stage1_tile(L, p, n0, 0, lane); stage1_tile(L, p, n0, 32, lane); }
            if (has_next) {
                if (w <= 4) { lora_tile(L, IN, 0, w - 1, XA, WdT, WaT, WgT, GB, lane); lora_tile(L, IN, 1, w - 1, XA, WdT, WaT, WgT, GB, lane); }
                else if (w == 5) { lora_tile(L, IN, 2, 0, XA, WdT, WaT, WgT, GB, lane); lora_tile(L, IN, 2, 1, XA, WdT, WaT, WgT, GB, lane); }
                else lora_tile(L, IN, 2, w - 4, XA, WdT, WaT, WgT, GB, lane);
            }
        }
        LDS_BARRIER();
        {
            const int p = w >> 2, n0 = 32 * ((w >> 1) & 1), m0 = 32 * (w & 1);
            f32x16 acc = zero16();
            if (p) mma_lds<64>(acc, (const LAS bf16*)(L + L_AAK), LDB, n0, (const LAS bf16*)(L + L_TP), LDB, m0, lane);
            else mma_lds_t<64, true, false>(acc, (const LAS bf16*)(L + L_AT), LDB, n0, (const LAS bf16*)(L + L_TP), LDB, m0, lane);
            st_tile_lds((LAS bf16*)(L + (p ? L_AKT : L_W1)), LDB, n0, m0, acc, lane);
        }
        LDS_BARRIER();
        {
            const int p = w >> 1, n0 = 32 * (w & 1), n = n0 + r32;
            const LAS bf16* Y = (const LAS bf16*)(L + (p < 2 ? L_ABR : L_BT)); const LAS bf16* X = (const LAS bf16*)(L + ((p & 1) ? L_AKT : L_W1));
            const float pc = ((const LAS float*)(L + L_PC))[n];
#pragma unroll 1
            for (int mt = 0; mt < 2; ++mt) { const int m0 = 32 * mt; f32x16 acc = zero16();
                if (p < 2) mma_lds<64>(acc, Y, LDB, n0, X, LDB, m0, lane); else mma_lds_t<64, true, false>(acc, Y, LDB, n0, X, LDB, m0, lane);
                if (p == 0) { add_tile_lds(acc, (const LAS bf16*)(L + L_RT), LDB, n0, m0, lane); st_tile_glb_frag(W2T + oidx * 4096, n0, m0, acc, lane); }
                else if (p == 1) { add_tile_lds(acc, (const LAS bf16*)(L + L_AKR), LDB, n0, m0, lane); st_tile_lds((LAS bf16*)(L + L_GT), LDB, n0, m0, acc, lane); }
                else if (p == 2) {
#pragma unroll
                    for (int i = 0; i < 16; ++i) { const int m = m0 + 8 * (i >> 2) + 4 * hh + (i & 3); acc[i] = (acc[i] + (m == n ? 1.f : 0.f)) * pc; }
                    st_tile_glb(MTg + oidx * 4096, 64, n0, m0, acc, lane); }
                else { add_tile_lds_t(acc, (const LAS bf16*)(L + L_KT), LDB, n0, m0, lane);
#pragma unroll
                    for (int i = 0; i < 16; ++i) acc[i] *= pc;
                    st_tile_lds((LAS bf16*)(L + L_NKT), LDB, n0, m0, acc, lane); } }
        }
        LDS_BARRIER();
        if (has_next) P3_REQ_ROWS(IN);
        {
            const int p = w >> 2, n0 = 32 * ((w >> 1) & 1), m0 = 32 * (w & 1);
            f32x16 acc = zero16();
            if (p) mma_lds_t<64, true, false>(acc, (const LAS bf16*)(L + L_VT), LDB, n0, (const LAS bf16*)(L + L_NKT), LDB, m0, lane);
            else mma_lds_t<64, false, true>(acc, (const LAS bf16*)(L + L_GT), LDB, n0, (const LAS bf16*)(L + L_VT), LDB, m0, lane);
            if (p) st_tile_glb(NBg + oidx * 4096, 64, n0, m0, acc, lane); else st_tile_glb_cl(YLT + oidx * 4096, n0, m0, acc, lane);
        }
    }
#undef P3_REQ_ROWS
}

constexpr int CH_GC = 4, CH_SLOT = (64 + 32) * LDB * 2, CH_NOFF = 64 * LDB * 2;
DI void p4_rwkv_chain(Frame& F, const Args& A) {
    const bf16* MTg = (const bf16*)(F.ws + WS_CH + CH_STRIDE); const bf16* NBg = (const bf16*)(F.ws + WS_CH + 3 * CH_STRIDE); bf16* S0g = (bf16*)(F.ws + WS_CH + 4 * CH_STRIDE);
    const int lane = F.lane, r32 = lane & 31, hh = lane >> 5, w = F.wave;
    for (int task = blockIdx.x; task < NB * 8 * 2; task += F.G) {
        const int bh = task >> 1, n0 = 32 * (task & 1), hd = bh & 7;
        f32x16 s[2];
        if (w == 0) { const bf16* Nm = NBg + (size_t)(NITEM + hd) * 4096 + (size_t)(n0 + r32) * 64 + 4 * hh;
#pragma unroll
            for (int mt = 0; mt < 2; ++mt)
#pragma unroll
                for (int g = 0; g < 4; ++g) { const v2u wv = *(const v2u*)(Nm + 32 * mt + 8 * g);
                    s[mt][4 * g] = __uint_as_float(wv.x << 16); s[mt][4 * g + 1] = __uint_as_float(wv.x & 0xffff0000u); s[mt][4 * g + 2] = __uint_as_float(wv.y << 16); s[mt][4 * g + 3] = __uint_as_float(wv.y & 0xffff0000u); } }
#define CH_STAGE(gi) do { if (w > 0) { v4u rg_[7]; \
            _Pragma("unroll") for (int u_ = 0; u_ < 7; ++u_) { const int pc_ = F.tid - 64 + u_ * 448; if (pc_ < CH_GC * 768) { const int sl_ = pc_ / 768, q_ = pc_ - sl_ * 768; const size_t o_ = (size_t)(bh * NCH + CH_GC * (gi) + sl_) * 4096; \
                rg_[u_] = q_ < 512 ? *(const v4u*)(MTg + o_ + (size_t)q_ * 8) : *(const v4u*)(NBg + o_ + (size_t)(n0 + ((q_ - 512) >> 3)) * 64 + ((q_ - 512) & 7) * 8); } } \
            _Pragma("unroll") for (int u_ = 0; u_ < 7; ++u_) { const int pc_ = F.tid - 64 + u_ * 448; if (pc_ < CH_GC * 768) { const int sl_ = pc_ / 768, q_ = pc_ - sl_ * 768; \
                LAS unsigned char* dst_ = F.lds + (((gi) & 1) * CH_GC + sl_) * CH_SLOT; \
                if (q_ < 512) *(LAS v4u*)(dst_ + (q_ >> 3) * (LDB * 2) + (q_ & 7) * 16) = rg_[u_]; \
                else { const int q2_ = q_ - 512; *(LAS v4u*)(dst_ + CH_NOFF + (q2_ >> 3) * (LDB * 2) + (q2_ & 7) * 16) = rg_[u_]; } } } } } while (0)
        CH_STAGE(0);
        LDS_BARRIER();
        for (int gi = 0; gi < NCH / CH_GC; ++gi) {
            if (gi + 1 < NCH / CH_GC) CH_STAGE(gi + 1);
            if (w == 0) {
#pragma unroll 1
                for (int sl = 0; sl < CH_GC; ++sl) { const int c = CH_GC * gi + sl;
                    const LAS bf16* Ms = (const LAS bf16*)(F.lds + ((gi & 1) * CH_GC + sl) * CH_SLOT); const LAS bf16* Ns = Ms + 64 * LDB;
                    bf16x8 am[2][4]; f32x16 acc[2];
#pragma unroll
                    for (int mt = 0; mt < 2; ++mt)
#pragma unroll
                        for (int q = 0; q < 4; ++q) { const LAS bf16* mr = Ms + (32 * mt + r32) * LDB + 16 * q + 4 * hh; const v2u lo = *(const LAS v2u*)mr, hi = *(const LAS v2u*)(mr + 8); const v2u nv = *(const LAS v2u*)(Ns + r32 * LDB + 32 * mt + 8 * q + 4 * hh);
                            v4u t4; t4.x = lo.x; t4.y = lo.y; t4.z = hi.x; t4.w = hi.y; am[mt][q] = __builtin_bit_cast(bf16x8, t4);
                            acc[mt][4 * q] = __uint_as_float(nv.x << 16); acc[mt][4 * q + 1] = __uint_as_float(nv.x & 0xffff0000u); acc[mt][4 * q + 2] = __uint_as_float(nv.y << 16); acc[mt][4 * q + 3] = __uint_as_float(nv.y & 0xffff0000u); }
                    bf16x8 sb[4];
                    { bf16* So = S0g + (size_t)(bh * NCH + c) * 4096 + (n0 >> 5) * 2048 + r32 * 8 + 4 * hh;
#pragma unroll
                        for (int q = 0; q < 4; ++q) { const int mt = q >> 1, i0 = 8 * (q & 1); v4u t4; t4.x = pk2(s[mt][i0], s[mt][i0 + 1]); t4.y = pk2(s[mt][i0 + 2], s[mt][i0 + 3]); t4.z = pk2(s[mt][i0 + 4], s[mt][i0 + 5]); t4.w = pk2(s[mt][i0 + 6], s[mt][i0 + 7]);
                            sb[q] = __builtin_bit_cast(bf16x8, t4);
                            v2u lo; lo.x = t4.x; lo.y = t4.y; v2u hi; hi.x = t4.z; hi.y = t4.w; *(v2u*)(So + 512 * q) = lo; *(v2u*)(So + 512 * q + 256) = hi; } }
#pragma unroll
                    for (int mt = 0; mt < 2; ++mt)
#pragma unroll
                        for (int q = 0; q < 4; ++q) acc[mt] = MFMA32(am[mt][q], sb[q], acc[mt]);
                    s[0] = acc[0]; s[1] = acc[1];
                }
            }
            LDS_BARRIER();
        }
#undef CH_STAGE
    }
}

DI void p5_rwkv_out(Frame& F, const Args& A) {
    const bf16* W2T = (const bf16*)(F.ws + WS_CH); const bf16* YLT = (const bf16*)(F.ws + WS_CH + 2 * CH_STRIDE); const bf16* S0g = (const bf16*)(F.ws + WS_CH + 4 * CH_STRIDE);
    const bf16* GB = (const bf16*)(F.ws + WS_GB); const bf16* PO = (const bf16*)(F.ws + WS_POST); bf16* RY = (bf16*)(F.ws + WS_AR) + 512;
    const int lane = F.lane, r32 = lane & 31, hh = lane >> 5;
    LAS bf16* stg = (LAS bf16*)(F.lds + F.wave * 8192);
    for (int pm = blockIdx.x; pm < M / 256; pm += F.G)
    for (int q = F.wave; q < 64; q += NWAVES) {
        const int b = pm >> 5, c = 4 * (pm & 31) + (q >> 4), h = (q >> 1) & 7, n0 = 32 * (q & 1), idx = (b * 8 + h) * NCH + c;
        const size_t o = (size_t)idx * 4096; const int row = b * SEQ + 64 * c + n0 + r32;
        const bf16* Yr = W2T + o + (n0 >> 5) * 2048 + lane * 8;
        v2u pwr[2][4], gvr[2][4]; f32x4 lgr[2][4];
#pragma unroll
        for (int mt = 0; mt < 2; ++mt)
#pragma unroll
            for (int g = 0; g < 4; ++g) { const int i0 = h * 64 + 32 * mt + 8 * g + 4 * hh; const size_t go = o + ((n0 >> 5) * 2 + mt) * 1024 + g * 256 + lane * 4; lgr[mt][g] = *(const f32x4*)(A.in[I_LNG] + i0); pwr[mt][g] = *(const v2u*)(PO + go); gvr[mt][g] = *(const v2u*)(GB + go); }
        f32x16 acc[2];
#pragma unroll
        for (int mt = 0; mt < 2; ++mt) { const bf16* Lr = YLT + o + ((n0 >> 5) * 2 + mt) * 1024 + lane * 4;
#pragma unroll
            for (int g = 0; g < 4; ++g) { const v2u wv = *(const v2u*)(Lr + 256 * g);
                acc[mt][4 * g] = __uint_as_float(wv.x << 16); acc[mt][4 * g + 1] = __uint_as_float(wv.x & 0xffff0000u); acc[mt][4 * g + 2] = __uint_as_float(wv.y << 16); acc[mt][4 * g + 3] = __uint_as_float(wv.y & 0xffff0000u); } }
#pragma unroll
        for (int k0 = 0; k0 < 64; k0 += 16) { const bf16x8 yb = *(const bf16x8*)(Yr + (k0 >> 4) * 512);
#pragma unroll
            for (int mt = 0; mt < 2; ++mt) { const bf16x8 xa = *(const bf16x8*)(S0g + o + (mt * 4 + (k0 >> 4)) * 512 + lane * 8); acc[mt] = MFMA32(xa, yb, acc[mt]); } }
        float sum = 0.f;
#pragma unroll
        for (int mt = 0; mt < 2; ++mt)
#pragma unroll
            for (int i = 0; i < 16; ++i) sum += acc[mt][i];
        sum += __shfl_xor(sum, 32); const float mean = sum * (1.0f / 64.0f);
        float sq = 0.f;
#pragma unroll
        for (int mt = 0; mt < 2; ++mt)
#pragma unroll
            for (int i = 0; i < 16; ++i) { acc[mt][i] -= mean; sq += acc[mt][i] * acc[mt][i]; }
        sq += __shfl_xor(sq, 32); const float rstd = 1.0f / sqrtf(sq * (1.0f / 64.0f) + 64e-5f);
#pragma unroll
        for (int mt = 0; mt < 2; ++mt)
#pragma unroll
            for (int g = 0; g < 4; ++g) { const int i0 = h * 64 + 32 * mt + 8 * g + 4 * hh; const size_t go = (size_t)row * 512 + i0;
                const f32x4 lg = lgr[mt][g]; const v2u pw = pwr[mt][g], gv = gvr[mt][g];
                const float o0 = (acc[mt][4 * g] * rstd * lg.x + __uint_as_float(pw.x << 16)) * __uint_as_float(gv.x << 16), o1 = (acc[mt][4 * g + 1] * rstd * lg.y + __uint_as_float(pw.x & 0xffff0000u)) * __uint_as_float(gv.x & 0xffff0000u);
                const float o2 = (acc[mt][4 * g + 2] * rstd * lg.z + __uint_as_float(pw.y << 16)) * __uint_as_float(gv.y << 16), o3 = (acc[mt][4 * g + 3] * rstd * lg.w + __uint_as_float(pw.y & 0xffff0000u)) * __uint_as_float(gv.y & 0xffff0000u);
                v2u ov; ov.x = pk2(o0, o1); ov.y = pk2(o2, o3); *(LAS v2u*)(stg + r32 * 72 + 32 * mt + 8 * g + 4 * hh) = ov; }
        LDS_WAIT();
        {
            const size_t rb = (size_t)(b * SEQ + 64 * c + n0) * 1024 + h * 64;
#pragma unroll
            for (int k = 0; k < 4; ++k) { const int p = lane + 64 * k, tk = p >> 3, c16 = p & 7; *(v4u*)(RY + rb + (size_t)tk * 1024 + c16 * 8) = *(const LAS v4u*)(stg + tk * 72 + c16 * 8); }
        }
        LDS_WAIT();
    }
}

constexpr int AT_LDK = 72, AT_LDV = 300, AT_VT = 288 * AT_LDK * 2;
DI void p2_attention_mfma(Frame& F, const Args& A) {
    LAS bf16* ostg = (LAS bf16*)(F.lds + 81920 + F.wave * 8192);
    LAS bf16* Ks = (LAS bf16*)F.lds; LAS bf16* Vt = (LAS bf16*)(F.lds + AT_VT);
    const bf16* Q = (const bf16*)(F.ws + WS_Q); const bf16* Kb = (const bf16*)(F.ws + WS_K); const bf16* Vb = (const bf16*)(F.ws + WS_V); bf16* AO = (bf16*)(F.ws + WS_AR);
    const int tid = F.tid, lane = F.lane, w = F.wave, r32 = lane & 31, hh = lane >> 5;
    for (int item = blockIdx.x; item < NB * 2 * (SEQ / 128); item += F.G) {
        const int b = item >> 7, kvh = (item >> 6) & 1, jb = item & 63, tok0 = 128 * (jb - 1);
        {
            v4u kvr[5], vvr[5];
#pragma unroll
            for (int u = 0; u < 5; ++u) { const int ch = tid + u * (NWAVES * 64), key = ch >> 3, c = ch & 7;
                const int tk = tok0 + key; int row = key < 256 ? (tk >= 0 ? b * SEQ + tk : -1) : (key < 272 ? M + key - 256 : -1);
                const unsigned msk = (unsigned)~(row >> 31); row = row < 0 ? 0 : row;
                kvr[u] = *(const v4u*)(Kb + (size_t)row * 128 + kvh * 64 + 8 * c); vvr[u] = *(const v4u*)(Vb + (size_t)row * 128 + kvh * 64 + 8 * c);
#pragma unroll
                for (int i = 0; i < 4; ++i) { kvr[u][i] &= msk; vvr[u][i] &= msk; } }
#pragma unroll
            for (int u = 0; u < 5; ++u) { const int ch = tid + u * (NWAVES * 64), key = ch >> 3, c = ch & 7;
                if (u < 4 || ch < 288 * 8) { *(LAS v4u*)(Ks + key * AT_LDK + 8 * c) = kvr[u];
#pragma unroll
                    for (int e2 = 0; e2 < 8; ++e2) Vt[(8 * c + e2) * AT_LDV + key] = (bf16)((e2 & 1) ? (vvr[u][e2 >> 1] >> 16) : (vvr[u][e2 >> 1] & 0xffffu)); } }
        }
        LDS_BARRIER();
        const int g = w & 3, qh = w >> 2, h = kvh * 4 + g;
        const float slope = exp2f(-(float)(h + 1)), sink = A.in[I_SINK][h];
#pragma unroll 1
        for (int qq = 0; qq < 2; ++qq) {
            const int qt = 2 * qh + qq, ql = 32 * qt + r32, t = 128 * jb + ql; const size_t row = (size_t)b * SEQ + t;
            bf16x8 qf[4];
#pragma unroll
            for (int ks = 0; ks < 4; ++ks) qf[ks] = *(const bf16x8*)(Q + row * 512 + h * 64 + 16 * ks + 8 * hh);
            f32x16 sc[6]; float mx = -INFINITY;
            const LAS bf16* kbase = Ks + (32 * qt + r32) * AT_LDK + 8 * hh; const LAS bf16* kmeta = Ks + (256 + r32) * AT_LDK + 8 * hh;
            const LAS bf16* vbase = Vt + r32 * AT_LDV + 32 * qt + 4 * hh; const LAS bf16* vmeta = Vt + r32 * AT_LDV + 256 + 4 * hh;
#pragma unroll
            for (int k6 = 0; k6 < 6; ++k6) { const int kta = k6 < 5 ? qt + k6 : 8; f32x16 acc = zero16(); const LAS bf16* kp = k6 < 5 ? kbase + 32 * k6 * AT_LDK : kmeta;
#pragma unroll
                for (int ks = 0; ks < 4; ++ks) { const bf16x8 a = *(const LAS bf16x8*)(kp + 16 * ks); acc = MFMA32(a, qf[ks], acc); }
#pragma unroll
                for (int i = 0; i < 16; ++i) { const int kr = 8 * (i >> 2) + 4 * hh + (i & 3); bool ok; float dist;
                    if (k6 < 5) { const int kb = 32 * kta + kr, diff = 128 + ql - kb; dist = (float)diff;
                        if (k6 >= 1 && k6 <= 3) ok = jb > 0 || tok0 + kb >= 0;
                        else ok = diff >= 0 && diff < 128 && tok0 + kb >= 0; }
                    else { const int dm = t + 16 - kr; ok = kr < 16; dist = (float)(dm < 128 ? dm : 128); }
                    const float v = ok ? acc[i] - slope * dist : -INFINITY; sc[k6][i] = v; mx = fmaxf(mx, v); } }
            mx = fmaxf(mx, __shfl_xor(mx, 32)); mx = fmaxf(mx, sink);
            float sum = 0.f;
#pragma unroll
            for (int k6 = 0; k6 < 6; ++k6)
#pragma unroll
                for (int i = 0; i < 16; ++i) { const float p = __expf(sc[k6][i] - mx); sc[k6][i] = p; sum += p; }
            sum += __shfl_xor(sum, 32); sum += __expf(sink - mx);
            const float inv = 1.0f / sum;
            f32x16 o[2]; o[0] = zero16(); o[1] = zero16();
#pragma unroll
            for (int k6 = 0; k6 < 6; ++k6) { const int kta = k6 < 5 ? qt + k6 : 8;
#pragma unroll
                for (int s = 0; s < 2; ++s) { v4u t4; t4.x = pk2(sc[k6][8 * s], sc[k6][8 * s + 1]); t4.y = pk2(sc[k6][8 * s + 2], sc[k6][8 * s + 3]); t4.z = pk2(sc[k6][8 * s + 4], sc[k6][8 * s + 5]); t4.w = pk2(sc[k6][8 * s + 6], sc[k6][8 * s + 7]);
                    const bf16x8 pb = __builtin_bit_cast(bf16x8, t4);
#pragma unroll
                    for (int dt = 0; dt < 2; ++dt) { const LAS bf16* vp = (k6 < 5 ? vbase + 32 * k6 : vmeta) + 32 * dt * AT_LDV + 16 * s; const v2u lo = *(const LAS v2u*)vp, hi = *(const LAS v2u*)(vp + 8);
                        v4u a4; a4.x = lo.x; a4.y = lo.y; a4.z = hi.x; a4.w = hi.y; o[dt] = MFMA32(__builtin_bit_cast(bf16x8, a4), pb, o[dt]); } } }
#pragma unroll
            for (int dt = 0; dt < 2; ++dt)
#pragma unroll
                for (int g4 = 0; g4 < 4; ++g4) { v2u ov; ov.x = pk2(o[dt][4 * g4] * inv, o[dt][4 * g4 + 1] * inv); ov.y = pk2(o[dt][4 * g4 + 2] * inv, o[dt][4 * g4 + 3] * inv);
                    *(LAS v2u*)(ostg + r32 * 72 + 32 * dt + 8 * g4 + 4 * hh) = ov; }
            LDS_WAIT();
            {
                const size_t rb = ((size_t)b * SEQ + 128 * jb + 32 * qt) * 1024 + h * 64;
#pragma unroll
                for (int k = 0; k < 4; ++k) { const int p = lane + 64 * k, tk = p >> 3, c16 = p & 7; *(v4u*)(AO + rb + (size_t)tk * 1024 + c16 * 8) = *(const LAS v4u*)(ostg + tk * 72 + c16 * 8); }
            }
            LDS_WAIT();
        }
        LDS_BARRIER();
    }
}

constexpr int R_EHI = 0, R_ELO = 65536, R_GHI = 131072, R_GLO = 139264;
DI float sq8(const v4u h) { float s = 0.f;
#pragma unroll
    for (int i = 0; i < 4; ++i) { const unsigned u = i == 0 ? h.x : i == 1 ? h.y : i == 2 ? h.z : h.w; const float a = __uint_as_float(u << 16), b = __uint_as_float(u & 0xffff0000u); s += a * a + b * b; }
    return s; }
DI void split8(const float (&wv)[8], v4u& hi, v4u& lo) {
    unsigned hw[4], lw[4];
#pragma unroll
    for (int i = 0; i < 4; ++i) { hw[i] = pk2(wv[2 * i], wv[2 * i + 1]); lw[i] = pk2(wv[2 * i] - __uint_as_float(hw[i] << 16), wv[2 * i + 1] - __uint_as_float(hw[i] & 0xffff0000u)); }
    hi.x = hw[0]; hi.y = hw[1]; hi.z = hw[2]; hi.w = hw[3]; lo.x = lw[0]; lo.y = lw[1]; lo.z = lw[2]; lo.w = lw[3]; }
DI void p8_router(Frame& F, const Args& A) {
    LAS unsigned char* L = F.lds;
    LAS int* lcnt = (LAS int*)(L + LDS_RT); LAS int* lbase = lcnt + 32; LAS int* ent_e = lcnt + 64; LAS int* ent_p = ent_e + 512; LAS int* ent_d = ent_p + 512; LAS float* ent_w = (LAS float*)(ent_d + 512); LAS float* ent_r = ent_w + 512;
    LAS float* bias = ent_r + 512;
    const bf16* H1 = (const bf16*)(F.ws + WS_AR);
    int* LD = (int*)(F.ws + WS_LISTD); float* LW = (float*)(F.ws + WS_LISTW); float* LR = (float*)(F.ws + WS_LISTR);
    const int lane = F.lane, r32 = lane & 31, hh = lane >> 5;
    if ((int)blockIdx.x >= M / 256) return;
    {
        const float* g2 = A.in[I_NFG];
        for (int it = F.tid; it < 128 * 32; it += NWAVES * 64) { const int e = it & 31, c = it >> 5; float wv[8];
#pragma unroll
            for (int j = 0; j < 8; ++j) wv[j] = A.in[I_WEXP][(8 * c + j) * 32 + e] * g2[8 * c + j];
            v4u hi, lo; split8(wv, hi, lo); const int o = e * 2048 + ((c ^ (e & 15)) << 4);
            *(LAS v4u*)(L + R_EHI + o) = hi; *(LAS v4u*)(L + R_ELO + o) = lo; }
        for (int it = F.tid; it < 128 * 4; it += NWAVES * 64) { const int g = it & 3, c = it >> 2; float wv[8];
#pragma unroll
            for (int j = 0; j < 8; ++j) wv[j] = A.in[I_WGRP][(8 * c + j) * 4 + g] * g2[8 * c + j];
            v4u hi, lo; split8(wv, hi, lo); const int o = g * 2048 + ((c ^ g) << 4);
            *(LAS v4u*)(L + R_GHI + o) = hi; *(LAS v4u*)(L + R_GLO + o) = lo; }
        if (F.tid < 36) bias[F.tid] = F.tid < 4 ? A.in[I_BGRP][F.tid] : A.in[I_BEXP][F.tid - 4];
    }
    for (int ch = blockIdx.x; ch < M / 256; ch += F.G) {
        if (F.tid < 32) lcnt[F.tid] = 0;
        __syncthreads();
        const int tok = ch * 256 + F.wave * 32 + r32;
        const bf16* hp = H1 + (size_t)tok * D + 32 * hh;
        v4u hb[4][4];
#pragma unroll
        for (int u = 0; u < 4; ++u)
#pragma unroll
            for (int s = 0; s < 4; ++s) hb[u][s] = *(const v4u*)(hp + 64 * u + 8 * s);
        f32x16 accE = zero16(), accG = zero16(); float ss = 0.f;
        const LAS unsigned char* eh = L + R_EHI + r32 * 2048; const LAS unsigned char* gh = L + R_GHI + (r32 & 3) * 2048;
        const int sw = r32 & 15, swg = r32 & 3;
#pragma unroll 1
        for (int q0 = 0; q0 < 16; q0 += 4) {
#pragma unroll
            for (int u = 0; u < 4; ++u) { const int q = q0 + u;
#pragma unroll
                for (int s = 0; s < 4; ++s) { const v4u hv = hb[u][s]; const int c = 8 * q + 4 * hh + s;
                    const bf16x8 b = __builtin_bit_cast(bf16x8, hv);
                    const bf16x8 a0 = *(const LAS bf16x8*)(eh + ((c ^ sw) << 4)), a1 = *(const LAS bf16x8*)(eh + (R_ELO - R_EHI) + ((c ^ sw) << 4));
                    const bf16x8 a2 = *(const LAS bf16x8*)(gh + ((c ^ swg) << 4)), a3 = *(const LAS bf16x8*)(gh + (R_GLO - R_GHI) + ((c ^ swg) << 4));
                    accE = MFMA32(a0, b, accE); accG = MFMA32(a2, b, accG); accE = MFMA32(a1, b, accE); accG = MFMA32(a3, b, accG);
                    ss += sq8(hv); }
                if (q + 4 < 16) {
#pragma unroll
                    for (int s = 0; s < 4; ++s) hb[u][s] = *(const v4u*)(hp + 64 * (q + 4) + 8 * s); } }
        }
        ss += __shfl_xor(ss, 32);
        const float rs = 1.0f / sqrtf(ss * (1.0f / D) + 1e-6f);
        float gl[4];
#pragma unroll
        for (int g = 0; g < 4; ++g) gl[g] = __shfl(accG[g], r32) * rs + bias[g];
        int gs = 0; float gm = gl[0];
#pragma unroll
        for (int g = 1; g < 4; ++g) if (gl[g] > gm) { gm = gl[g]; gs = g; }
        float den = 0.f;
#pragma unroll
        for (int g = 0; g < 4; ++g) den += __expf(gl[g] - gm);
        const float pg = 1.0f / den;
        float a1 = -INFINITY, a2 = -INFINITY; int ai1 = 0, ai2 = 0;
#pragma unroll
        for (int j = 0; j < 4; ++j) { const float cd = gs == 0 ? accE[j] : gs == 1 ? accE[4 + j] : gs == 2 ? accE[8 + j] : accE[12 + j];
            const int idx = 4 * hh + j; const float l = cd * rs + bias[4 + gs * 8 + idx];
            if (l > a1) { a2 = a1; ai2 = ai1; a1 = l; ai1 = idx; } else if (l > a2) { a2 = l; ai2 = idx; } }
        const float b1 = __shfl_xor(a1, 32), b2 = __shfl_xor(a2, 32); const int bi1 = __shfl_xor(ai1, 32), bi2 = __shfl_xor(ai2, 32);
        const float p1 = hh ? b1 : a1, p2 = hh ? b2 : a2, q1 = hh ? a1 : b1, q2 = hh ? a2 : b2;
        const int pi1 = hh ? bi1 : ai1, pi2 = hh ? bi2 : ai2, qi1 = hh ? ai1 : bi1, qi2 = hh ? ai2 : bi2;
        float v1, v2; int i1, i2;
        if (p1 >= q1) { v1 = p1; i1 = pi1; if (p2 >= q1) { v2 = p2; i2 = pi2; } else { v2 = q1; i2 = qi1; } }
        else { v1 = q1; i1 = qi1; if (p1 >= q2) { v2 = p1; i2 = pi1; } else { v2 = q2; i2 = qi2; } }
        const float e2 = __expf(v2 - v1), w1 = pg / (1.0f + e2), w2 = pg * e2 / (1.0f + e2);
        { const int ex = gs * 8 + (hh == 0 ? i1 : i2); const int pos = atomicAdd((int*)&lcnt[ex], 1); const int slot = (F.wave * 32 + r32) * 2 + hh;
            ent_e[slot] = ex; ent_p[slot] = pos; ent_d[slot] = tok * 2 + hh; ent_w[slot] = hh == 0 ? w1 : w2; ent_r[slot] = rs; }
        __syncthreads();
        if (F.tid < 32) lbase[F.tid] = (int)__hip_atomic_fetch_add(F.ctl + CW_GCNT + 64 * F.tid, (unsigned)lcnt[F.tid], __ATOMIC_RELAXED, __HIP_MEMORY_SCOPE_AGENT);
        __syncthreads();
        { const int sl = F.tid; const int ex = ent_e[sl]; const size_t o = (size_t)ex * LCAP + lbase[ex] + ent_p[sl]; LD[o] = ent_d[sl]; LW[o] = ent_w[sl]; LR[o] = ent_r[sl]; }
        __syncthreads();
    }
}
__global__ void __launch_bounds__(NWAVES * 64, 2) mk_fwd(Args args) {
    extern __shared__ __attribute__((aligned(16))) unsigned char lds[];
    Frame F;
    F.lds = (LAS unsigned char*)lds;
    F.tid = threadIdx.x; F.lane = F.tid & 63; F.wave = __builtin_amdgcn_readfirstlane(F.tid >> 6); F.G = gridDim.x;
    F.out = args.out; F.ws = args.ws; F.ctl = (unsigned*)(args.ws + WS_CTL);
    volatile LAS unsigned* MISC = (volatile LAS unsigned*)(F.lds + LDS_MISC);
    if (F.tid < 64) MISC[F.tid] = 0u;
    __syncthreads();
    const int lo = args.ph_lo, hi = args.ph_hi;
    XcdBarrier bar; bar.bar = (unsigned*)(F.ctl + CW_BAR); bar.x = 0; bar.st = nullptr;
    if (hi - lo > 1) bar = xcd_barrier_post((unsigned*)(F.ctl + CW_BAR), MISC + 8);
#ifdef ONLY_PHASE
#define IN(k) ((k) == ONLY_PHASE && lo <= (k) && (k) < hi)
#elif defined(SKIP_PHASE)
#define IN(k) ((k) != SKIP_PHASE && lo <= (k) && (k) < hi)
#else
#define IN(k) (lo <= (k) && (k) < hi)
#endif
#ifndef PROBE_MASK
#define PROBE_MASK 0
#endif
#define REPS(k) (1 + ((PROBE_MASK >> (k)) & 1))
#define SEAM(k) do { if (IN(k) && IN((k) + 1)) xcd_barrier(bar); } while (0)
#define LOCAL_SEAM(k) do { if (IN(k) && IN((k) + 1)) { asm volatile("s_waitcnt vmcnt(0)" ::: "memory"); __syncthreads(); __builtin_amdgcn_fence(__ATOMIC_ACQUIRE, "agent"); asm volatile("s_waitcnt vmcnt(0)" ::: "memory"); __syncthreads(); } } while (0)
    unsigned char* ws = args.ws;
    if (IN(0)) { _Pragma("unroll") for (int rep = 0; rep < REPS(0); ++rep) { p0_prologue(F, args); } SEAM(0); }
    if (IN(1)) {
        p1_meta_finish(F, args);
        pg8::Gemm g{(const pg8::bf16_t*)(ws + WS_XB), (const pg8::bf16_t*)(ws + WS_WIN), M, IN_COLS, D, 0}; pg8::StaticOrder S; S.init(M, IN_COLS, F.G, (int)blockIdx.x);
        pg8::EpiIn E{(bf16*)(ws + WS_Q), (bf16*)(ws + WS_K), (bf16*)(ws + WS_V), (bf16*)(ws + WS_RC), (bf16*)F.out};
        _Pragma("unroll") for (int rep = 0; rep < REPS(1); ++rep) { pg8::gemm_phase<pg8::EpiIn, pg8::StaticOrder, true, true>(F.lds, g, S, E); }
        SEAM(1);
    }
    if (IN(2)) { _Pragma("unroll") for (int rep = 0; rep < REPS(2); ++rep) { p2a_lora_inputs(F, args); p2_attention_mfma(F, args); } SEAM(2); }
    if (IN(3)) { _Pragma("unroll") for (int rep = 0; rep < REPS(3); ++rep) { p3_rwkv_chunk(F, args); } SEAM(3); }
    if (IN(4)) { _Pragma("unroll") for (int rep = 0; rep < REPS(4); ++rep) { if (F.G >= 2 * NB * 8 * 2) expert_weights(F, args, NB * 8 * 2); else { expert_weights(F, args, 0); LDS_BARRIER(); } p4_rwkv_chain(F, args); } SEAM(4); }
    if (IN(5)) { _Pragma("unroll") for (int rep = 0; rep < REPS(5); ++rep) { p5_rwkv_out(F, args); } LOCAL_SEAM(5); }
    if (IN(6)) {
        pg8::Gemm g{(const pg8::bf16_t*)(ws + WS_AR), (const pg8::bf16_t*)(ws + WS_WOA), M, D, D, 512}; pg8::PairOrder<pg8::PanelOrder> S; S.base.init(M, D, F.G, (int)blockIdx.x); S.koff_bytes = 1024;
        pg8::EpiGate2 E{(const bf16*)F.out, (bf16*)(ws + WS_MG)};
        _Pragma("unroll") for (int rep = 0; rep < REPS(6); ++rep) { pg8::gemm_phase<pg8::EpiGate2, pg8::PairOrder<pg8::PanelOrder>, true, true>(F.lds, g, S, E); }
        LOCAL_SEAM(6);
    }
    if (IN(7)) {
        pg8::Gemm g{(const pg8::bf16_t*)(ws + WS_MG), (const pg8::bf16_t*)(ws + WS_WOUT), M, D, D, 0}; pg8::PanelOrder S; S.init(M, D, F.G, (int)blockIdx.x);
        pg8::EpiRes E{args.in[I_X], (bf16*)(ws + WS_AR)};
        _Pragma("unroll") for (int rep = 0; rep < REPS(7); ++rep) { pg8::gemm_phase<pg8::EpiRes, pg8::PanelOrder, true, true>(F.lds, g, S, E); }
        LOCAL_SEAM(7);
    }
    if (IN(8)) { _Pragma("unroll") for (int rep = 0; rep < REPS(8); ++rep) { p8_router(F, args); } SEAM(8); }
    if (IN(9)) {
        const int TT = moe_table(F);
        const LAS int* tile_e = (const LAS int*)(F.lds + LDS_TBL); const LAS int* tb = tile_e + TT_MAX;
        LAS int* ldd = (LAS int*)(F.lds + 131072); LAS float* ldw = (LAS float*)(F.lds + 131072 + 8 * 1024); LAS float* ldr = (LAS float*)(F.lds + 131072 + 16 * 1024);
        pg8::Gemm g{(const pg8::bf16_t*)(ws + WS_XN2), (const pg8::bf16_t*)(ws + WS_WGU), CAP, NE * 512, D, 0};
        pg8::GroupedOrder<true> S{tile_e, tb, TT, 2, F.G, (int)blockIdx.x, ldd, (unsigned)(D * 2)};
        { const int* LD = (const int*)(ws + WS_LISTD); const float* LW = (const float*)(ws + WS_LISTW); const float* LR = (const float*)(ws + WS_LISTR);
          for (int idx = F.tid; idx < 8 * 256; idx += NWAVES * 64) { pg8::Unit u; const int i = idx >> 8, r = idx & 255;
              if (S.next(i, u)) { const int li = u.r0 + r; const bool ok = li < u.cnt; const int e = u.pn >> 1; const float rs = ok ? LR[e * LCAP + li] : 0.f; ldd[idx] = ok ? LD[e * LCAP + li] : -1; ldw[idx] = ok ? LW[e * LCAP + li] * rs * rs : 0.f; ldr[idx] = rs; } }
          __syncthreads(); }
        pg8::EpiSwiglu E{(bf16*)(ws + WS_HMID), ldd, ldw, ldr, (int*)(ws + WS_SLOTD)};
        _Pragma("unroll") for (int rep = 0; rep < REPS(9); ++rep) { pg8::gemm_phase<pg8::EpiSwiglu, pg8::GroupedOrder<true>, true, true>(F.lds, g, S, E); }
        SEAM(9);
    }
    if (IN(10)) {
        const int TT = moe_table(F);
        const LAS int* tile_e = (const LAS int*)(F.lds + LDS_TBL); const LAS int* tb = tile_e + TT_MAX;
        LAS int* lsl = (LAS int*)(F.lds + 131072);
        pg8::Gemm g{(const pg8::bf16_t*)(ws + WS_HMID), (const pg8::bf16_t*)(ws + WS_WDN), CAP, NE * 1024, 256, 0};
        pg8::GroupedOrder<false> S{tile_e, tb, TT, 4, F.G, (int)blockIdx.x, nullptr, 0u};
        { const int* SD = (const int*)(ws + WS_SLOTD);
          for (int idx = F.tid; idx < 12 * 256; idx += NWAVES * 64) { pg8::Unit u; const int i = idx >> 8, r = idx & 255; if (S.next(i, u)) lsl[idx] = SD[u.pm * 256 + r]; }
          __syncthreads(); }
        pg8::EpiDown E{(unsigned char*)(ws + WS_Y), lsl};
        _Pragma("unroll") for (int rep = 0; rep < REPS(10); ++rep) { pg8::gemm_phase<pg8::EpiDown, pg8::GroupedOrder<false>, true, true>(F.lds, g, S, E); }
        SEAM(10);
    }
    if (IN(11)) { _Pragma("unroll") for (int rep = 0; rep < REPS(11); ++rep) { p12_final(F, args); } }
#undef IN
#undef SEAM
}

extern "C" void kernel_launch(void* const* d_in, const int* in_sizes, int n_in, void* d_out, int out_size, void* d_ws, size_t ws_size, hipStream_t stream) {
    static int grid = 0;
    if (grid == 0) {
        if (n_in != 28 || in_sizes[0] != M * D || out_size != M * D || ws_size < WS_END) { fprintf(stderr, "kernel_launch: unexpected shapes (n_in %d, in0 %d, out %d, ws %zu)\n", n_in, n_in > 0 ? in_sizes[0] : -1, out_size, ws_size); grid = -1; return; }
        int dev = 0, cus = 0, per_cu = 0;
        if (hipGetDevice(&dev) != hipSuccess || hipDeviceGetAttribute(&cus, hipDeviceAttributeMultiprocessorCount, dev) != hipSuccess) { grid = -1; return; }
        if (hipFuncSetAttribute((const void*)mk_fwd, hipFuncAttributeMaxDynamicSharedMemorySize, LDS_BYTES) != hipSuccess) { fprintf(stderr, "kernel_launch: hipFuncSetAttribute failed\n"); grid = -1; return; }
        if (hipOccupancyMaxActiveBlocksPerMultiprocessor(&per_cu, (const void*)mk_fwd, NWAVES * 64, LDS_BYTES) != hipSuccess || per_cu < 1) fprintf(stderr, "kernel_launch: occupancy query reports %d\n", per_cu);
        (void)hipGetLastError();
        grid = cus;
    }
    if (grid < 0) return;
    if (hipMemsetAsync((char*)d_ws + WS_CTL, 0, CTL_ZERO_BYTES, stream) != hipSuccess) return;
    Args a{};
    for (int i = 0; i < 28; ++i) a.in[i] = (const float*)d_in[i];
    a.out = (float*)d_out; a.ws = (unsigned char*)d_ws;
#if MK_ONE_LAUNCH
    a.ph_lo = 0; a.ph_hi = N_PHASES; a.li = 0;
    hipLaunchKernelGGL(mk_fwd, dim3(grid), dim3(NWAVES * 64), LDS_BYTES, stream, a);
#else
    for (int p = 0; p < N_PHASES; ++p) { a.ph_lo = p; a.ph_hi = p + 1; a.li = p; hipLaunchKernelGGL(mk_fwd, dim3(grid), dim3(NWAVES * 64), LDS_BYTES, stream, a); }
#endif
}
```

```cpp
#include <hip/hip_runtime.h>
#include <cstdio>
#include <cstdint>
#define PROBE_MASK 0
namespace pg8 {
#define PG8_LAS __attribute__((address_space(3)))
typedef unsigned short bf16_t;
typedef short bf16x8 __attribute__((ext_vector_type(8)));
typedef float f32x4 __attribute__((ext_vector_type(4)));
typedef unsigned u32x4 __attribute__((ext_vector_type(4)));
constexpr int BM = 256, BK = 64, HALF = 128, HTB = HALF * BK * 2  , STAGE_BYTES = 8 * HTB, NXCD = 8, WGM = 8;

__host__ __device__ __forceinline__ int lds_byte(int r, int c) { const int st = (r >> 4) * 2 + (c >> 5), rr = r & 15, cc = c & 31, ob = rr * 64 + cc * 2; return st * 1024 + (ob ^ (((ob >> 9) & 1) << 5)); }
__host__ __device__ __forceinline__ void stage_rc(int b, int& R, int& C) { const int st = b / 1024, sb = b % 1024, swz = sb ^ (((sb >> 9) & 1) << 5); R = (st >> 1) * 16 + swz / 64; C = (st & 1) * 32 + (swz % 64) / 2; }
__host__ __device__ __forceinline__ int perm32(int rho) { const int n = rho >> 4, i = rho & 15; return 8 * (i >> 2) + 4 * n + (i & 3); }

struct Unit { int pm, pn, r0, cnt, ord; };
struct Gemm { const bf16_t* A; const bf16_t* Bt; int M, N, K, kext; };

struct StaticOrder {
    static constexpr bool GATHER = false;
    __device__ __forceinline__ unsigned a_off(const Unit&, int) const { return 0u; }
    __device__ __forceinline__ size_t koff(const Unit&) const { return 0; }
    __device__ __forceinline__ bool is_mid(const Unit&) const { return false; }
    int nM, nN, nwg, G, c;
    __host__ __device__ void init(int M, int N, int G_, int c_) { nM = M / BM; nN = N / BM; nwg = nM * nN; G = G_; c = c_; }
    __host__ __device__ bool next(int i, Unit& u) const {
        const long L = (long)i * G + c; if (L >= nwg) return false;
        int wgid = (int)L; { const int q = nwg / NXCD, r = nwg % NXCD, xcd = wgid % NXCD, off = wgid / NXCD; wgid = (xcd < r ? xcd * (q + 1) : r * (q + 1) + (xcd - r) * q) + off; }
        const int nig = WGM * nN, gid = wgid / nig, fm = gid * WGM, gsz = (nM - fm) < WGM ? (nM - fm) : WGM;
        u.pm = fm + ((wgid % nig) % gsz); u.pn = (wgid % nig) / gsz; u.r0 = 0; u.cnt = 0; u.ord = i; return true;
    }
    __device__ __forceinline__ void a_ready(const Unit&) const {}
    __device__ __forceinline__ void done(const Unit&) const {}
};

__device__ __forceinline__ unsigned cvt_pk_bf16(float lo, float hi) { unsigned r; asm volatile("v_cvt_pk_bf16_f32 %0, %1, %2" : "=v"(r) : "v"(lo), "v"(hi)); return r; }
typedef float f32x2 __attribute__((ext_vector_type(2)));

struct PanelOrder {
    static constexpr bool GATHER = false;
    int nM, nN, G, c;
    __host__ __device__ void init(int M, int N, int G_, int c_) { nM = M / BM; nN = N / BM; G = G_; c = c_; }
    __device__ __forceinline__ bool next(int i, Unit& u) const { const int p = c + (i / nN) * G; if (p >= nM) return false; u.pm = p; u.pn = i % nN; u.r0 = 0; u.cnt = 0; u.ord = i; return true; }
    __device__ __forceinline__ unsigned a_off(const Unit&, int) const { return 0u; }
    __device__ __forceinline__ size_t koff(const Unit&) const { return 0; }
    __device__ __forceinline__ bool is_mid(const Unit&) const { return false; }
    __device__ __forceinline__ void a_ready(const Unit&) const {}
    __device__ __forceinline__ void done(const Unit&) const {}
};
template <class Base> struct PairOrder {
    static constexpr bool GATHER = false;
    Base base; size_t koff_bytes;
    __device__ __forceinline__ bool next(int i, Unit& u) const { if (!base.next(i >> 1, u)) return false; u.r0 = i & 1; u.cnt = 0; u.ord = i; return true; }
    __device__ __forceinline__ unsigned a_off(const Unit&, int) const { return 0u; }
    __device__ __forceinline__ size_t koff(const Unit& u) const { return u.r0 ? koff_bytes : (size_t)0; }
    __device__ __forceinline__ bool is_mid(const Unit& u) const { return u.r0 == 0; }
    __device__ __forceinline__ void a_ready(const Unit&) const {}
    __device__ __forceinline__ void done(const Unit&) const {}
};
template <class Epi, class Sched, bool ALIGN_EPI = false, bool SP2 = false>
__device__ __forceinline__ void gemm_phase(PG8_LAS unsigned char* lds, const Gemm g, const Sched& S, const Epi& E) {
    const int tid = threadIdx.x, wid = __builtin_amdgcn_readfirstlane(tid >> 6), lane = tid & 63, wr = wid >> 2, wc = wid & 3, fr = lane & 15, fq = lane >> 4;
    const int K = g.K, nt = (g.kext ? g.kext : K) / BK;
    unsigned voffA[2], voffB[2];
#pragma unroll
    for (int i = 0; i < 2; ++i) { int R, C; stage_rc(tid * 16 + i * 8192, R, C); const int Rb = Epi::PERM ? ((R & ~31) + perm32(R & 31)) : R;
        voffA[i] = (unsigned)(R * K + C) * 2u; voffB[i] = (unsigned)(Rb * K + C) * 2u; }
    unsigned gAc[2][2], gAn[2][2]; int gR[2], gC[2];
#pragma unroll
    for (int i = 0; i < 2; ++i) { int R, C; stage_rc(tid * 16 + i * 8192, R, C); gR[i] = R; gC[i] = C * 2; gAc[0][i] = gAc[1][i] = gAn[0][i] = gAn[1][i] = 0u; }
    const size_t kstep = (size_t)(BK * 2);
    const size_t hstep = (size_t)HALF * K * 2;
    const size_t hstepA = Sched::GATHER ? (size_t)0 : hstep;
    const size_t tstep = 2 * hstep;
    const unsigned ldsw = (unsigned)wid * 1024u;
    const int aoff = lds_byte(wr * 64 + fr, fq * 8), boff = lds_byte(wc * 32 + fr, fq * 8);
#define PG8_SA(b, h) (((b) * 2 + (h)) * HTB)
#define PG8_SB(b, h) ((4 + (b) * 2 + (h)) * HTB)
#define PG8_STAGE(bufoff, gbase, voff) do { _Pragma("unroll") for (int _i = 0; _i < 2; ++_i) \
        __builtin_amdgcn_global_load_lds((const unsigned*)((const char*)(gbase) + (voff)[_i]), (PG8_LAS unsigned*)(lds + (bufoff) + ldsw + _i * 8192), 16, 0, 0); } while (0)
#define PG8_LDA(dst, b, h) do { _Pragma("unroll") for (int m = 0; m < 4; ++m) _Pragma("unroll") for (int k = 0; k < 2; ++k) dst[m][k] = *(const PG8_LAS bf16x8*)(lds + PG8_SA(b, h) + aoff + m * 2048 + k * 1024); } while (0)
#define PG8_LDB(dst, b, h) do { _Pragma("unroll") for (int n = 0; n < 2; ++n) _Pragma("unroll") for (int k = 0; k < 2; ++k) dst[n][k] = *(const PG8_LAS bf16x8*)(lds + PG8_SB(b, h) + boff + n * 2048 + k * 1024); } while (0)
#define PG8_MMA(ai, bj, At, Bt) do { __builtin_amdgcn_s_setprio(1); _Pragma("unroll") for (int m = 0; m < 4; ++m) _Pragma("unroll") for (int n = 0; n < 2; ++n) _Pragma("unroll") for (int k = 0; k < 2; ++k) \
        acc[ai][bj][m][n] = __builtin_amdgcn_mfma_f32_16x16x32_bf16(Bt[n][k], At[m][k], acc[ai][bj][m][n], 0, 0, 0); __builtin_amdgcn_s_setprio(0); } while (0)
#define PG8_WAIT_V(n) asm volatile("s_waitcnt vmcnt(" #n ")" ::: "memory")
#define PG8_WAIT_L(n) asm volatile("s_waitcnt lgkmcnt(" #n ")" ::: "memory")
#define PG8_BAR __builtin_amdgcn_s_barrier()
#define PG8_SCHED __builtin_amdgcn_sched_barrier(0)
    Unit cur, nxt; int ui = 0;
    if (!S.next(0, cur)) return;
    f32x4 acc[2][2][4][2];
#pragma unroll
    for (int a = 0; a < 2; ++a)
#pragma unroll
        for (int b = 0; b < 2; ++b)
#pragma unroll
            for (int m = 0; m < 4; ++m)
#pragma unroll
                for (int n = 0; n < 2; ++n) acc[a][b][m][n] = (f32x4){0.f, 0.f, 0.f, 0.f};
    bf16x8 At[4][2], B0[2][2], B1[2][2];
    const char* cA = (const char*)g.A + (Sched::GATHER ? (size_t)0 : (size_t)cur.pm * tstep) + S.koff(cur); const char* cB = (const char*)g.Bt + (size_t)cur.pn * tstep + S.koff(cur);
    if constexpr (Sched::GATHER) {
#pragma unroll
        for (int h = 0; h < 2; ++h)
#pragma unroll
            for (int i = 0; i < 2; ++i) gAc[h][i] = S.a_off(cur, h * HALF + gR[i]) + (unsigned)gC[i]; }
#define PG8_VA(sel, h) (Sched::GATHER ? (sel)[h] : voffA)
    S.a_ready(cur);
    if constexpr (SP2) {
        PG8_STAGE(PG8_SB(0, 0), cB, voffB); PG8_STAGE(PG8_SB(0, 1), cB + hstep, voffB); PG8_STAGE(PG8_SA(0, 0), cA, PG8_VA(gAc, 0)); PG8_STAGE(PG8_SA(0, 1), cA + hstepA, PG8_VA(gAc, 1));
        if (wr == 1) PG8_BAR;
        PG8_WAIT_V(2); PG8_BAR;
        PG8_STAGE(PG8_SB(1, 0), cB + kstep, voffB); PG8_STAGE(PG8_SA(1, 0), cA + kstep, PG8_VA(gAc, 0)); PG8_STAGE(PG8_SB(1, 1), cB + hstep + kstep, voffB);
        PG8_WAIT_V(6); PG8_BAR;
    } else {
        PG8_STAGE(PG8_SB(0, 0), cB, voffB); PG8_STAGE(PG8_SA(0, 0), cA, voffA); PG8_STAGE(PG8_SB(0, 1), cB + hstep, voffB); PG8_STAGE(PG8_SA(0, 1), cA + hstep, voffA);
        if (wr == 1) PG8_BAR;
        PG8_WAIT_V(4); PG8_BAR;
        PG8_STAGE(PG8_SB(1, 0), cB + kstep, voffB); PG8_STAGE(PG8_SA(1, 0), cA + kstep, voffA); PG8_STAGE(PG8_SB(1, 1), cB + hstep + kstep, voffB);
        PG8_WAIT_V(6); PG8_BAR;
    }
    for (;;) {
        const bool has_next = S.next(ui + 1, nxt);
        const char* nA = (has_next && !Sched::GATHER) ? (const char*)g.A + (size_t)nxt.pm * tstep + S.koff(nxt) : cA; const char* nB = has_next ? (const char*)g.Bt + (size_t)nxt.pn * tstep + S.koff(nxt) : cB;
        if constexpr (Sched::GATHER) {
#pragma unroll
            for (int h = 0; h < 2; ++h)
#pragma unroll
                for (int i = 0; i < 2; ++i) gAn[h][i] = has_next ? S.a_off(nxt, h * HALF + gR[i]) + (unsigned)gC[i] : gAc[h][i]; }
#pragma unroll 1
        for (int t = 0; t < nt; t += 2) {
            const bool last = (t == nt - 2);
            const char* a1 = cA + (size_t)(t + 1) * kstep;
            const char* a2 = last ? nA : cA + (size_t)(t + 2) * kstep; const char* b2 = last ? nB : cB + (size_t)(t + 2) * kstep;
            const char* a3 = a2 + kstep; const char* b3 = b2 + kstep;
            if (last && has_next) S.a_ready(nxt);
            unsigned g2[2][2];
#pragma unroll
            for (int h = 0; h < 2; ++h)
#pragma unroll
                for (int i = 0; i < 2; ++i) g2[h][i] = last ? gAn[h][i] : gAc[h][i];
            if constexpr (SP2) {
            PG8_LDB(B0, 0, 0); PG8_LDB(B1, 0, 1); PG8_SCHED; PG8_LDA(At, 0, 0); PG8_STAGE(PG8_SA(1, 1), a1 + hstepA, PG8_VA(gAc, 1));
            PG8_WAIT_V(8); PG8_WAIT_L(0); PG8_BAR; PG8_MMA(0, 0, At, B0); PG8_MMA(0, 1, At, B1); PG8_BAR; PG8_SCHED;
            PG8_LDA(At, 0, 1); PG8_STAGE(PG8_SB(0, 0), b2, voffB); PG8_STAGE(PG8_SB(0, 1), b2 + hstep, voffB); PG8_STAGE(PG8_SA(0, 0), a2, PG8_VA(g2, 0));
            PG8_WAIT_V(8); PG8_WAIT_L(0); PG8_BAR; PG8_MMA(1, 0, At, B0); PG8_MMA(1, 1, At, B1); PG8_BAR; PG8_SCHED;
            PG8_LDB(B0, 1, 0); PG8_LDB(B1, 1, 1); PG8_SCHED; PG8_LDA(At, 1, 0); PG8_STAGE(PG8_SA(0, 1), a2 + hstepA, PG8_VA(g2, 1));
            PG8_WAIT_V(8); PG8_WAIT_L(0); PG8_BAR; PG8_MMA(0, 0, At, B0); PG8_MMA(0, 1, At, B1); PG8_BAR; PG8_SCHED;
            PG8_LDA(At, 1, 1); PG8_STAGE(PG8_SB(1, 0), b3, voffB); PG8_STAGE(PG8_SB(1, 1), b3 + hstep, voffB); PG8_STAGE(PG8_SA(1, 0), a3, PG8_VA(g2, 0));
            PG8_WAIT_V(8); PG8_WAIT_L(0); PG8_BAR; PG8_MMA(1, 0, At, B0); PG8_MMA(1, 1, At, B1); PG8_BAR; PG8_SCHED;
            } else {
            PG8_LDB(B0, 0, 0); PG8_SCHED; PG8_LDA(At, 0, 0); PG8_STAGE(PG8_SA(1, 1), a1 + hstep, voffA);
            PG8_WAIT_L(8); PG8_BAR; PG8_WAIT_L(0); PG8_MMA(0, 0, At, B0); PG8_BAR; PG8_SCHED;
            PG8_LDB(B1, 0, 1); PG8_STAGE(PG8_SB(0, 0), b2, voffB);
            PG8_BAR; PG8_WAIT_L(0); PG8_MMA(0, 1, At, B1); PG8_BAR;
            PG8_LDA(At, 0, 1); PG8_STAGE(PG8_SA(0, 0), a2, voffA);
            PG8_BAR; PG8_WAIT_L(0); PG8_MMA(1, 0, At, B0); PG8_BAR; PG8_SCHED;
            PG8_STAGE(PG8_SB(0, 1), b2 + hstep, voffB);
            PG8_WAIT_V(6); PG8_BAR; PG8_MMA(1, 1, At, B1); PG8_BAR;
            PG8_LDB(B0, 1, 0); PG8_SCHED; PG8_LDA(At, 1, 0); PG8_STAGE(PG8_SA(0, 1), a2 + hstep, voffA);
            PG8_WAIT_L(8); PG8_BAR; PG8_WAIT_L(0); PG8_MMA(0, 0, At, B0); PG8_BAR; PG8_SCHED;
            PG8_LDB(B1, 1, 1); PG8_STAGE(PG8_SB(1, 0), b3, voffB);
            PG8_BAR; PG8_WAIT_L(0); PG8_MMA(0, 1, At, B1); PG8_BAR;
            PG8_LDA(At, 1, 1); PG8_STAGE(PG8_SA(1, 0), a3, voffA);
            PG8_BAR; PG8_WAIT_L(0); PG8_MMA(1, 0, At, B0); PG8_BAR; PG8_SCHED;
            PG8_STAGE(PG8_SB(1, 1), b3 + hstep, voffB);
            PG8_WAIT_V(6); PG8_BAR; PG8_MMA(1, 1, At, B1); PG8_BAR;
            }
        }
        if constexpr (ALIGN_EPI) { if (wr == 0) PG8_BAR; }
        bool keep_acc = false;
        if constexpr (Epi::MIDK) { if (S.is_mid(cur)) { E.mid(acc, cur, wr, wc, fr, fq); keep_acc = true; } else E(acc, cur, wr, wc, fr, fq); }
        else if constexpr (!Epi::AFTER_DRAIN) { E(acc, cur, wr, wc, fr, fq);
#ifdef PROBE_EPI2
            if constexpr (Epi::PROBE2) { asm volatile("" ::: "memory"); E(acc, cur, wr, wc, fr, fq); }
#endif
            S.done(cur); }
        if (!has_next) break;
        if (!keep_acc)
#pragma unroll
        for (int a = 0; a < 2; ++a)
#pragma unroll
            for (int b = 0; b < 2; ++b)
#pragma unroll
                for (int m = 0; m < 4; ++m)
#pragma unroll
                    for (int n = 0; n < 2; ++n) acc[a][b][m][n] = (f32x4){0.f, 0.f, 0.f, 0.f};
        cur = nxt; cA = nA; cB = nB; ++ui;
        if constexpr (Sched::GATHER) {
#pragma unroll
            for (int h = 0; h < 2; ++h)
#pragma unroll
                for (int i = 0; i < 2; ++i) gAc[h][i] = gAn[h][i]; }
        if constexpr (ALIGN_EPI) { if (wr == 1) PG8_BAR; }
    }
    PG8_WAIT_V(0);
    if constexpr (!ALIGN_EPI) { if (wr == 0) PG8_BAR; }
    PG8_BAR;
    if constexpr (Epi::AFTER_DRAIN) { E.fused(acc, cur, wr, wc, fr, fq, lds, wid, lane); S.done(cur); }
#undef PG8_SA
#undef PG8_VA
#undef PG8_SB
#undef PG8_STAGE
#undef PG8_LDA
#undef PG8_LDB
#undef PG8_MMA
#undef PG8_WAIT_V
#undef PG8_WAIT_L
#undef PG8_BAR
#undef PG8_SCHED
}

__device__ __forceinline__ float sigm(float x) { return __builtin_amdgcn_rcpf(1.0f + __builtin_amdgcn_exp2f(-1.44269504089f * x)); }
__device__ __forceinline__ f32x4 up_lo(u32x4 w) { f32x4 r; r[0] = __uint_as_float(w[0] << 16); r[1] = __uint_as_float(w[0] & 0xffff0000u); r[2] = __uint_as_float(w[1] << 16); r[3] = __uint_as_float(w[1] & 0xffff0000u); return r; }
__device__ __forceinline__ f32x4 up_hi(u32x4 w) { f32x4 r; r[0] = __uint_as_float(w[2] << 16); r[1] = __uint_as_float(w[2] & 0xffff0000u); r[2] = __uint_as_float(w[3] << 16); r[3] = __uint_as_float(w[3] & 0xffff0000u); return r; }
__device__ __forceinline__ u32x4 pack8(f32x4 v0, f32x4 v1) { u32x4 w; w.x = cvt_pk_bf16(v0[0], v0[1]); w.y = cvt_pk_bf16(v0[2], v0[3]); w.z = cvt_pk_bf16(v1[0], v1[1]); w.w = cvt_pk_bf16(v1[2], v1[3]); return w; }

struct EpiIn {
    static constexpr bool PERM = true, AFTER_DRAIN = false, MIDK = false, PROBE2 = true;
    bf16_t *Q, *Kb, *Vb, *RC, *G;
    __device__ __forceinline__ void operator()(const f32x4 (&acc)[2][2][4][2], const Unit& u, int wr, int wc, int fr, int fq) const {
        const int row0 = u.pm * BM + wr * 64 + fr, cl = wc * 32 + 8 * fq;
        bf16_t* b0; bf16_t* b1; int ld; const int pn = u.pn;
        if (pn < 2) { ld = 512; b0 = Q + pn * 256 + cl; b1 = b0 + 128; }
        else if (pn == 2) { ld = 128; b0 = Kb + cl; b1 = Vb + cl; }
        else if (pn < 10) { ld = 1792; b0 = RC + (pn - 3) * 256 + cl; b1 = b0 + 128; }
        else { ld = 2048; b0 = G + (pn - 10) * 128 + cl; b1 = b0 + 1024; }
        const bool sg = pn >= 10;
#pragma unroll
        for (int ai = 0; ai < 2; ++ai)
#pragma unroll
            for (int m = 0; m < 4; ++m) { const int row = row0 + ai * HALF + m * 16;
                f32x4 a0 = acc[ai][0][m][0], a1 = acc[ai][0][m][1], c0 = acc[ai][1][m][0], c1 = acc[ai][1][m][1];
                if (sg) {
#pragma unroll
                    for (int j = 0; j < 4; ++j) { const float ea0 = __builtin_amdgcn_exp2f(-1.44269504089f * a0[j]), ea1 = __builtin_amdgcn_exp2f(-1.44269504089f * a1[j]), eb0 = __builtin_amdgcn_exp2f(-1.44269504089f * c0[j]), eb1 = __builtin_amdgcn_exp2f(-1.44269504089f * c1[j]);
                        a0[j] = (1.0f + eb0) * __builtin_amdgcn_rcpf(1.0f + ea0); a1[j] = (1.0f + eb1) * __builtin_amdgcn_rcpf(1.0f + ea1); c0[j] = __builtin_amdgcn_rcpf(1.0f + eb0); c1[j] = __builtin_amdgcn_rcpf(1.0f + eb1); } }
                *(u32x4*)(b0 + (size_t)row * ld) = pack8(a0, a1); *(u32x4*)(b1 + (size_t)row * ld) = pack8(c0, c1); }
    }
};
struct EpiGate2 {
    static constexpr bool PERM = true, AFTER_DRAIN = false, MIDK = true;
    const bf16_t* G; bf16_t* O;
    __device__ __forceinline__ void mid(f32x4 (&acc)[2][2][4][2], const Unit& u, int wr, int wc, int fr, int fq) const {
        const int row0 = u.pm * BM + wr * 64 + fr, col0 = u.pn * BM + wc * 32 + 8 * fq;
        u32x4 g0w[2][4][2];
#pragma unroll
        for (int ai = 0; ai < 2; ++ai)
#pragma unroll
            for (int m = 0; m < 4; ++m)
#pragma unroll
                for (int bj = 0; bj < 2; ++bj) g0w[ai][m][bj] = *(const u32x4*)(G + (size_t)(row0 + ai * HALF + m * 16) * 2048 + col0 + bj * HALF);
#pragma unroll
        for (int ai = 0; ai < 2; ++ai)
#pragma unroll
            for (int m = 0; m < 4; ++m)
#pragma unroll
                for (int bj = 0; bj < 2; ++bj)
#pragma unroll
                    for (int j = 0; j < 4; ++j) { const unsigned gn = g0w[ai][m][bj][j];
                        acc[ai][bj][m][j >> 1][2 * (j & 1)] *= __uint_as_float(gn << 16); acc[ai][bj][m][j >> 1][2 * (j & 1) + 1] *= __uint_as_float(gn & 0xffff0000u); }
    }
    __device__ __forceinline__ void operator()(const f32x4 (&acc)[2][2][4][2], const Unit& u, int wr, int wc, int fr, int fq) const {
        const int row0 = u.pm * BM + wr * 64 + fr, col0 = u.pn * BM + wc * 32 + 8 * fq;
        u32x4 gw[2][4][2];
#pragma unroll
        for (int ai = 0; ai < 2; ++ai)
#pragma unroll
            for (int m = 0; m < 4; ++m)
#pragma unroll
                for (int bj = 0; bj < 2; ++bj) gw[ai][m][bj] = *(const u32x4*)(G + (size_t)(row0 + ai * HALF + m * 16) * 2048 + 1024 + col0 + bj * HALF);
#pragma unroll
        for (int ai = 0; ai < 2; ++ai)
#pragma unroll
            for (int m = 0; m < 4; ++m)
#pragma unroll
                for (int bj = 0; bj < 2; ++bj) *(u32x4*)(O + (size_t)(row0 + ai * HALF + m * 16) * 1024 + col0 + bj * HALF) = pack8(acc[ai][bj][m][0] * up_lo(gw[ai][m][bj]), acc[ai][bj][m][1] * up_hi(gw[ai][m][bj]));
    }
};
struct EpiRes {
    static constexpr bool PERM = true, AFTER_DRAIN = false, MIDK = false, PROBE2 = false;
    const float* X; bf16_t* O;
    __device__ __forceinline__ void operator()(const f32x4 (&acc)[2][2][4][2], const Unit& u, int wr, int wc, int fr, int fq) const {
        const int row0 = u.pm * BM + wr * 64 + fr, col0 = u.pn * BM + wc * 32 + 8 * fq;
#pragma unroll
        for (int ai = 0; ai < 2; ++ai) { f32x4 xv[4][2][2];
#pragma unroll
            for (int m = 0; m < 4; ++m)
#pragma unroll
                for (int bj = 0; bj < 2; ++bj)
#pragma unroll
                    for (int n = 0; n < 2; ++n) xv[m][bj][n] = *(const f32x4*)(X + (size_t)(row0 + ai * HALF + m * 16) * 1024 + col0 + bj * HALF + 4 * n);
#pragma unroll
            for (int m = 0; m < 4; ++m)
#pragma unroll
                for (int bj = 0; bj < 2; ++bj) *(u32x4*)(O + (size_t)(row0 + ai * HALF + m * 16) * 1024 + col0 + bj * HALF) = pack8(xv[m][bj][0] + acc[ai][bj][m][0], xv[m][bj][1] + acc[ai][bj][m][1]);
            asm volatile("" ::: "memory"); }
    }
};
template <bool GATHER_> struct GroupedOrder {
    static constexpr bool GATHER = GATHER_;
    const PG8_LAS int* tile_e; const PG8_LAS int* tb; int ntiles, ntn, G, c; const PG8_LAS int* lds_d; unsigned rowbytes;
    __device__ __forceinline__ bool next(int i, Unit& u) const {
        const int L = i * G + c; if (L >= ntiles * ntn) return false;
        const int mt = L / ntn, nl = L - mt * ntn; const int e = __builtin_amdgcn_readfirstlane(tile_e[mt]);
        u.pm = mt; u.pn = e * ntn + nl; u.r0 = __builtin_amdgcn_readfirstlane((mt - tb[e]) * BM); u.cnt = __builtin_amdgcn_readfirstlane(tb[33 + e]); u.ord = i; return true;
    }
    __device__ __forceinline__ unsigned a_off(const Unit& u, int r) const {
        const int d = lds_d[u.ord * BM + r]; const int tok = d >= 0 ? (d >> 1) : 0;
        return (unsigned)tok * rowbytes;
    }
    __device__ __forceinline__ size_t koff(const Unit&) const { return 0; }
    __device__ __forceinline__ bool is_mid(const Unit&) const { return false; }
    __device__ __forceinline__ void a_ready(const Unit&) const {}
    __device__ __forceinline__ void done(const Unit&) const {}
};
struct EpiSwiglu {
    static constexpr bool PERM = true, AFTER_DRAIN = false, MIDK = false, PROBE2 = false;
    bf16_t* H; const PG8_LAS int* lds_d; const PG8_LAS float* lds_w; const PG8_LAS float* lds_r; int* slot_dst;
    __device__ __forceinline__ void operator()(const f32x4 (&acc)[2][2][4][2], const Unit& u, int wr, int wc, int fr, int fq) const {
        const int rl0 = wr * 64 + fr, row0 = u.pm * BM + rl0, col0 = (u.pn & 1) * 128 + wc * 32 + 8 * fq;
        const bool slots = (u.pn & 1) == 0 && wc == 0 && fq == 0;
        int ld8[2][4]; float lw8[2][4], lr8[2][4];
#pragma unroll
        for (int ai = 0; ai < 2; ++ai)
#pragma unroll
            for (int m = 0; m < 4; ++m) { const int rl = u.ord * BM + rl0 + ai * HALF + m * 16; ld8[ai][m] = lds_d[rl]; lw8[ai][m] = lds_w[rl]; lr8[ai][m] = lds_r[rl]; }
        if (slots) {
#pragma unroll
            for (int ai = 0; ai < 2; ++ai)
#pragma unroll
                for (int m = 0; m < 4; ++m) slot_dst[row0 + ai * HALF + m * 16] = ld8[ai][m]; }
#pragma unroll
        for (int ai = 0; ai < 2; ++ai)
#pragma unroll
            for (int m = 0; m < 4; ++m) { const int row = row0 + ai * HALF + m * 16;
                if (ld8[ai][m] >= 0) { f32x4 v0, v1; const float w = lw8[ai][m], rs = lr8[ai][m];
#pragma unroll
                    for (int j = 0; j < 4; ++j) { const float g0 = acc[ai][0][m][0][j], g1 = acc[ai][0][m][1][j]; v0[j] = w * g0 * sigm(rs * g0) * acc[ai][1][m][0][j]; v1[j] = w * g1 * sigm(rs * g1) * acc[ai][1][m][1][j]; }
                    *(u32x4*)(H + (size_t)row * 256 + col0) = pack8(v0, v1); } }
    }
};
struct EpiDown {
    static constexpr bool PERM = true, AFTER_DRAIN = false, MIDK = false, PROBE2 = false;
    unsigned char* Y; const PG8_LAS int* lds_slot;
    __device__ __forceinline__ static unsigned pk4(float a, float b, float c, float d) { int w = 0; w = __builtin_amdgcn_cvt_pk_fp8_f32(a * 16.f, b * 16.f, w, false); w = __builtin_amdgcn_cvt_pk_fp8_f32(c * 16.f, d * 16.f, w, true); return (unsigned)w; }
    __device__ __forceinline__ void operator()(const f32x4 (&acc)[2][2][4][2], const Unit& u, int wr, int wc, int fr, int fq) const {
        const int row0 = u.pm * BM + wr * 64 + fr, col0 = (u.pn & 3) * 256 + wc * 32 + 8 * fq;
        int dsts[2][4];
#pragma unroll
        for (int ai = 0; ai < 2; ++ai)
#pragma unroll
            for (int m = 0; m < 4; ++m) dsts[ai][m] = lds_slot[u.ord * BM + wr * 64 + fr + ai * HALF + m * 16];
        typedef unsigned u32x2 __attribute__((ext_vector_type(2)));
#pragma unroll
        for (int ai = 0; ai < 2; ++ai)
#pragma unroll
            for (int m = 0; m < 4; ++m) { const int dst = dsts[ai][m];
                if (dst >= 0) {
#pragma unroll
                    for (int bj = 0; bj < 2; ++bj) { const f32x4 v0 = acc[ai][bj][m][0], v1 = acc[ai][bj][m][1]; u32x2 w; w.x = pk4(v0[0], v0[1], v0[2], v0[3]); w.y = pk4(v1[0], v1[1], v1[2], v1[3]);
                        *(u32x2*)(Y + (size_t)dst * 1024 + col0 + bj * HALF) = w; } } }
    }
};
}

constexpr int NWAVES = 8;
constexpr int D = 1024, NB = 8, SEQ = 8192, M = NB * SEQ, NMETA = 16, MV = M + NMETA;
constexpr int IN_COLS = 4608, RCW = 1792;
constexpr int NE = 32, TT_MAX = 544, CAP = TT_MAX * 256, LCAP = 65536;
constexpr int N_PHASES = 12;
#ifndef MK_ONE_LAUNCH
#define MK_ONE_LAUNCH 1
#endif

constexpr size_t MiB = 1u << 20;
constexpr size_t WS_CTL = 0, CTL_ZERO_BYTES = 96 * 1024;
constexpr size_t WS_RSTD = 1 * MiB, WS_METAP = 1 * MiB + 512 * 1024, WS_SLOTD = 3 * MiB, WS_SLOTW = 4 * MiB;
constexpr size_t WS_WIN = 6 * MiB, WS_WOA = 15 * MiB, WS_WOR = 16 * MiB, WS_WOUT = 17 * MiB, WS_WGU = 19 * MiB, WS_WDN = 51 * MiB;
constexpr size_t WS_LISTD = 68 * MiB, WS_LISTW = 76 * MiB, WS_LISTR = 84 * MiB;
constexpr size_t WS_XB = 96 * MiB, WS_Q = 224 * MiB, WS_K = 288 * MiB, WS_V = 305 * MiB, WS_RC = 352 * MiB, WS_AR = 96 * MiB;
constexpr size_t WS_GB = 224 * MiB, WS_POST = 288 * MiB, WS_MG = 416 * MiB;
constexpr size_t WS_XN2 = 96 * MiB, WS_XG = 224 * MiB, WS_HMID = 496 * MiB, WS_Y = 611 * MiB, WS_END = 1024 * MiB;
static_assert(WS_Y + (size_t)2 * M * D * 2 <= WS_END && WS_HMID + (size_t)CAP * 256 * 2 <= 611 * MiB && WS_RC + (size_t)MV * RCW * 2 <= 611 * MiB, "ws map");
constexpr int CW_BAR = 4096;
constexpr int CW_GCNT = 16384;

constexpr int LDS_BYTES = 163840;
constexpr int LDS_RT = 147456, LDS_TBL = 159744, LDS_MISC = 163328;

#define LAS __attribute__((address_space(3)))
typedef unsigned short bf16;
typedef unsigned v4u __attribute__((ext_vector_type(4)));
typedef unsigned v2u __attribute__((ext_vector_type(2)));
typedef float f32x4 __attribute__((ext_vector_type(4)));
#define DI __device__ __forceinline__
#define LDS_WAIT() asm volatile("s_waitcnt lgkmcnt(0)" ::: "memory")
#define LDS_BARRIER() asm volatile("s_waitcnt lgkmcnt(0)\n\ts_barrier" ::: "memory")
typedef float f32x2_t __attribute__((ext_vector_type(2)));
typedef __bf16 bf16x2_t __attribute__((ext_vector_type(2)));
DI unsigned pk2(float lo, float hi) { const f32x2_t v = {lo, hi}; const bf16x2_t b = __builtin_convertvector(v, bf16x2_t); return __builtin_bit_cast(unsigned, b); }
DI unsigned f2bf(float f) { return pk2(f, 0.f) & 0xffffu; }
DI float bf2f(bf16 b) { return __uint_as_float((unsigned)b << 16); }
DI float xsum32(float v) { const auto r = __builtin_amdgcn_permlane32_swap(__float_as_uint(v), __float_as_uint(v), false, false); return __uint_as_float(r[0]) + __uint_as_float(r[1]); }
DI float xmax32(float v) { const auto r = __builtin_amdgcn_permlane32_swap(__float_as_uint(v), __float_as_uint(v), false, false); return fmaxf(__uint_as_float(r[0]), __uint_as_float(r[1])); }
DI float xsum16(float v) { const auto r = __builtin_amdgcn_permlane16_swap(__float_as_uint(v), __float_as_uint(v), false, false); return __uint_as_float(r[0]) + __uint_as_float(r[1]); }
DI float wave_sum(float v) {
    v += __int_as_float(__builtin_amdgcn_update_dpp(0, __float_as_int(v), 0xB1, 0xF, 0xF, true));
    v += __int_as_float(__builtin_amdgcn_update_dpp(0, __float_as_int(v), 0x4E, 0xF, 0xF, true));
    v += __int_as_float(__builtin_amdgcn_update_dpp(0, __float_as_int(v), 0x141, 0xF, 0xF, true));
    v += __int_as_float(__builtin_amdgcn_update_dpp(0, __float_as_int(v), 0x140, 0xF, 0xF, true));
    return xsum32(xsum16(v));
}
DI float wave_max(float v) {
#pragma unroll
    for (int o = 1; o < 64; o <<= 1) v = fmaxf(v, __shfl_xor(v, o));
    return v;
}
DI float sigmoid_f(float x) { return __builtin_amdgcn_rcpf(1.0f + __builtin_amdgcn_exp2f(-1.44269504089f * x)); }

#define XB_TMO      128
#define XB_XCNT(j)  (256  + 64 * (j))
#define XB_XSUB(j)  (1280 + 64 * (j))
#define XB_XGEN(j)  (2304 + 64 * (j))
#define XB_TOP      3328
#define XB_TOPGEN   3392
#define XCD_BAR_WORDS 3456
#define XB_SPIN_CAP (1u << 20)
DI unsigned xb_ld(unsigned* p)              { return __hip_atomic_load(p, __ATOMIC_RELAXED, __HIP_MEMORY_SCOPE_AGENT); }
DI unsigned xb_add(unsigned* p, unsigned v) { return __hip_atomic_fetch_add(p, v, __ATOMIC_RELAXED, __HIP_MEMORY_SCOPE_AGENT); }
DI unsigned xb_xcc_id() { return (unsigned)__builtin_amdgcn_s_getreg((3 << 11) | 20) & 0xFu; }
#define XB_SPIN(cond, bar) do { unsigned _sp = 0; while (cond) { __builtin_amdgcn_s_sleep(1); \
    if ((++_sp & 255u) == 0u) { if (xb_ld(&(bar)[XB_TMO])) break; if (_sp > XB_SPIN_CAP) { atomicAdd(&(bar)[XB_TMO], 1u); break; } } } } while (0)
struct XcdBarrier { unsigned* bar; unsigned x; volatile LAS unsigned* st; };
DI XcdBarrier xcd_barrier_post(unsigned* bar, volatile LAS unsigned* st) {
    XcdBarrier b; b.bar = bar; b.x = xb_xcc_id(); b.st = st;
    if (threadIdx.x == 0) (void)xb_add(&bar[XB_XCNT(b.x)], 1u);
    return b;
}
DI void xcd_barrier_complete(unsigned* bar, unsigned x, unsigned& nloc, unsigned& nx) {
    const unsigned G = gridDim.x * gridDim.y * gridDim.z;
    unsigned sum, cnt, mine, sp = 0u;
    for (;;) {
        sum = 0u; cnt = 0u; mine = 0u;
#pragma unroll
        for (unsigned j = 0; j < 16; ++j) { const unsigned c = xb_ld(&bar[XB_XCNT(j)]); sum += c; cnt += (c > 0u) ? 1u : 0u; mine = (j == x) ? c : mine; }
        if (sum == G) break;
        __builtin_amdgcn_s_sleep(1);
        if ((++sp & 255u) == 0u) { if (xb_ld(&bar[XB_TMO])) break; if (sp > XB_SPIN_CAP) { atomicAdd(&bar[XB_TMO], 1u); break; } }
    }
    nloc = mine > 0u ? mine : 1u; nx = cnt > 0u ? cnt : 1u;
}
DI void xcd_barrier(const XcdBarrier& b) {
    asm volatile("s_waitcnt vmcnt(0)" ::: "memory");
    __syncthreads();
    if (threadIdx.x == 0) {
        unsigned* bar = b.bar;
        __builtin_amdgcn_s_waitcnt(0);
        unsigned nloc = b.st[0], nx = b.st[1];
        if (nloc == 0u) { xcd_barrier_complete(bar, b.x, nloc, nx); b.st[0] = nloc; b.st[1] = nx; }
        const unsigned old = xb_add(&bar[XB_XSUB(b.x)], 1u);
        const unsigned gen = old / nloc;
        if (old + 1u == (gen + 1u) * nloc) {
            __builtin_amdgcn_fence(__ATOMIC_RELEASE, "agent");
            asm volatile("s_waitcnt vmcnt(0)" ::: "memory");
            const unsigned og = xb_add(&bar[XB_TOP], 1u);
            const unsigned tg = og / nx;
            if (og + 1u == (tg + 1u) * nx) xb_add(&bar[XB_TOPGEN], 1u);
            else XB_SPIN(xb_ld(&bar[XB_TOPGEN]) == tg, bar);
            __builtin_amdgcn_fence(__ATOMIC_ACQUIRE, "agent");
            xb_add(&bar[XB_XGEN(b.x)], 1u);
            asm volatile("s_waitcnt vmcnt(0)" ::: "memory");
        } else {
            XB_SPIN(xb_ld(&bar[XB_XGEN(b.x)]) == gen, bar);
            __builtin_amdgcn_fence(__ATOMIC_ACQUIRE, "agent");
            asm volatile("s_waitcnt vmcnt(0)" ::: "memory");
        }
    }
    __syncthreads();
}

struct Args { const float* in[28]; float* out; unsigned char* ws; int ph_lo, ph_hi, li, pad; };
struct Frame {
    LAS unsigned char* lds;
    unsigned* ctl;
    int tid, lane, wave, G;
    float* out; unsigned char* ws;
};
enum { I_X = 0, I_META, I_NMG, I_WIN, I_MU, I_W0, I_WD, I_A0, I_WA, I_WG, I_KK, I_KA, I_RK, I_LNG, I_LNB, I_SINK, I_WOA, I_WOR, I_WOUT, I_NFG, I_WGRP, I_BGRP, I_WEXP, I_BEXP, I_EG, I_EU, I_ED, I_NFIN };

DI void transpose_item(const float* W, int ldw, int K, bf16* WT, int k0, int n0, int drow0, const float* kscale, float nscale, LAS float* scr, int lane) {
    float wv[32];
#pragma unroll
    for (int i = 0; i < 32; ++i) { const int kk = 2 * i + (lane >> 5); wv[i] = W[(size_t)(k0 + kk) * ldw + n0 + (lane & 31)]; }
#pragma unroll
    for (int i = 0; i < 32; ++i) { const int kk = 2 * i + (lane >> 5); float v = wv[i]; if (kscale) v *= kscale[k0 + kk]; scr[kk * 33 + (lane & 31)] = v * nscale; }
    LDS_WAIT(); asm volatile("" ::: "memory");
    const int c = lane & 7;
#pragma unroll
    for (int j = 0; j < 4; ++j) { const int n = (lane >> 3) + 8 * j; const LAS float* s = scr + (8 * c) * 33 + n;
        v4u o; o.x = pk2(s[0 * 33], s[1 * 33]); o.y = pk2(s[2 * 33], s[3 * 33]); o.z = pk2(s[4 * 33], s[5 * 33]); o.w = pk2(s[6 * 33], s[7 * 33]);
        *(v4u*)(WT + (size_t)(drow0 + n) * K + k0 + 8 * c) = o; }
    LDS_WAIT(); asm volatile("" ::: "memory");
}
DI void expert_weights(Frame& F, const Args& A, int wg0) {
    if ((int)blockIdx.x < wg0) return;
    LAS float* scr = (LAS float*)(F.lds + F.wave * 16384);
    unsigned char* ws = F.ws;
    constexpr int I_G = 32 * 16 * 8, I_U = I_G, I_DN = 32 * 4 * 32;
    const int gw = ((int)blockIdx.x - wg0) * NWAVES + F.wave, NGW = (F.G - wg0) * NWAVES;
    for (int it = gw; it < I_G + I_U + I_DN; it += NGW) {
        int r = it;
        if (r < I_G + I_U) { const int up = r >= I_G; if (up) r -= I_G; const int e = r / 128, q = r % 128, kb = q / 8, nb = q % 8, n0 = 32 * nb;
            transpose_item(A.in[up ? I_EU : I_EG] + (size_t)e * 1024 * 256, 256, 1024, (bf16*)(ws + WS_WGU), 64 * kb, n0, e * 512 + (n0 >> 7) * 256 + up * 128 + (n0 & 127), A.in[I_NFG], 1.0f, scr, F.lane); continue; } r -= I_G + I_U;
        { const int e = r / 128, q = r % 128, kb = q / 32, nb = q % 32; transpose_item(A.in[I_ED] + (size_t)e * 256 * 1024, 1024, 256, (bf16*)(ws + WS_WDN), 64 * kb, 32 * nb, e * 1024 + 32 * nb, nullptr, 1.0f, scr, F.lane); }
    }
}
DI void p0_prologue(Frame& F, const Args& A) {
    LAS float* scr = (LAS float*)(F.lds + F.wave * 16384);
    const int gw = blockIdx.x * NWAVES + F.wave, NGW = F.G * NWAVES;
    unsigned char* ws = F.ws;
    constexpr int I_IN = 16 * 144, I_OA = 8 * 32, I_OR = 8 * 32, I_OUT = 16 * 32, I_LD = 16, I_LA = 16, I_LG = 32;
    constexpr int NITEMS = I_IN + I_OA + I_OR + I_OUT + I_LD + I_LA + I_LG;
    for (int it = gw; it < NITEMS; it += NGW) {
        int r = it;
        if (r < I_IN) { const int kb = r / 144, nb = r % 144, n0 = 32 * nb; int dr = n0;
            if (n0 >= 2560) { const int ng = n0 - 2560, which = ng >> 10, c = ng & 1023; dr = 2560 + (c >> 7) * 256 + which * 128 + (c & 127); }
            transpose_item(A.in[I_WIN], IN_COLS, 1024, (bf16*)(ws + WS_WIN), 64 * kb, n0, dr, A.in[I_NMG], nb < 16 ? 0.125f : 1.0f, scr, F.lane); continue; } r -= I_IN;
        if (r < I_OA) { const int kb = r / 32, nb = r % 32; transpose_item(A.in[I_WOA], 1024, 1024, (bf16*)(ws + WS_WOA), 64 * kb, 32 * nb, 32 * nb, nullptr, 1.0f, scr, F.lane); continue; } r -= I_OA;
        if (r < I_OR) { const int kb = r / 32, nb = r % 32; transpose_item(A.in[I_WOR], 1024, 1024, (bf16*)(ws + WS_WOA) + 512, 64 * kb, 32 * nb, 32 * nb, nullptr, 1.0f, scr, F.lane); continue; } r -= I_OR;
        if (r < I_OUT) { const int kb = r / 32, nb = r % 32; transpose_item(A.in[I_WOUT], 1024, 1024, (bf16*)(ws + WS_WOUT), 64 * kb, 32 * nb, 32 * nb, nullptr, 1.0f, scr, F.lane); continue; } r -= I_OUT;
        if (r < I_LD) { transpose_item(A.in[I_WD], 512, 64, (bf16*)(ws + 5 * MiB), 0, 32 * r, 32 * r, nullptr, 1.0f, scr, F.lane); continue; } r -= I_LD;
        if (r < I_LA) { transpose_item(A.in[I_WA], 512, 64, (bf16*)(ws + 5 * MiB) + 512 * 64, 0, 32 * r, 32 * r, nullptr, 1.0f, scr, F.lane); continue; } r -= I_LA;
        { const int kb = r / 16, nb = r % 16; transpose_item(A.in[I_WG], 512, 128, (bf16*)(ws + 5 * MiB) + 2 * 512 * 64, 64 * kb, 32 * nb, 32 * nb, nullptr, 1.0f, scr, F.lane); }
    }
    {
        bf16* XB = (bf16*)(ws + WS_XB);
        for (int m0 = gw; m0 < M; m0 += 4 * NGW) {
            f32x4 v[4][4];
#pragma unroll
            for (int q = 0; q < 4; ++q) { const int m = m0 + q * NGW < M ? m0 + q * NGW : m0; const f32x4* xr = (const f32x4*)(A.in[I_X] + (size_t)m * D) + F.lane;
#pragma unroll
                for (int j = 0; j < 4; ++j) v[q][j] = xr[64 * j]; }
#pragma unroll
            for (int q = 0; q < 4; ++q) { const int m = m0 + q * NGW; if (m < M) { float s = 0.f;
#pragma unroll
                for (int j = 0; j < 4; ++j) s += (v[q][j].x * v[q][j].x + v[q][j].y * v[q][j].y) + (v[q][j].z * v[q][j].z + v[q][j].w * v[q][j].w);
                const float rs = 1.0f / sqrtf(wave_sum(s) * (1.0f / D) + 1e-6f);
                v2u* o8 = (v2u*)(XB + (size_t)m * D) + F.lane;
#pragma unroll
                for (int j = 0; j < 4; ++j) { v2u o; o.x = pk2(v[q][j].x * rs, v[q][j].y * rs); o.y = pk2(v[q][j].z * rs, v[q][j].w * rs); o8[64 * j] = o; } } }
        }
    }
    __syncthreads();
    {
        LAS float* xnm = (LAS float*)F.lds;
        LAS float* red = (LAS float*)(F.lds + 65536);
        bool have = false;
        for (int it = blockIdx.x; it < 256; it += F.G) {
            if (!have) {
                for (int rr = 0; rr < 2; ++rr) { const int row = 2 * F.wave + rr; const f32x4* xr = (const f32x4*)(A.in[I_META] + row * D) + F.lane; const f32x4* gr = (const f32x4*)(A.in[I_NMG]) + F.lane;
                    f32x4 v[4]; float s = 0.f;
#pragma unroll
                    for (int j = 0; j < 4; ++j) { v[j] = xr[64 * j]; s += (v[j].x * v[j].x + v[j].y * v[j].y) + (v[j].z * v[j].z + v[j].w * v[j].w); }
                    const float rs = 1.0f / sqrtf(wave_sum(s) * (1.0f / D) + 1e-6f);
#pragma unroll
                    for (int j = 0; j < 4; ++j) { const f32x4 g = gr[64 * j]; *(LAS f32x4*)(xnm + row * D + 256 * j + 4 * F.lane) = v[j] * rs * g; } }
                __syncthreads(); have = true;
            }
            const int cg = it >> 3, ks = it & 7, col = 512 + cg * 64 + F.lane, kbase = ks * 128 + F.wave * 16;
            float acc[16];
#pragma unroll
            for (int r = 0; r < 16; ++r) acc[r] = 0.f;
#pragma unroll 4
            for (int k = 0; k < 16; ++k) { const float w = A.in[I_WIN][(size_t)(kbase + k) * IN_COLS + col];
#pragma unroll
                for (int r = 0; r < 16; ++r) acc[r] += xnm[r * D + kbase + k] * w; }
#pragma unroll
            for (int r = 0; r < 16; ++r) red[(F.wave * 16 + r) * 64 + F.lane] = acc[r];
            __syncthreads();
            float* MP = (float*)(ws + WS_METAP);
            for (int e = F.tid; e < 16 * 64; e += NWAVES * 64) { const int r = e >> 6, c = e & 63; float s = 0.f;
#pragma unroll
                for (int w = 0; w < 8; ++w) s += red[(w * 16 + r) * 64 + c];
                MP[(size_t)(ks * 16 + r) * 2048 + cg * 64 + c] = s; }
            __syncthreads();
        }
    }
}
DI void p1_meta_finish(Frame& F, const Args& A) {
    const float* MP = (const float*)(F.ws + WS_METAP);
    bf16* Kb = (bf16*)(F.ws + WS_K); bf16* Vb = (bf16*)(F.ws + WS_V); bf16* RC = (bf16*)(F.ws + WS_RC);
    for (int e = blockIdx.x * 512 + F.tid; e < 16 * 2048; e += F.G * 512) { const int r = e >> 11, c = e & 2047; float s = 0.f;
#pragma unroll
        for (int k = 0; k < 8; ++k) s += MP[(size_t)(k * 16 + r) * 2048 + c];
        const bf16 v = (bf16)f2bf(s);
        if (c < 128) Kb[(size_t)(M + r) * 128 + c] = v; else if (c < 256) Vb[(size_t)(M + r) * 128 + c - 128] = v; else RC[(size_t)(M + r) * RCW + c - 256] = v; }
}

DI int moe_table(Frame& F) {
    LAS int* tile_e = (LAS int*)(F.lds + LDS_TBL); LAS int* tb = tile_e + TT_MAX;
    if (F.wave == 0) {
        const int e = F.lane & 31; const int c = (int)__hip_atomic_load(F.ctl + CW_GCNT + 64 * e, __ATOMIC_RELAXED, __HIP_MEMORY_SCOPE_AGENT); const int nt = (c + 255) >> 8;
        int incl = nt;
#pragma unroll
        for (int d = 1; d < 32; d <<= 1) { const int y = __shfl_up(incl, d); if ((F.lane & 31) >= d) incl += y; }
        const int first = incl - nt;
        if (F.lane < 32) { tb[e] = first; tb[33 + e] = c; for (int t = 0; t < nt; ++t) tile_e[first + t] = e; if (e == 31) { tb[32] = incl; tb[65] = incl; } }
    }
    __syncthreads();
    return tb[65];
}
DI void p12_final(Frame& F, const Args& A) {
    const unsigned char* Y = (const unsigned char*)(F.ws + WS_Y); const bf16* H1 = (const bf16*)(F.ws + WS_AR);
    const int gw = blockIdx.x * NWAVES + F.wave, NGW = F.G * NWAVES, lane = F.lane;
    f32x4 gf[4];
#pragma unroll
    for (int j = 0; j < 4; ++j) gf[j] = ((const f32x4*)A.in[I_NFIN])[64 * j + lane];
    for (int m0 = gw; m0 < M; m0 += 2 * NGW) {
        v2u xh[2][4]; unsigned ya[2][4], yb[2][4];
#pragma unroll
        for (int q = 0; q < 2; ++q) { const int m = m0 + q * NGW < M ? m0 + q * NGW : m0; const v2u* hr = (const v2u*)(H1 + (size_t)m * D) + lane; const unsigned* y0 = (const unsigned*)(Y + (size_t)(2 * m) * D) + lane; const unsigned* y1 = (const unsigned*)(Y + (size_t)(2 * m + 1) * D) + lane;
#pragma unroll
            for (int j = 0; j < 4; ++j) { xh[q][j] = hr[64 * j]; ya[q][j] = y0[64 * j]; yb[q][j] = y1[64 * j]; } }
#pragma unroll
        for (int q = 0; q < 2; ++q) { const int m = m0 + q * NGW; if (m < M) { float s = 0.f; f32x4 v[4];
#pragma unroll
            for (int j = 0; j < 4; ++j) { const v2u h = xh[q][j]; const int a = (int)ya[q][j], c = (int)yb[q][j];
                v[j].x = __uint_as_float(h.x << 16) + 0.0625f * (__builtin_amdgcn_cvt_f32_fp8(a, 0) + __builtin_amdgcn_cvt_f32_fp8(c, 0)); v[j].y = __uint_as_float(h.x & 0xffff0000u) + 0.0625f * (__builtin_amdgcn_cvt_f32_fp8(a, 1) + __builtin_amdgcn_cvt_f32_fp8(c, 1));
                v[j].z = __uint_as_float(h.y << 16) + 0.0625f * (__builtin_amdgcn_cvt_f32_fp8(a, 2) + __builtin_amdgcn_cvt_f32_fp8(c, 2)); v[j].w = __uint_as_float(h.y & 0xffff0000u) + 0.0625f * (__builtin_amdgcn_cvt_f32_fp8(a, 3) + __builtin_amdgcn_cvt_f32_fp8(c, 3));
                s += (v[j].x * v[j].x + v[j].y * v[j].y) + (v[j].z * v[j].z + v[j].w * v[j].w); }
            const float rs = 1.0f / sqrtf(wave_sum(s) * (1.0f / D) + 1e-6f);
            f32x4* ho = (f32x4*)(F.out + (size_t)m * D) + lane;
#pragma unroll
            for (int j = 0; j < 4; ++j) ho[64 * j] = v[j] * rs * gf[j]; } }
    }
}

typedef short bf16x8 __attribute__((ext_vector_type(8)));
typedef float f32x16 __attribute__((ext_vector_type(16)));
#define MFMA32(a, b, c) __builtin_amdgcn_mfma_f32_32x32x16_bf16((a), (b), (c), 0, 0, 0)
constexpr int LDB = 72;
constexpr int LDF = 68;
constexpr int NCH = SEQ / 64, NITEM = NB * 8 * NCH, NITEM_ALL = NITEM + 8;
constexpr size_t CH_STRIDE = 65 * MiB;
constexpr size_t WS_CH = 611 * MiB;
constexpr size_t WS_LORA = 5 * MiB;
static_assert(WS_CH + 5 * CH_STRIDE <= WS_END && (size_t)NITEM_ALL * 8192 <= CH_STRIDE, "chunk map");

template <int KK> DI void mma_lds(f32x16& acc, const LAS bf16* Y, int ldy, int n0, const LAS bf16* X, int ldx, int m0, int lane) {
    const int r = lane & 31, hh = lane >> 5;
    const LAS bf16* yp = Y + (n0 + r) * ldy + 8 * hh; const LAS bf16* xp = X + (m0 + r) * ldx + 8 * hh;
#pragma unroll
    for (int k0 = 0; k0 < KK; k0 += 16) { const bf16x8 a = *(const LAS bf16x8*)(xp + k0), b = *(const LAS bf16x8*)(yp + k0); acc = MFMA32(a, b, acc); }
}
DI bf16x8 col_frag(const LAS bf16* Mx, int ld, int row0, int col) {
    const LAS bf16* p = Mx + row0 * ld + col; v4u t4;
#pragma unroll
    for (int i = 0; i < 4; ++i) t4[i] = (unsigned)p[(2 * i) * ld] | ((unsigned)p[(2 * i + 1) * ld] << 16);
    return __builtin_bit_cast(bf16x8, t4);
}
template <int KK, bool YT, bool XT> DI void mma_lds_t(f32x16& acc, const LAS bf16* Y, int ldy, int n0, const LAS bf16* X, int ldx, int m0, int lane) {
    const int r = lane & 31, hh = lane >> 5;
#pragma unroll
    for (int k0 = 0; k0 < KK; k0 += 16) {
        const bf16x8 a = XT ? col_frag(X, ldx, k0 + 8 * hh, m0 + r) : *(const LAS bf16x8*)(X + (m0 + r) * ldx + 8 * hh + k0);
        const bf16x8 b = YT ? col_frag(Y, ldy, k0 + 8 * hh, n0 + r) : *(const LAS bf16x8*)(Y + (n0 + r) * ldy + 8 * hh + k0);
        acc = MFMA32(a, b, acc); }
}
DI void add_tile_lds_t(f32x16& acc, const LAS bf16* Rm, int ld, int n0, int m0, int lane) {
    const int r = lane & 31, hh = lane >> 5;
#pragma unroll
    for (int i = 0; i < 16; ++i) acc[i] += __uint_as_float((unsigned)Rm[(m0 + 8 * (i >> 2) + 4 * hh + (i & 3)) * ld + n0 + r] << 16);
}
DI f32x16 zero16() { f32x16 z;
#pragma unroll
    for (int i = 0; i < 16; ++i) z[i] = 0.f; return z; }
DI void st_tile_lds(LAS bf16* Dm, int ld, int n0, int m0, const f32x16& acc, int lane) {
    const int r = lane & 31, hh = lane >> 5;
#pragma unroll
    for (int g = 0; g < 4; ++g) { v2u o; o.x = pk2(acc[4 * g], acc[4 * g + 1]); o.y = pk2(acc[4 * g + 2], acc[4 * g + 3]); *(LAS v2u*)(Dm + (n0 + r) * ld + m0 + 8 * g + 4 * hh) = o; }
}
DI void st_tile_glb(bf16* Dm, int ld, int n0, int m0, const f32x16& acc, int lane) {
    const int r = lane & 31, hh = lane >> 5;
#pragma unroll
    for (int g = 0; g < 4; ++g) { v2u o; o.x = pk2(acc[4 * g], acc[4 * g + 1]); o.y = pk2(acc[4 * g + 2], acc[4 * g + 3]); *(v2u*)(Dm + (size_t)(n0 + r) * ld + m0 + 8 * g + 4 * hh) = o; }
}
DI void st_tile_glb_frag(bf16* Dm, int n0, int m0, const f32x16& acc, int lane) {
    const int r = lane & 31, hh = lane >> 5;
#pragma unroll
    for (int g = 0; g < 4; ++g) { v2u o; o.x = pk2(acc[4 * g], acc[4 * g + 1]); o.y = pk2(acc[4 * g + 2], acc[4 * g + 3]);
        *(v2u*)(Dm + ((n0 >> 5) * 4 + (m0 >> 4) + (g >> 1)) * 512 + ((g & 1) * 32 + r) * 8 + 4 * hh) = o; }
}
DI void st_tile_glb_cl(bf16* Dm, int n0, int m0, const f32x16& acc, int lane) {
#pragma unroll
    for (int g = 0; g < 4; ++g) { v2u o; o.x = pk2(acc[4 * g], acc[4 * g + 1]); o.y = pk2(acc[4 * g + 2], acc[4 * g + 3]); *(v2u*)(Dm + ((n0 >> 5) * 2 + (m0 >> 5)) * 1024 + g * 256 + lane * 4) = o; }
}
DI void add_tile_lds(f32x16& acc, const LAS bf16* R, int ld, int n0, int m0, int lane) {
    const int r = lane & 31, hh = lane >> 5;
#pragma unroll
    for (int g = 0; g < 4; ++g) { const v2u w = *(const LAS v2u*)(R + (n0 + r) * ld + m0 + 8 * g + 4 * hh);
        acc[4 * g] += __uint_as_float(w.x << 16); acc[4 * g + 1] += __uint_as_float(w.x & 0xffff0000u); acc[4 * g + 2] += __uint_as_float(w.y << 16); acc[4 * g + 3] += __uint_as_float(w.y & 0xffff0000u); }
}
DI void up8(const v4u w, float* f) {
#pragma unroll
    for (int i = 0; i < 4; ++i) { f[2 * i] = __uint_as_float(w[i] << 16); f[2 * i + 1] = __uint_as_float(w[i] & 0xffff0000u); }
}
DI v4u pk8(const float* f) { v4u o; o.x = pk2(f[0], f[1]); o.y = pk2(f[2], f[3]); o.z = pk2(f[4], f[5]); o.w = pk2(f[6], f[7]); return o; }


constexpr size_t WS_XA = 936 * MiB;
DI int prev_row_of(int vt) { if (vt < M) return (vt % SEQ) > 0 ? vt - 1 : M + 15; return vt > M ? vt - 1 : -1; }
DI void p2a_lora_inputs(Frame& F, const Args& A) {
    const bf16* RC = (const bf16*)(F.ws + WS_RC); const float* mu = A.in[I_MU]; bf16* XA = (bf16*)(F.ws + WS_XA);
    const int stride = F.G * NWAVES * 64;
    for (int e0 = blockIdx.x * (NWAVES * 64) + F.tid; e0 < MV * 32; e0 += 4 * stride) {
        v4u cur[4], prv[4]; bool hp[4];
#pragma unroll
        for (int u = 0; u < 4; ++u) { const int e = e0 + u * stride < MV * 32 ? e0 + u * stride : e0; const int vt = e >> 5, col = 1536 + (e & 31) * 8, prow = prev_row_of(vt);
            hp[u] = prow >= 0; cur[u] = *(const v4u*)(RC + (size_t)vt * RCW + col); prv[u] = *(const v4u*)(RC + (size_t)(prow >= 0 ? prow : vt) * RCW + col); }
#pragma unroll
        for (int u = 0; u < 4; ++u) { const int e = e0 + u * stride; if (e < MV * 32) { const int vt = e >> 5, cg = e & 31, cl = cg * 8, col = 1536 + cl;
            float cu[8], pv[8], o[8]; up8(cur[u], cu); up8(prv[u], pv);
            if (!hp[u]) {
#pragma unroll
                for (int i = 0; i < 8; ++i) pv[i] = 0.f; }
            const f32x4 m0 = *(const f32x4*)(mu + col), m1 = *(const f32x4*)(mu + col + 4);
#pragma unroll
            for (int i = 0; i < 8; ++i) { const float mm = i < 4 ? m0[i] : m1[i - 4]; const float v = cu[i] + mm * (pv[i] - cu[i]);
                const float ex = __expf(-2.0f * fabsf(v)), th = copysignf((1.0f - ex) * __builtin_amdgcn_rcpf(1.0f + ex), v);
                o[i] = cg < 8 ? th : (cg < 16 ? v : sigmoid_f(v)); }
            *(v4u*)(XA + (size_t)vt * 256 + cl) = pk8(o); } }
    }
}

DI float sum8_dpp(float v) {
    v += __int_as_float(__builtin_amdgcn_update_dpp(0, __float_as_int(v), 0xB1, 0xF, 0xF, true));
    v += __int_as_float(__builtin_amdgcn_update_dpp(0, __float_as_int(v), 0x4E, 0xF, 0xF, true));
    v += __int_as_float(__builtin_amdgcn_update_dpp(0, __float_as_int(v), 0x141, 0xF, 0xF, true));
    return v;
}
constexpr int L_AT = 0, L_ATT = 9216, L_RT = 18432, L_BT = 27648, L_BTT = 36864, L_KT = 46080, L_KTT = 55296, L_VT = 64512;
constexpr int L_AF = 73728, L_AP = 91136, L_AAK = 100352, L_ABR = 109568, L_AKR = 118784, L_TP = 128000, L_D1T = 137216, L_XT = 142336, L_PC = 146432;
constexpr int L_W1 = L_AF, L_AKT = L_AF + 9216, L_GT = L_AT, L_NKT = L_ATT;
constexpr int L_XL = 73728, L_LW = 73728, L_SEG = 91136, L_WL = 107520, L_AL = 124928;
constexpr int LDX = 264;

constexpr int L_WLN = 146688, L_ALN = L_WLN + 8192, L_TOT = L_LW;
struct ChunkItem { int h, row0, nvalid, prow0; bool meta; size_t oidx; };
DI ChunkItem chunk_item(int it, int npairs, int G) {
    ChunkItem I; I.meta = it >= npairs * 8;
    const int pair = I.meta ? 0 : (int)blockIdx.x + (it >> 3) * G; I.h = I.meta ? (int)blockIdx.x : (it & 7);
    const int b = I.meta ? 0 : pair / NCH, c = I.meta ? 0 : pair % NCH;
    I.row0 = I.meta ? M : b * SEQ + 64 * c; I.nvalid = I.meta ? 16 : 64; I.prow0 = I.meta ? -1 : (c > 0 ? I.row0 - 1 : M + 15);
    I.oidx = I.meta ? (size_t)(NITEM + I.h) : (size_t)((b * 8 + I.h) * NCH + c);
    return I;
}
DI void lora_tile(LAS unsigned char* L, const ChunkItem& I, int kind, int tq, const bf16* XA, const bf16* WdT, const bf16* WaT, const bf16* WgT, bf16* GB, int lane) {
    const int r32 = lane & 31, hh = lane >> 5, n0 = 32 * (tq >> 1), m0 = 32 * (tq & 1);
    const int tvx = (n0 + r32) < I.nvalid ? (n0 + r32) : I.nvalid - 1; const bf16* XLr = XA + (size_t)(I.row0 + tvx) * 256 + 8 * hh;
    f32x16 acc = zero16();
    if (kind < 2) { const bf16* Wt = (kind ? WaT : WdT) + (size_t)(I.h * 64 + m0 + r32) * 64 + 8 * hh;
#pragma unroll
        for (int k0 = 0; k0 < 64; k0 += 16) { const bf16x8 a = *(const bf16x8*)(Wt + k0), bb = *(const bf16x8*)(XLr + kind * 64 + k0); acc = MFMA32(a, bb, acc); }
        st_tile_lds((LAS bf16*)(L + (kind ? L_ALN : L_WLN)), 64, n0, m0, acc, lane);
    } else { const bf16* Wt = WgT + (size_t)(I.h * 64 + m0 + r32) * 128 + 8 * hh;
#pragma unroll
        for (int k0 = 0; k0 < 128; k0 += 16) { const bf16x8 a = *(const bf16x8*)(Wt + k0), bb = *(const bf16x8*)(XLr + 128 + k0); acc = MFMA32(a, bb, acc); }
        if (!I.meta) st_tile_glb_cl(GB + I.oidx * 4096, n0, m0, acc, lane); }
}
DI void stage1_tile(LAS unsigned char* L, int p, int n0, int m0, int lane) {
    const int r32 = lane & 31, hh = lane >> 5, n = n0 + r32;
    const LAS bf16* Y = (const LAS bf16*)(L + (p == 0 ? L_AT : p == 1 ? L_KT : L_RT));
    const LAS bf16* X = (const LAS bf16*)(L + (p == 0 ? L_BT : p == 1 ? L_AT : p == 2 ? L_BT : L_KT));
    f32x16 acc = zero16(); mma_lds<64>(acc, Y, LDB, n0, X, LDB, m0, lane);
#pragma unroll
    for (int i = 0; i < 16; ++i) { const int m = m0 + 8 * (i >> 2) + 4 * hh + (i & 3); const bool keep = p == 0 ? (m < n) : p == 1 ? (n < m) : (m <= n); if (!keep) acc[i] = 0.f; }
    if (p == 0) { LAS float* AFm = (LAS float*)(L + L_AF);
#pragma unroll
        for (int g = 0; g < 4; ++g) *(LAS f32x4*)(AFm + n * LDF + m0 + 8 * g + 4 * hh) = (f32x4){acc[4 * g], acc[4 * g + 1], acc[4 * g + 2], acc[4 * g + 3]};
        st_tile_lds((LAS bf16*)(L + L_AP), LDB, n0, m0, acc, lane); }
    else st_tile_lds((LAS bf16*)(L + (p == 1 ? L_AAK : p == 2 ? L_ABR : L_AKR)), LDB, n0, m0, acc, lane);
}
#ifndef P3I_REPS
#define P3I_REPS 1
#endif
DI void p3_rwkv_chunk(Frame& F, const Args& A) {
    LAS unsigned char* L = F.lds;
    const bf16* RC = (const bf16*)(F.ws + WS_RC); const float* mu = A.in[I_MU];
    bf16* GB = (bf16*)(F.ws + WS_GB); bf16* PO = (bf16*)(F.ws + WS_POST);
    const bf16* WdT = (const bf16*)(F.ws + WS_LORA); const bf16* WaT = WdT + 512 * 64; const bf16* WgT = WaT + 512 * 64;
    bf16* W2T = (bf16*)(F.ws + WS_CH); bf16* MTg = (bf16*)(F.ws + WS_CH + CH_STRIDE); bf16* YLT = (bf16*)(F.ws + WS_CH + 2 * CH_STRIDE); bf16* NBg = (bf16*)(F.ws + WS_CH + 3 * CH_STRIDE);
    const int tid = F.tid, lane = F.lane, w = F.wave, r32 = lane & 31, hh = lane >> 5;
    const bf16* XA = (const bf16*)(F.ws + WS_XA);
    const int npairs = (NB * NCH - (int)blockIdx.x + F.G - 1) / F.G, nmine = npairs * 8 + (blockIdx.x < 8 ? 1 : 0);
    if (nmine == 0) return;
    { LAS float* P1 = (LAS float*)(L + L_BTT); LAS float* P2 = (LAS float*)(L + L_KTT); const int i = tid;
        P1[i] = A.in[I_W0][i]; P1[512 + i] = A.in[I_A0][i]; P1[1024 + i] = A.in[I_KK][i]; P1[1536 + i] = A.in[I_KA][i]; ((LAS bf16*)(P1 + 2048))[i] = (bf16)f2bf(A.in[I_RK][i]);
        P2[i] = mu[i]; P2[512 + i] = mu[512 + i]; P2[1024 + i] = mu[1024 + i]; ((LAS bf16*)(P2 + 1536))[i] = (bf16)f2bf(A.in[I_LNB][i]); }
    const int t = tid >> 3, jg = tid & 7, j0 = 8 * jg;
    v4u rcu[3], rpv[3];
#define P3_REQ_ROWS(I_) do { const int tv_ = t < (I_).nvalid ? t : (I_).nvalid - 1, row_ = (I_).row0 + tv_, prow_ = tv_ > 0 ? row_ - 1 : (I_).prow0, ch_ = (I_).h * 64 + j0; \
        _Pragma("unroll") for (int which = 0; which < 3; ++which) { rcu[which] = *(const v4u*)(RC + (size_t)row_ * RCW + which * 512 + ch_); rpv[which] = *(const v4u*)(RC + (size_t)(prow_ >= 0 ? prow_ : row_) * RCW + which * 512 + ch_); } } while (0)
    {
        const ChunkItem I0 = chunk_item(0, npairs, F.G);
        P3_REQ_ROWS(I0);
        if (w < 4) { lora_tile(L, I0, 0, w, XA, WdT, WaT, WgT, GB, lane); lora_tile(L, I0, 1, w, XA, WdT, WaT, WgT, GB, lane); } else lora_tile(L, I0, 2, w - 4, XA, WdT, WaT, WgT, GB, lane);
    }
    LDS_BARRIER();
    for (int it = 0; it < nmine; ++it) {
        const ChunkItem I = chunk_item(it, npairs, F.G);
        const bool has_next = it + 1 < nmine; const ChunkItem IN = chunk_item(has_next ? it + 1 : it, npairs, F.G);
        const int h = I.h, row0 = I.row0, nvalid = I.nvalid, prow0 = I.prow0; const bool meta = I.meta; const size_t oidx = I.oidx;
        const int ch = h * 64 + j0;
        float rr[8], kp[8], vv[8], lw[8], aa[8], bb8[8], cum[8];
        {
            const bool valid = t < nvalid; const int tv = valid ? t : nvalid - 1;
            const int row = row0 + tv, prow = tv > 0 ? row - 1 : prow0;
            float cu[8], pv[8], kr[8];
#pragma unroll
            for (int which = 0; which < 3; ++which) { const int col = which * 512 + ch;
                up8(rcu[which], cu); up8(rpv[which], pv);
                if (prow < 0) {
#pragma unroll
                    for (int e = 0; e < 8; ++e) pv[e] = 0.f; }
                const f32x4 m0 = *(const LAS f32x4*)(L + L_KTT + (which * 512 + ch) * 4), m1 = *(const LAS f32x4*)(L + L_KTT + (which * 512 + ch + 4) * 4);
#pragma unroll
                for (int e = 0; e < 8; ++e) { const float mm = e < 4 ? m0[e] : m1[e - 4]; const float v = cu[e] + mm * (pv[e] - cu[e]); if (which == 0) rr[e] = v; else if (which == 1) kr[e] = v; else vv[e] = v; } }
            float wl8[8], al8[8]; up8(*(const LAS v4u*)(L + L_WLN + (t * 64 + j0) * 2), wl8); up8(*(const LAS v4u*)(L + L_ALN + (t * 64 + j0) * 2), al8);
            float s1 = 0.f, asg[8], pw0[8], pa0[8], pkk[8], pka[8], prk[8], plb[8];
#pragma unroll
            for (int q = 0; q < 2; ++q) { const LAS float* P1 = (const LAS float*)(L + L_BTT) + ch + 4 * q; const f32x4 v0 = *(const LAS f32x4*)P1, v1 = *(const LAS f32x4*)(P1 + 512), v2 = *(const LAS f32x4*)(P1 + 1024), v3 = *(const LAS f32x4*)(P1 + 1536);
#pragma unroll
                for (int i = 0; i < 4; ++i) { pw0[4 * q + i] = v0[i]; pa0[4 * q + i] = v1[i]; pkk[4 * q + i] = v2[i]; pka[4 * q + i] = v3[i]; } }
            up8(*(const LAS v4u*)(L + L_BTT + 8192 + ch * 2), prk); up8(*(const LAS v4u*)(L + L_KTT + 6144 + ch * 2), plb);
#pragma unroll
            for (int e = 0; e < 8; ++e) { lw[e] = -0.60653065971f * sigmoid_f(pw0[e] + wl8[e]);
                asg[e] = sigmoid_f(pa0[e] + al8[e]); aa[e] = kr[e] * pkk[e]; s1 += aa[e] * aa[e];
                kp[e] = kr[e] * (1.0f + (asg[e] - 1.0f) * pka[e]); }
            s1 = sum8_dpp(s1);
            const float inv = __builtin_amdgcn_rcpf(fmaxf(__builtin_amdgcn_sqrtf(s1), 1e-12f));
            float s2 = 0.f;
#pragma unroll
            for (int e = 0; e < 8; ++e) { const float kkv = aa[e] * inv; aa[e] = -kkv; bb8[e] = kkv * asg[e]; s2 += rr[e] * kp[e] * prk[e]; }
            s2 = sum8_dpp(s2);
            if (!meta) { float po[8];
#pragma unroll
                for (int e = 0; e < 8; ++e) po[e] = plb[e] + s2 * vv[e];
                const v4u pp = pk8(po); bf16* pd = PO + oidx * 4096 + ((t >> 5) * 2 + (jg >> 2)) * 1024 + (jg & 3) * 256 + (t & 31) * 4;
                v2u lo; lo.x = pp.x; lo.y = pp.y; v2u hi; hi.x = pp.z; hi.y = pp.w; *(v2u*)pd = lo; *(v2u*)(pd + 128) = hi; }
            if (!valid) {
#pragma unroll
                for (int e = 0; e < 8; ++e) { rr[e] = 0.f; kp[e] = 0.f; vv[e] = 0.f; lw[e] = 0.f; aa[e] = 0.f; bb8[e] = 0.f; } }
#pragma unroll
            for (int e = 0; e < 8; ++e) { float x = lw[e];
#pragma unroll
                for (int dlt = 8; dlt < 64; dlt <<= 1) { const float y = __shfl_up(x, dlt); if (lane >= dlt) x += y; }
                cum[e] = x; }
            if ((lane >> 3) == 7) { LAS float* TOT = (LAS float*)(L + L_TOT) + w * 64 + j0; *(LAS f32x4*)TOT = (f32x4){cum[0], cum[1], cum[2], cum[3]}; *(LAS f32x4*)(TOT + 4) = (f32x4){cum[4], cum[5], cum[6], cum[7]}; }
        }
        LDS_BARRIER();
        {
            const LAS float* TOT = (const LAS float*)(L + L_TOT) + j0;
            for (int q = 0; q < w; ++q) { const f32x4 a4 = *(const LAS f32x4*)(TOT + q * 64), b4 = *(const LAS f32x4*)(TOT + q * 64 + 4);
                cum[0] += a4.x; cum[1] += a4.y; cum[2] += a4.z; cum[3] += a4.w; cum[4] += b4.x; cum[5] += b4.y; cum[6] += b4.z; cum[7] += b4.w; }
            float at[8], rt[8], bt[8], kt[8];
#pragma unroll
            for (int e = 0; e < 8; ++e) { const float p = __builtin_amdgcn_exp2f(1.44269504089f * cum[e]), pprev = __builtin_amdgcn_exp2f(1.44269504089f * (cum[e] - lw[e])), pinv = __builtin_amdgcn_rcpf(p);
                at[e] = aa[e] * pprev; rt[e] = rr[e] * p; bt[e] = bb8[e] * pinv; kt[e] = kp[e] * pinv;
                if (t == 63) ((LAS float*)(L + L_PC))[j0 + e] = p; }
            *(LAS v4u*)(L + L_RT + (t * LDB + j0) * 2) = pk8(rt);
            const v4u pat = pk8(at), pbt = pk8(bt), pkt = pk8(kt), pvt = pk8(vv);
            *(LAS v4u*)(L + L_AT + (t * LDB + j0) * 2) = pat; *(LAS v4u*)(L + L_BT + (t * LDB + j0) * 2) = pbt; *(LAS v4u*)(L + L_KT + (t * LDB + j0) * 2) = pkt;
            *(LAS v4u*)(L + L_VT + (t * LDB + j0) * 2) = pvt;
        }
        LDS_BARRIER();
        stage1_tile(L, w >> 2, 32 * ((w >> 1) & 1), 32 * (w & 1), lane);
        LDS_BARRIER();
        _Pragma("unroll 1") for (int repi_ = 0; repi_ < P3I_REPS; ++repi_)
        if (w == 0) {
            LAS bf16* TP = (LAS bf16*)(L + L_TP); const LAS bf16* AP = (const LAS bf16*)(L + L_AP); LAS bf16* XT1 = (LAS bf16*)(L + L_D1T); LAS bf16* XT2 = (LAS bf16*)(L + L_XT);
            const int d4 = lane >> 4, cc = lane & 15; const LAS float* AFm = (const LAS float*)(L + L_AF) + (16 * d4) * LDF + 16 * d4;
#pragma unroll
            for (int i = 0; i < 9; ++i) *(LAS v4u*)(L + L_TP + (lane + 64 * i) * 16) = (v4u){0u, 0u, 0u, 0u};
            float x[16];
#pragma unroll
            for (int tt = 0; tt < 16; ++tt) x[tt] = 0.f;
            x[0] = cc == 0 ? 1.f : 0.f;
            {
                f32x4 ar[7][2];
#pragma unroll
                for (int tt = 1; tt < 8; ++tt)
#pragma unroll
                    for (int q = 0; q < 2; ++q) if (4 * q < tt) ar[tt - 1][q] = *(const LAS f32x4*)(AFm + tt * LDF + 4 * q);
#pragma unroll
                for (int tt = 1; tt < 8; ++tt) { float acc = (tt == cc) ? 1.f : 0.f;
#pragma unroll
                    for (int q = 0; q < 2; ++q) if (4 * q < tt) acc += (ar[tt - 1][q].x * x[4 * q] + ar[tt - 1][q].y * x[4 * q + 1]) + (ar[tt - 1][q].z * x[4 * q + 2] + ar[tt - 1][q].w * x[4 * q + 3]);
                    x[tt] = acc; }
            }
            {
                f32x4 ar[8][4];
#pragma unroll
                for (int tt = 8; tt < 16; ++tt)
#pragma unroll
                    for (int q = 0; q < 4; ++q) if (4 * q < tt) ar[tt - 8][q] = *(const LAS f32x4*)(AFm + tt * LDF + 4 * q);
#pragma unroll
                for (int tt = 8; tt < 16; ++tt) { float acc = (tt == cc) ? 1.f : 0.f;
#pragma unroll
                    for (int q = 0; q < 4; ++q) if (4 * q < tt) acc += (ar[tt - 8][q].x * x[4 * q] + ar[tt - 8][q].y * x[4 * q + 1]) + (ar[tt - 8][q].z * x[4 * q + 2] + ar[tt - 8][q].w * x[4 * q + 3]);
                    x[tt] = acc; }
            }
#pragma unroll
            for (int tt = 0; tt < 16; ++tt) TP[(16 * d4 + tt) * LDB + 16 * d4 + cc] = (bf16)f2bf(x[tt]);
            LDS_WAIT();
            f32x16 f0 = zero16(), f1 = zero16();
            mma_lds_t<32, true, false>(f0, TP, LDB, 0, AP, LDB, 0, lane); mma_lds_t<32, true, false>(f1, TP + 32 * LDB + 32, LDB, 0, AP + 32 * LDB + 32, LDB, 0, lane);
            st_tile_lds(XT1, 40, 0, 0, f0, lane); st_tile_lds(XT1 + 1280, 40, 0, 0, f1, lane);
            LDS_WAIT();
            f0 = zero16(); f1 = zero16();
            mma_lds<32>(f0, TP, LDB, 0, XT1, 40, 0, lane); mma_lds<32>(f1, TP + 32 * LDB + 32, LDB, 0, XT1 + 1280, 40, 0, lane);
            if (r32 >= 16) {
#pragma unroll
                for (int g = 0; g < 2; ++g) { v2u o0, o1; o0.x = pk2(f0[4 * g], f0[4 * g + 1]); o0.y = pk2(f0[4 * g + 2], f0[4 * g + 3]); o1.x = pk2(f1[4 * g], f1[4 * g + 1]); o1.y = pk2(f1[4 * g + 2], f1[4 * g + 3]);
                    *(LAS v2u*)(TP + r32 * LDB + 8 * g + 4 * hh) = o0; *(LAS v2u*)(TP + (32 + r32) * LDB + 32 + 8 * g + 4 * hh) = o1; } }
            LDS_WAIT();
            {
                f32x16 acc = zero16(); mma_lds_t<32, true, false>(acc, TP, LDB, 0, AP + 32 * LDB, LDB, 0, lane);
                st_tile_lds(XT2, 40, 0, 0, acc, lane);
            }
            LDS_WAIT();
            {
                f32x16 acc = zero16(); mma_lds<32>(acc, TP + 32 * LDB + 32, LDB, 0, XT2, 40, 0, lane);
                st_tile_lds(TP + 32 * LDB, LDB, 0, 0, acc, lane);
            }
        } else {
            if (w <= 4) { const int p = 2 + ((w - 1) >> 1), n0 = 32 * ((w - 1) & 1); stage1_tile(L, p, n0, 0, lane); stage1_tile(L, p, n0, 32, lane); }
            if (has_next) {
                if (w <= 4) { lora_tile(L, IN, 0, w - 1, XA, WdT, WaT, WgT, GB, lane); lora_tile(L, IN, 1, w - 1, XA, WdT, WaT, WgT, GB, lane); }
                else if (w == 5) { lora_tile(L, IN, 2, 0, XA, WdT, WaT, WgT, GB, lane); lora_tile(L, IN, 2, 1, XA, WdT, WaT, WgT, GB, lane); }
                else lora_tile(L, IN, 2, w - 4, XA, WdT, WaT, WgT, GB, lane);
            }
        }
        LDS_BARRIER();
        {
            const int p = w >> 2, n0 = 32 * ((w >> 1) & 1), m0 = 32 * (w & 1);
            f32x16 acc = zero16();
            if (p) mma_lds<64>(acc, (const LAS bf16*)(L + L_AAK), LDB, n0, (const LAS bf16*)(L + L_TP), LDB, m0, lane);
            else mma_lds_t<64, true, false>(acc, (const LAS bf16*)(L + L_AT), LDB, n0, (const LAS bf16*)(L + L_TP), LDB, m0, lane);
            st_tile_lds((LAS bf16*)(L + (p ? L_AKT : L_W1)), LDB, n0, m0, acc, lane);
        }
        LDS_BARRIER();
        {
            const int p = w >> 1, n0 = 32 * (w & 1), n = n0 + r32;
            const LAS bf16* Y = (const LAS bf16*)(L + (p < 2 ? L_ABR : L_BT)); const LAS bf16* X = (const LAS bf16*)(L + ((p & 1) ? L_AKT : L_W1));
            const float pc = ((const LAS float*)(L + L_PC))[n];
#pragma unroll 1
            for (int mt = 0; mt < 2; ++mt) { const int m0 = 32 * mt; f32x16 acc = zero16();
                if (p < 2) mma_lds<64>(acc, Y, LDB, n0, X, LDB, m0, lane); else mma_lds_t<64, true, false>(acc, Y, LDB, n0, X, LDB, m0, lane);
                if (p == 0) { add_tile_lds(acc, (const LAS bf16*)(L + L_RT), LDB, n0, m0, lane); st_tile_glb_frag(W2T + oidx * 4096, n0, m0, acc, lane); }
                else if (p == 1) { add_tile_lds(acc, (const LAS bf16*)(L + L_AKR), LDB, n0, m0, lane); st_tile_lds((LAS bf16*)(L + L_GT), LDB, n0, m0, acc, lane); }
                else if (p == 2) {
#pragma unroll
                    for (int i = 0; i < 16; ++i) { const int m = m0 + 8 * (i >> 2) + 4 * hh + (i & 3); acc[i] = (acc[i] + (m == n ? 1.f : 0.f)) * pc; }
                    st_tile_glb(MTg + oidx * 4096, 64, n0, m0, acc, lane); }
                else { add_tile_lds_t(acc, (const LAS bf16*)(L + L_KT), LDB, n0, m0, lane);
#pragma unroll
                    for (int i = 0; i < 16; ++i) acc[i] *= pc;
                    st_tile_lds((LAS bf16*)(L + L_NKT), LDB, n0, m0, acc, lane); } }
        }
        LDS_BARRIER();
        if (has_next) P3_REQ_ROWS(IN);
        {
            const int p = w >> 2, n0 = 32 * ((w >> 1) & 1), m0 = 32 * (w & 1);
            f32x16 acc = zero16();
            if (p) mma_lds_t<64, true, false>(acc, (const LAS bf16*)(L + L_VT), LDB, n0, (const LAS bf16*)(L + L_NKT), LDB, m0, lane);
            else mma_lds_t<64, false, true>(acc, (const LAS bf16*)(L + L_GT), LDB, n0, (const LAS bf16*)(L + L_VT), LDB, m0, lane);
            if (p) st_tile_glb(NBg + oidx * 4096, 64, n0, m0, acc, lane); else st_tile_glb_cl(YLT + oidx * 4096, n0, m0, acc, lane);
        }
    }
#undef P3_REQ_ROWS
}

constexpr int CH_GC = 4, CH_SLOT = (64 + 32) * LDB * 2, CH_NOFF = 64 * LDB * 2;
DI void p4_rwkv_chain(Frame& F, const Args& A) {
    const bf16* MTg = (const bf16*)(F.ws + WS_CH + CH_STRIDE); const bf16* NBg = (const bf16*)(F.ws + WS_CH + 3 * CH_STRIDE); bf16* S0g = (bf16*)(F.ws + WS_CH + 4 * CH_STRIDE);
    const int lane = F.lane, r32 = lane & 31, hh = lane >> 5, w = F.wave;
    for (int task = blockIdx.x; task < NB * 8 * 2; task += F.G) {
        const int bh = task >> 1, n0 = 32 * (task & 1), hd = bh & 7;
        f32x16 s[2];
        if (w == 0) { const bf16* Nm = NBg + (size_t)(NITEM + hd) * 4096 + (size_t)(n0 + r32) * 64 + 4 * hh;
#pragma unroll
            for (int mt = 0; mt < 2; ++mt)
#pragma unroll
                for (int g = 0; g < 4; ++g) { const v2u wv = *(const v2u*)(Nm + 32 * mt + 8 * g);
                    s[mt][4 * g] = __uint_as_float(wv.x << 16); s[mt][4 * g + 1] = __uint_as_float(wv.x & 0xffff0000u); s[mt][4 * g + 2] = __uint_as_float(wv.y << 16); s[mt][4 * g + 3] = __uint_as_float(wv.y & 0xffff0000u); } }
#define CH_STAGE(gi) do { if (w > 0) { v4u rg_[7]; \
            _Pragma("unroll") for (int u_ = 0; u_ < 7; ++u_) { const int pc_ = F.tid - 64 + u_ * 448; if (pc_ < CH_GC * 768) { const int sl_ = pc_ / 768, q_ = pc_ - sl_ * 768; const size_t o_ = (size_t)(bh * NCH + CH_GC * (gi) + sl_) * 4096; \
                rg_[u_] = q_ < 512 ? *(const v4u*)(MTg + o_ + (size_t)q_ * 8) : *(const v4u*)(NBg + o_ + (size_t)(n0 + ((q_ - 512) >> 3)) * 64 + ((q_ - 512) & 7) * 8); } } \
            _Pragma("unroll") for (int u_ = 0; u_ < 7; ++u_) { const int pc_ = F.tid - 64 + u_ * 448; if (pc_ < CH_GC * 768) { const int sl_ = pc_ / 768, q_ = pc_ - sl_ * 768; \
                LAS unsigned char* dst_ = F.lds + (((gi) & 1) * CH_GC + sl_) * CH_SLOT; \
                if (q_ < 512) *(LAS v4u*)(dst_ + (q_ >> 3) * (LDB * 2) + (q_ & 7) * 16) = rg_[u_]; \
                else { const int q2_ = q_ - 512; *(LAS v4u*)(dst_ + CH_NOFF + (q2_ >> 3) * (LDB * 2) + (q2_ & 7) * 16) = rg_[u_]; } } } } } while (0)
        CH_STAGE(0);
        LDS_BARRIER();
        for (int gi = 0; gi < NCH / CH_GC; ++gi) {
            if (gi + 1 < NCH / CH_GC) CH_STAGE(gi + 1);
            if (w == 0) {
#pragma unroll 1
                for (int sl = 0; sl < CH_GC; ++sl) { const int c = CH_GC * gi + sl;
                    const LAS bf16* Ms = (const LAS bf16*)(F.lds + ((gi & 1) * CH_GC + sl) * CH_SLOT); const LAS bf16* Ns = Ms + 64 * LDB;
                    bf16x8 am[2][4]; f32x16 acc[2];
#pragma unroll
                    for (int mt = 0; mt < 2; ++mt)
#pragma unroll
                        for (int q = 0; q < 4; ++q) { const LAS bf16* mr = Ms + (32 * mt + r32) * LDB + 16 * q + 4 * hh; const v2u lo = *(const LAS v2u*)mr, hi = *(const LAS v2u*)(mr + 8); const v2u nv = *(const LAS v2u*)(Ns + r32 * LDB + 32 * mt + 8 * q + 4 * hh);
                            v4u t4; t4.x = lo.x; t4.y = lo.y; t4.z = hi.x; t4.w = hi.y; am[mt][q] = __builtin_bit_cast(bf16x8, t4);
                            acc[mt][4 * q] = __uint_as_float(nv.x << 16); acc[mt][4 * q + 1] = __uint_as_float(nv.x & 0xffff0000u); acc[mt][4 * q + 2] = __uint_as_float(nv.y << 16); acc[mt][4 * q + 3] = __uint_as_float(nv.y & 0xffff0000u); }
                    bf16x8 sb[4];
                    { bf16* So = S0g + (size_t)(bh * NCH + c) * 4096 + (n0 >> 5) * 2048 + r32 * 8 + 4 * hh;
#pragma unroll
                        for (int q = 0; q < 4; ++q) { const int mt = q >> 1, i0 = 8 * (q & 1); v4u t4; t4.x = pk2(s[mt][i0], s[mt][i0 + 1]); t4.y = pk2(s[mt][i0 + 2], s[mt][i0 + 3]); t4.z = pk2(s[mt][i0 + 4], s[mt][i0 + 5]); t4.w = pk2(s[mt][i0 + 6], s[mt][i0 + 7]);
                            sb[q] = __builtin_bit_cast(bf16x8, t4);
                            v2u lo; lo.x = t4.x; lo.y = t4.y; v2u hi; hi.x = t4.z; hi.y = t4.w; *(v2u*)(So + 512 * q) = lo; *(v2u*)(So + 512 * q + 256) = hi; } }
#pragma unroll
                    for (int mt = 0; mt < 2; ++mt)
#pragma unroll
                        for (int q = 0; q < 4; ++q) acc[mt] = MFMA32(am[mt][q], sb[q], acc[mt]);
                    s[0] = acc[0]; s[1] = acc[1];
                }
            }
            LDS_BARRIER();
        }
#undef CH_STAGE
    }
}

DI void p5_rwkv_out(Frame& F, const Args& A) {
    const bf16* W2T = (const bf16*)(F.ws + WS_CH); const bf16* YLT = (const bf16*)(F.ws + WS_CH + 2 * CH_STRIDE); const bf16* S0g = (const bf16*)(F.ws + WS_CH + 4 * CH_STRIDE);
    const bf16* GB = (const bf16*)(F.ws + WS_GB); const bf16* PO = (const bf16*)(F.ws + WS_POST); bf16* RY = (bf16*)(F.ws + WS_AR) + 512;
    const int lane = F.lane, r32 = lane & 31, hh = lane >> 5;
    LAS bf16* stg = (LAS bf16*)(F.lds + F.wave * 8192);
    for (int pm = blockIdx.x; pm < M / 256; pm += F.G)
    for (int q = F.wave; q < 64; q += NWAVES) {
        const int b = pm >> 5, c = 4 * (pm & 31) + (q >> 4), h = (q >> 1) & 7, n0 = 32 * (q & 1), idx = (b * 8 + h) * NCH + c;
        const size_t o = (size_t)idx * 4096; const int row = b * SEQ + 64 * c + n0 + r32;
        const bf16* Yr = W2T + o + (n0 >> 5) * 2048 + lane * 8;
        v2u pwr[2][4], gvr[2][4]; f32x4 lgr[2][4];
#pragma unroll
        for (int mt = 0; mt < 2; ++mt)
#pragma unroll
            for (int g = 0; g < 4; ++g) { const int i0 = h * 64 + 32 * mt + 8 * g + 4 * hh; const size_t go = o + ((n0 >> 5) * 2 + mt) * 1024 + g * 256 + lane * 4; lgr[mt][g] = *(const f32x4*)(A.in[I_LNG] + i0); pwr[mt][g] = *(const v2u*)(PO + go); gvr[mt][g] = *(const v2u*)(GB + go); }
        f32x16 acc[2];
#pragma unroll
        for (int mt = 0; mt < 2; ++mt) { const bf16* Lr = YLT + o + ((n0 >> 5) * 2 + mt) * 1024 + lane * 4;
#pragma unroll
            for (int g = 0; g < 4; ++g) { const v2u wv = *(const v2u*)(Lr + 256 * g);
                acc[mt][4 * g] = __uint_as_float(wv.x << 16); acc[mt][4 * g + 1] = __uint_as_float(wv.x & 0xffff0000u); acc[mt][4 * g + 2] = __uint_as_float(wv.y << 16); acc[mt][4 * g + 3] = __uint_as_float(wv.y & 0xffff0000u); } }
#pragma unroll
        for (int k0 = 0; k0 < 64; k0 += 16) { const bf16x8 yb = *(const bf16x8*)(Yr + (k0 >> 4) * 512);
#pragma unroll
            for (int mt = 0; mt < 2; ++mt) { const bf16x8 xa = *(const bf16x8*)(S0g + o + (mt * 4 + (k0 >> 4)) * 512 + lane * 8); acc[mt] = MFMA32(xa, yb, acc[mt]); } }
        float sum = 0.f;
#pragma unroll
        for (int mt = 0; mt < 2; ++mt)
#pragma unroll
            for (int i = 0; i < 16; ++i) sum += acc[mt][i];
        sum = xsum32(sum); const float mean = sum * (1.0f / 64.0f);
        float sq = 0.f;
#pragma unroll
        for (int mt = 0; mt < 2; ++mt)
#pragma unroll
            for (int i = 0; i < 16; ++i) { acc[mt][i] -= mean; sq += acc[mt][i] * acc[mt][i]; }
        sq = xsum32(sq); const float rstd = 1.0f / sqrtf(sq * (1.0f / 64.0f) + 64e-5f);
#pragma unroll
        for (int mt = 0; mt < 2; ++mt)
#pragma unroll
            for (int g = 0; g < 4; ++g) { const int i0 = h * 64 + 32 * mt + 8 * g + 4 * hh; const size_t go = (size_t)row * 512 + i0;
                const f32x4 lg = lgr[mt][g]; const v2u pw = pwr[mt][g], gv = gvr[mt][g];
                const float o0 = (acc[mt][4 * g] * rstd * lg.x + __uint_as_float(pw.x << 16)) * __uint_as_float(gv.x << 16), o1 = (acc[mt][4 * g + 1] * rstd * lg.y + __uint_as_float(pw.x & 0xffff0000u)) * __uint_as_float(gv.x & 0xffff0000u);
                const float o2 = (acc[mt][4 * g + 2] * rstd * lg.z + __uint_as_float(pw.y << 16)) * __uint_as_float(gv.y << 16), o3 = (acc[mt][4 * g + 3] * rstd * lg.w + __uint_as_float(pw.y & 0xffff0000u)) * __uint_as_float(gv.y & 0xffff0000u);
                v2u ov; ov.x = pk2(o0, o1); ov.y = pk2(o2, o3); *(LAS v2u*)(stg + r32 * 72 + 32 * mt + 8 * g + 4 * hh) = ov; }
        LDS_WAIT();
        {
            const size_t rb = (size_t)(b * SEQ + 64 * c + n0) * 1024 + h * 64;
#pragma unroll
            for (int k = 0; k < 4; ++k) { const int p = lane + 64 * k, tk = p >> 3, c16 = p & 7; *(v4u*)(RY + rb + (size_t)tk * 1024 + c16 * 8) = *(const LAS v4u*)(stg + tk * 72 + c16 * 8); }
        }
        LDS_WAIT();
    }
}

constexpr int AT_LDK = 72, AT_LDV = 300, AT_VT = 288 * AT_LDK * 2;
DI void p2_attention_mfma(Frame& F, const Args& A) {
    LAS bf16* ostg = (LAS bf16*)(F.lds + 81920 + F.wave * 8192);
    LAS bf16* Ks = (LAS bf16*)F.lds; LAS bf16* Vt = (LAS bf16*)(F.lds + AT_VT);
    const bf16* Q = (const bf16*)(F.ws + WS_Q); const bf16* Kb = (const bf16*)(F.ws + WS_K); const bf16* Vb = (const bf16*)(F.ws + WS_V); bf16* AO = (bf16*)(F.ws + WS_AR);
    const int tid = F.tid, lane = F.lane, w = F.wave, r32 = lane & 31, hh = lane >> 5;
    for (int item = blockIdx.x; item < NB * 2 * (SEQ / 128); item += F.G) {
        const int b = item >> 7, kvh = (item >> 6) & 1, jb = item & 63, tok0 = 128 * (jb - 1);
        {
            v4u kvr[5], vvr[5];
#pragma unroll
            for (int u = 0; u < 5; ++u) { const int ch = tid + u * (NWAVES * 64), key = ch >> 3, c = ch & 7;
                const int tk = tok0 + key; int row = key < 256 ? (tk >= 0 ? b * SEQ + tk : -1) : (key < 272 ? M + key - 256 : -1);
                const unsigned msk = (unsigned)~(row >> 31); row = row < 0 ? 0 : row;
                kvr[u] = *(const v4u*)(Kb + (size_t)row * 128 + kvh * 64 + 8 * c); vvr[u] = *(const v4u*)(Vb + (size_t)row * 128 + kvh * 64 + 8 * c);
#pragma unroll
                for (int i = 0; i < 4; ++i) { kvr[u][i] &= msk; vvr[u][i] &= msk; } }
#pragma unroll
            for (int u = 0; u < 5; ++u) { const int ch = tid + u * (NWAVES * 64), key = ch >> 3, c = ch & 7;
                if (u < 4 || ch < 288 * 8) { *(LAS v4u*)(Ks + key * AT_LDK + 8 * c) = kvr[u];
#pragma unroll
                    for (int e2 = 0; e2 < 8; ++e2) Vt[(8 * c + e2) * AT_LDV + key] = (bf16)((e2 & 1) ? (vvr[u][e2 >> 1] >> 16) : (vvr[u][e2 >> 1] & 0xffffu)); } }
        }
        LDS_BARRIER();
        const int g = w & 3, qh = w >> 2, h = kvh * 4 + g;
        const float slope = exp2f(-(float)(h + 1)), sink = A.in[I_SINK][h];
#pragma unroll 1
        for (int qq = 0; qq < 2; ++qq) {
            const int qt = 2 * qh + qq, ql = 32 * qt + r32, t = 128 * jb + ql; const size_t row = (size_t)b * SEQ + t;
            bf16x8 qf[4];
#pragma unroll
            for (int ks = 0; ks < 4; ++ks) qf[ks] = *(const bf16x8*)(Q + row * 512 + h * 64 + 16 * ks + 8 * hh);
            f32x16 sc[6]; float mx = -INFINITY;
            const LAS bf16* kbase = Ks + (32 * qt + r32) * AT_LDK + 8 * hh; const LAS bf16* kmeta = Ks + (256 + r32) * AT_LDK + 8 * hh;
            const LAS bf16* vbase = Vt + r32 * AT_LDV + 32 * qt + 4 * hh; const LAS bf16* vmeta = Vt + r32 * AT_LDV + 256 + 4 * hh;
#pragma unroll
            for (int k6 = 0; k6 < 6; ++k6) { const int kta = k6 < 5 ? qt + k6 : 8; f32x16 acc = zero16(); const LAS bf16* kp = k6 < 5 ? kbase + 32 * k6 * AT_LDK : kmeta;
#pragma unroll
                for (int ks = 0; ks < 4; ++ks) { const bf16x8 a = *(const LAS bf16x8*)(kp + 16 * ks); acc = MFMA32(a, qf[ks], acc); }
#pragma unroll
                for (int i = 0; i < 16; ++i) { const int kr = 8 * (i >> 2) + 4 * hh + (i & 3); bool ok; float dist;
                    if (k6 < 5) { const int kb = 32 * kta + kr, diff = 128 + ql - kb; dist = (float)diff;
                        if (k6 >= 1 && k6 <= 3) ok = jb > 0 || tok0 + kb >= 0;
                        else ok = diff >= 0 && diff < 128 && tok0 + kb >= 0; }
                    else { const int dm = t + 16 - kr; ok = kr < 16; dist = (float)(dm < 128 ? dm : 128); }
                    const float v = ok ? acc[i] - slope * dist : -INFINITY; sc[k6][i] = v; mx = fmaxf(mx, v); } }
            mx = xmax32(mx); mx = fmaxf(mx, sink);
            float sum = 0.f;
#pragma unroll
            for (int k6 = 0; k6 < 6; ++k6)
#pragma unroll
                for (int i = 0; i < 16; ++i) { const float p = __expf(sc[k6][i] - mx); sc[k6][i] = p; sum += p; }
            sum = xsum32(sum); sum += __expf(sink - mx);
            const float inv = 1.0f / sum;
            f32x16 o[2]; o[0] = zero16(); o[1] = zero16();
#pragma unroll
            for (int k6 = 0; k6 < 6; ++k6) { const int kta = k6 < 5 ? qt + k6 : 8;
#pragma unroll
                for (int s = 0; s < 2; ++s) { v4u t4; t4.x = pk2(sc[k6][8 * s], sc[k6][8 * s + 1]); t4.y = pk2(sc[k6][8 * s + 2], sc[k6][8 * s + 3]); t4.z = pk2(sc[k6][8 * s + 4], sc[k6][8 * s + 5]); t4.w = pk2(sc[k6][8 * s + 6], sc[k6][8 * s + 7]);
                    const bf16x8 pb = __builtin_bit_cast(bf16x8, t4);
#pragma unroll
                    for (int dt = 0; dt < 2; ++dt) { const LAS bf16* vp = (k6 < 5 ? vbase + 32 * k6 : vmeta) + 32 * dt * AT_LDV + 16 * s; const v2u lo = *(const LAS v2u*)vp, hi = *(const LAS v2u*)(vp + 8);
                        v4u a4; a4.x = lo.x; a4.y = lo.y; a4.z = hi.x; a4.w = hi.y; o[dt] = MFMA32(__builtin_bit_cast(bf16x8, a4), pb, o[dt]); } } }
#pragma unroll
            for (int dt = 0; dt < 2; ++dt)
#pragma unroll
                for (int g4 = 0; g4 < 4; ++g4) { v2u ov; ov.x = pk2(o[dt][4 * g4] * inv, o[dt][4 * g4 + 1] * inv); ov.y = pk2(o[dt][4 * g4 + 2] * inv, o[dt][4 * g4 + 3] * inv);
                    *(LAS v2u*)(ostg + r32 * 72 + 32 * dt + 8 * g4 + 4 * hh) = ov; }
            LDS_WAIT();
            {
                const size_t rb = ((size_t)b * SEQ + 128 * jb + 32 * qt) * 1024 + h * 64;
#pragma unroll
                for (int k = 0; k < 4; ++k) { const int p = lane + 64 * k, tk = p >> 3, c16 = p & 7; *(v4u*)(AO + rb + (size_t)tk * 1024 + c16 * 8) = *(const LAS v4u*)(ostg + tk * 72 + c16 * 8); }
            }
            LDS_WAIT();
        }
        LDS_BARRIER();
    }
}

constexpr int R_EHI = 0, R_ELO = 65536, R_GHI = 131072, R_GLO = 139264;
DI float sq8(const v4u h) { float s = 0.f;
#pragma unroll
    for (int i = 0; i < 4; ++i) { const unsigned u = i == 0 ? h.x : i == 1 ? h.y : i == 2 ? h.z : h.w; const float a = __uint_as_float(u << 16), b = __uint_as_float(u & 0xffff0000u); s += a * a + b * b; }
    return s; }
DI void split8(const float (&wv)[8], v4u& hi, v4u& lo) {
    unsigned hw[4], lw[4];
#pragma unroll
    for (int i = 0; i < 4; ++i) { hw[i] = pk2(wv[2 * i], wv[2 * i + 1]); lw[i] = pk2(wv[2 * i] - __uint_as_float(hw[i] << 16), wv[2 * i + 1] - __uint_as_float(hw[i] & 0xffff0000u)); }
    hi.x = hw[0]; hi.y = hw[1]; hi.z = hw[2]; hi.w = hw[3]; lo.x = lw[0]; lo.y = lw[1]; lo.z = lw[2]; lo.w = lw[3]; }
DI void p8_router(Frame& F, const Args& A) {
    LAS unsigned char* L = F.lds;
    LAS int* lcnt = (LAS int*)(L + LDS_RT); LAS int* lbase = lcnt + 32; LAS int* ent_e = lcnt + 64; LAS int* ent_p = ent_e + 512; LAS int* ent_d = ent_p + 512; LAS float* ent_w = (LAS float*)(ent_d + 512); LAS float* ent_r = ent_w + 512;
    LAS float* bias = ent_r + 512;
    const bf16* H1 = (const bf16*)(F.ws + WS_AR);
    int* LD = (int*)(F.ws + WS_LISTD); float* LW = (float*)(F.ws + WS_LISTW); float* LR = (float*)(F.ws + WS_LISTR);
    const int lane = F.lane, r32 = lane & 31, hh = lane >> 5;
    if ((int)blockIdx.x >= M / 256) return;
    {
        const float* g2 = A.in[I_NFG];
        for (int it = F.tid; it < 128 * 32; it += NWAVES * 64) { const int e = it & 31, c = it >> 5; float wv[8];
#pragma unroll
            for (int j = 0; j < 8; ++j) wv[j] = A.in[I_WEXP][(8 * c + j) * 32 + e] * g2[8 * c + j];
            v4u hi, lo; split8(wv, hi, lo); const int o = e * 2048 + ((c ^ (e & 15)) << 4);
            *(LAS v4u*)(L + R_EHI + o) = hi; *(LAS v4u*)(L + R_ELO + o) = lo; }
        for (int it = F.tid; it < 128 * 4; it += NWAVES * 64) { const int g = it & 3, c = it >> 2; float wv[8];
#pragma unroll
            for (int j = 0; j < 8; ++j) wv[j] = A.in[I_WGRP][(8 * c + j) * 4 + g] * g2[8 * c + j];
            v4u hi, lo; split8(wv, hi, lo); const int o = g * 2048 + ((c ^ g) << 4);
            *(LAS v4u*)(L + R_GHI + o) = hi; *(LAS v4u*)(L + R_GLO + o) = lo; }
        if (F.tid < 36) bias[F.tid] = F.tid < 4 ? A.in[I_BGRP][F.tid] : A.in[I_BEXP][F.tid - 4];
    }
    for (int ch = blockIdx.x; ch < M / 256; ch += F.G) {
        if (F.tid < 32) lcnt[F.tid] = 0;
        __syncthreads();
        const int tok = ch * 256 + F.wave * 32 + r32;
        const bf16* hp = H1 + (size_t)tok * D + 32 * hh;
        v4u hb[4][4];
#pragma unroll
        for (int u = 0; u < 4; ++u)
#pragma unroll
            for (int s = 0; s < 4; ++s) hb[u][s] = *(const v4u*)(hp + 64 * u + 8 * s);
        f32x16 accE = zero16(), accG = zero16(); float ss = 0.f;
        const LAS unsigned char* eh = L + R_EHI + r32 * 2048; const LAS unsigned char* gh = L + R_GHI + (r32 & 3) * 2048;
        const int sw = r32 & 15, swg = r32 & 3;
#pragma unroll 1
        for (int q0 = 0; q0 < 16; q0 += 4) {
#pragma unroll
            for (int u = 0; u < 4; ++u) { const int q = q0 + u;
#pragma unroll
                for (int s = 0; s < 4; ++s) { const v4u hv = hb[u][s]; const int c = 8 * q + 4 * hh + s;
                    const bf16x8 b = __builtin_bit_cast(bf16x8, hv);
                    const bf16x8 a0 = *(const LAS bf16x8*)(eh + ((c ^ sw) << 4)), a1 = *(const LAS bf16x8*)(eh + (R_ELO - R_EHI) + ((c ^ sw) << 4));
                    const bf16x8 a2 = *(const LAS bf16x8*)(gh + ((c ^ swg) << 4)), a3 = *(const LAS bf16x8*)(gh + (R_GLO - R_GHI) + ((c ^ swg) << 4));
                    accE = MFMA32(a0, b, accE); accG = MFMA32(a2, b, accG); accE = MFMA32(a1, b, accE); accG = MFMA32(a3, b, accG);
                    ss += sq8(hv); }
                if (q + 4 < 16) {
#pragma unroll
                    for (int s = 0; s < 4; ++s) hb[u][s] = *(const v4u*)(hp + 64 * (q + 4) + 8 * s); } }
        }
        ss = xsum32(ss);
        const float rs = 1.0f / sqrtf(ss * (1.0f / D) + 1e-6f);
        float gl[4];
#pragma unroll
        for (int g = 0; g < 4; ++g) gl[g] = __shfl(accG[g], r32) * rs + bias[g];
        int gs = 0; float gm = gl[0];
#pragma unroll
        for (int g = 1; g < 4; ++g) if (gl[g] > gm) { gm = gl[g]; gs = g; }
        float den = 0.f;
#pragma unroll
        for (int g = 0; g < 4; ++g) den += __expf(gl[g] - gm);
        const float pg = 1.0f / den;
        float a1 = -INFINITY, a2 = -INFINITY; int ai1 = 0, ai2 = 0;
#pragma unroll
        for (int j = 0; j < 4; ++j) { const float cd = gs == 0 ? accE[j] : gs == 1 ? accE[4 + j] : gs == 2 ? accE[8 + j] : accE[12 + j];
            const int idx = 4 * hh + j; const float l = cd * rs + bias[4 + gs * 8 + idx];
            if (l > a1) { a2 = a1; ai2 = ai1; a1 = l; ai1 = idx; } else if (l > a2) { a2 = l; ai2 = idx; } }
        const float b1 = __shfl_xor(a1, 32), b2 = __shfl_xor(a2, 32); const int bi1 = __shfl_xor(ai1, 32), bi2 = __shfl_xor(ai2, 32);
        const float p1 = hh ? b1 : a1, p2 = hh ? b2 : a2, q1 = hh ? a1 : b1, q2 = hh ? a2 : b2;
        const int pi1 = hh ? bi1 : ai1, pi2 = hh ? bi2 : ai2, qi1 = hh ? ai1 : bi1, qi2 = hh ? ai2 : bi2;
        float v1, v2; int i1, i2;
        if (p1 >= q1) { v1 = p1; i1 = pi1; if (p2 >= q1) { v2 = p2; i2 = pi2; } else { v2 = q1; i2 = qi1; } }
        else { v1 = q1; i1 = qi1; if (p1 >= q2) { v2 = p1; i2 = pi1; } else { v2 = q2; i2 = qi2; } }
        const float e2 = __expf(v2 - v1), w1 = pg / (1.0f + e2), w2 = pg * e2 / (1.0f + e2);
        { const int ex = gs * 8 + (hh == 0 ? i1 : i2); const int pos = atomicAdd((int*)&lcnt[ex], 1); const int slot = (F.wave * 32 + r32) * 2 + hh;
            ent_e[slot] = ex; ent_p[slot] = pos; ent_d[slot] = tok * 2 + hh; ent_w[slot] = hh == 0 ? w1 : w2; ent_r[slot] = rs; }
        __syncthreads();
        if (F.tid < 32) lbase[F.tid] = (int)__hip_atomic_fetch_add(F.ctl + CW_GCNT + 64 * F.tid, (unsigned)lcnt[F.tid], __ATOMIC_RELAXED, __HIP_MEMORY_SCOPE_AGENT);
        __syncthreads();
        { const int sl = F.tid; const int ex = ent_e[sl]; const size_t o = (size_t)ex * LCAP + lbase[ex] + ent_p[sl]; LD[o] = ent_d[sl]; LW[o] = ent_w[sl]; LR[o] = ent_r[sl]; }
        __syncthreads();
    }
}
__global__ void __launch_bounds__(NWAVES * 64, 2) mk_fwd(Args args) {
    extern __shared__ __attribute__((aligned(16))) unsigned char lds[];
    Frame F;
    F.lds = (LAS unsigned char*)lds;
    F.tid = threadIdx.x; F.lane = F.tid & 63; F.wave = __builtin_amdgcn_readfirstlane(F.tid >> 6); F.G = gridDim.x;
    F.out = args.out; F.ws = args.ws; F.ctl = (unsigned*)(args.ws + WS_CTL);
    volatile LAS unsigned* MISC = (volatile LAS unsigned*)(F.lds + LDS_MISC);
    if (F.tid < 64) MISC[F.tid] = 0u;
    __syncthreads();
    const int lo = args.ph_lo, hi = args.ph_hi;
    XcdBarrier bar; bar.bar = (unsigned*)(F.ctl + CW_BAR); bar.x = 0; bar.st = nullptr;
    if (hi - lo > 1) bar = xcd_barrier_post((unsigned*)(F.ctl + CW_BAR), MISC + 8);
#ifdef ONLY_PHASE
#define IN(k) ((k) == ONLY_PHASE && lo <= (k) && (k) < hi)
#elif defined(SKIP_PHASE)
#define IN(k) ((k) != SKIP_PHASE && lo <= (k) && (k) < hi)
#else
#define IN(k) (lo <= (k) && (k) < hi)
#endif
#ifndef PROBE_MASK
#define PROBE_MASK 0
#endif
#define REPS(k) (1 + ((PROBE_MASK >> (k)) & 1))
#define SEAM(k) do { if (IN(k) && IN((k) + 1)) xcd_barrier(bar); } while (0)
#define LOCAL_SEAM(k) do { if (IN(k) && IN((k) + 1)) { asm volatile("s_waitcnt vmcnt(0)" ::: "memory"); __syncthreads(); __builtin_amdgcn_fence(__ATOMIC_ACQUIRE, "agent"); asm volatile("s_waitcnt vmcnt(0)" ::: "memory"); __syncthreads(); } } while (0)
    unsigned char* ws = args.ws;
    if (IN(0)) { _Pragma("unroll") for (int rep = 0; rep < REPS(0); ++rep) { p0_prologue(F, args); } SEAM(0); }
    if (IN(1)) {
        p1_meta_finish(F, args);
        pg8::Gemm g{(const pg8::bf16_t*)(ws + WS_XB), (const pg8::bf16_t*)(ws + WS_WIN), M, IN_COLS, D, 0}; pg8::StaticOrder S; S.init(M, IN_COLS, F.G, (int)blockIdx.x);
        pg8::EpiIn E{(bf16*)(ws + WS_Q), (bf16*)(ws + WS_K), (bf16*)(ws + WS_V), (bf16*)(ws + WS_RC), (bf16*)F.out};
        _Pragma("unroll") for (int rep = 0; rep < REPS(1); ++rep) { pg8::gemm_phase<pg8::EpiIn, pg8::StaticOrder, true, true>(F.lds, g, S, E); }
        SEAM(1);
    }
    if (IN(2)) { _Pragma("unroll") for (int rep = 0; rep < REPS(2); ++rep) { p2a_lora_inputs(F, args); p2_attention_mfma(F, args); } SEAM(2); }
    if (IN(3)) { _Pragma("unroll") for (int rep = 0; rep < REPS(3); ++rep) { p3_rwkv_chunk(F, args); } SEAM(3); }
    if (IN(4)) { _Pragma("unroll") for (int rep = 0; rep < REPS(4); ++rep) { if (F.G >= 2 * NB * 8 * 2) expert_weights(F, args, NB * 8 * 2); else { expert_weights(F, args, 0); LDS_BARRIER(); } p4_rwkv_chain(F, args); } SEAM(4); }
    if (IN(5)) { _Pragma("unroll") for (int rep = 0; rep < REPS(5); ++rep) { p5_rwkv_out(F, args); } LOCAL_SEAM(5); }
    if (IN(6)) {
        pg8::Gemm g{(const pg8::bf16_t*)(ws + WS_AR), (const pg8::bf16_t*)(ws + WS_WOA), M, D, D, 512}; pg8::PairOrder<pg8::PanelOrder> S; S.base.init(M, D, F.G, (int)blockIdx.x); S.koff_bytes = 1024;
        pg8::EpiGate2 E{(const bf16*)F.out, (bf16*)(ws + WS_MG)};
        _Pragma("unroll") for (int rep = 0; rep < REPS(6); ++rep) { pg8::gemm_phase<pg8::EpiGate2, pg8::PairOrder<pg8::PanelOrder>, true, true>(F.lds, g, S, E); }
        LOCAL_SEAM(6);
    }
    if (IN(7)) {
        pg8::Gemm g{(const pg8::bf16_t*)(ws + WS_MG), (const pg8::bf16_t*)(ws + WS_WOUT), M, D, D, 0}; pg8::PanelOrder S; S.init(M, D, F.G, (int)blockIdx.x);
        pg8::EpiRes E{args.in[I_X], (bf16*)(ws + WS_AR)};
        _Pragma("unroll") for (int rep = 0; rep < REPS(7); ++rep) { pg8::gemm_phase<pg8::EpiRes, pg8::PanelOrder, true, true>(F.lds, g, S, E); }
        LOCAL_SEAM(7);
    }
    if (IN(8)) { _Pragma("unroll") for (int rep = 0; rep < REPS(8); ++rep) { p8_router(F, args); } SEAM(8); }
    if (IN(9)) {
        const int TT = moe_table(F);
        const LAS int* tile_e = (const LAS int*)(F.lds + LDS_TBL); const LAS int* tb = tile_e + TT_MAX;
        LAS int* ldd = (LAS int*)(F.lds + 131072); LAS float* ldw = (LAS float*)(F.lds + 131072 + 8 * 1024); LAS float* ldr = (LAS float*)(F.lds + 131072 + 16 * 1024);
        pg8::Gemm g{(const pg8::bf16_t*)(ws + WS_XN2), (const pg8::bf16_t*)(ws + WS_WGU), CAP, NE * 512, D, 0};
        pg8::GroupedOrder<true> S{tile_e, tb, TT, 2, F.G, (int)blockIdx.x, ldd, (unsigned)(D * 2)};
        { const int* LD = (const int*)(ws + WS_LISTD); const float* LW = (const float*)(ws + WS_LISTW); const float* LR = (const float*)(ws + WS_LISTR);
          for (int idx = F.tid; idx < 8 * 256; idx += NWAVES * 64) { pg8::Unit u; const int i = idx >> 8, r = idx & 255;
              if (S.next(i, u)) { const int li = u.r0 + r; const bool ok = li < u.cnt; const int e = u.pn >> 1; const float rs = ok ? LR[e * LCAP + li] : 0.f; ldd[idx] = ok ? LD[e * LCAP + li] : -1; ldw[idx] = ok ? LW[e * LCAP + li] * rs * rs : 0.f; ldr[idx] = rs; } }
          __syncthreads(); }
        pg8::EpiSwiglu E{(bf16*)(ws + WS_HMID), ldd, ldw, ldr, (int*)(ws + WS_SLOTD)};
        _Pragma("unroll") for (int rep = 0; rep < REPS(9); ++rep) { pg8::gemm_phase<pg8::EpiSwiglu, pg8::GroupedOrder<true>, true, true>(F.lds, g, S, E); }
        SEAM(9);
    }
    if (IN(10)) {
        const int TT = moe_table(F);
        const LAS int* tile_e = (const LAS int*)(F.lds + LDS_TBL); const LAS int* tb = tile_e + TT_MAX;
        LAS int* lsl = (LAS int*)(F.lds + 131072);
        pg8::Gemm g{(const pg8::bf16_t*)(ws + WS_HMID), (const pg8::bf16_t*)(ws + WS_WDN), CAP, NE * 1024, 256, 0};
        pg8::GroupedOrder<false> S{tile_e, tb, TT, 4, F.G, (int)blockIdx.x, nullptr, 0u};
        { const int* SD = (const int*)(ws + WS_SLOTD);
          for (int idx = F.tid; idx < 12 * 256; idx += NWAVES * 64) { pg8::Unit u; const int i = idx >> 8, r = idx & 255; if (S.next(i, u)) lsl[idx] = SD[u.pm * 256 + r]; }
          __syncthreads(); }
        pg8::EpiDown E{(unsigned char*)(ws + WS_Y), lsl};
        _Pragma("unroll") for (int rep = 0; rep < REPS(10); ++rep) { pg8::gemm_phase<pg8::EpiDown, pg8::GroupedOrder<false>, true, true>(F.lds, g, S, E); }
        SEAM(10);
    }
    if (IN(11)) { _Pragma("unroll") for (int rep = 0; rep < REPS(11); ++rep) { p12_final(F, args); } }
#undef IN
#undef SEAM
}

extern "C" void kernel_launch(void* const* d_in, const int* in_sizes, int n_in, void* d_out, int out_size, void* d_ws, size_t ws_size, hipStream_t stream) {
    static int grid = 0;
    if (grid == 0) {
        if (n_in != 28 || in_sizes[0] != M * D || out_size != M * D || ws_size < WS_END) { fprintf(stderr, "kernel_launch: unexpected shapes (n_in %d, in0 %d, out %d, ws %zu)\n", n_in, n_in > 0 ? in_sizes[0] : -1, out_size, ws_size); grid = -1; return; }
        int dev = 0, cus = 0, per_cu = 0;
        if (hipGetDevice(&dev) != hipSuccess || hipDeviceGetAttribute(&cus, hipDeviceAttributeMultiprocessorCount, dev) != hipSuccess) { grid = -1; return; }
        if (hipFuncSetAttribute((const void*)mk_fwd, hipFuncAttributeMaxDynamicSharedMemorySize, LDS_BYTES) != hipSuccess) { fprintf(stderr, "kernel_launch: hipFuncSetAttribute failed\n"); grid = -1; return; }
        if (hipOccupancyMaxActiveBlocksPerMultiprocessor(&per_cu, (const void*)mk_fwd, NWAVES * 64, LDS_BYTES) != hipSuccess || per_cu < 1) fprintf(stderr, "kernel_launch: occupancy query reports %d\n", per_cu);
        (void)hipGetLastError();
        grid = cus;
    }
    if (grid < 0) return;
    if (hipMemsetAsync((char*)d_ws + WS_CTL, 0, CTL_ZERO_BYTES, stream) != hipSuccess) return;
    Args a{};
    for (int i = 0; i < 28; ++i) a.in[i] = (const float*)d_in[i];
    a.out = (float*)d_out; a.ws = (unsigned char*)d_ws;
#if MK_ONE_LAUNCH
    a.ph_lo = 0; a.ph_hi = N_PHASES; a.li = 0;
    hipLaunchKernelGGL(mk_fwd, dim3(grid), dim3(NWAVES * 64), LDS_BYTES, stream, a);
#else
    for (int p = 0; p < N_PHASES; ++p) { a.ph_lo = p; a.ph_hi = p + 1; a.li = p; hipLaunchKernelGGL(mk_fwd, dim3(grid), dim3(NWAVES * 64), LDS_BYTES, stream, a); }
#endif
}
```

```cpp
#include <hip/hip_runtime.h>
#include <cstdio>
#include <cstdint>
#define PROBE_MASK 0
namespace pg8 {
#define PG8_LAS __attribute__((address_space(3)))
typedef unsigned short bf16_t;
typedef short bf16x8 __attribute__((ext_vector_type(8)));
typedef float f32x4 __attribute__((ext_vector_type(4)));
typedef unsigned u32x4 __attribute__((ext_vector_type(4)));
constexpr int BM = 256, BK = 64, HALF = 128, HTB = HALF * BK * 2  , STAGE_BYTES = 8 * HTB, NXCD = 8, WGM = 8;

__host__ __device__ __forceinline__ int lds_byte(int r, int c) { const int st = (r >> 4) * 2 + (c >> 5), rr = r & 15, cc = c & 31, ob = rr * 64 + cc * 2; return st * 1024 + (ob ^ (((ob >> 9) & 1) << 5)); }
__host__ __device__ __forceinline__ void stage_rc(int b, int& R, int& C) { const int st = b / 1024, sb = b % 1024, swz = sb ^ (((sb >> 9) & 1) << 5); R = (st >> 1) * 16 + swz / 64; C = (st & 1) * 32 + (swz % 64) / 2; }
__host__ __device__ __forceinline__ int perm32(int rho) { const int n = rho >> 4, i = rho & 15; return 8 * (i >> 2) + 4 * n + (i & 3); }

struct Unit { int pm, pn, r0, cnt, ord; };
struct Gemm { const bf16_t* A; const bf16_t* Bt; int M, N, K, kext; };

struct StaticOrder {
    static constexpr bool GATHER = false;
    __device__ __forceinline__ unsigned a_off(const Unit&, int) const { return 0u; }
    __device__ __forceinline__ size_t koff(const Unit&) const { return 0; }
    __device__ __forceinline__ bool is_mid(const Unit&) const { return false; }
    int nM, nN, nwg, G, c;
    __host__ __device__ void init(int M, int N, int G_, int c_) { nM = M / BM; nN = N / BM; nwg = nM * nN; G = G_; c = c_; }
    __host__ __device__ bool next(int i, Unit& u) const {
        const long L = (long)i * G + c; if (L >= nwg) return false;
        int wgid = (int)L; { const int q = nwg / NXCD, r = nwg % NXCD, xcd = wgid % NXCD, off = wgid / NXCD; wgid = (xcd < r ? xcd * (q + 1) : r * (q + 1) + (xcd - r) * q) + off; }
        const int nig = WGM * nN, gid = wgid / nig, fm = gid * WGM, gsz = (nM - fm) < WGM ? (nM - fm) : WGM;
        u.pm = fm + ((wgid % nig) % gsz); u.pn = (wgid % nig) / gsz; u.r0 = 0; u.cnt = 0; u.ord = i; return true;
    }
    __device__ __forceinline__ void a_ready(const Unit&) const {}
    __device__ __forceinline__ void done(const Unit&) const {}
};

__device__ __forceinline__ unsigned cvt_pk_bf16(float lo, float hi) { unsigned r; asm volatile("v_cvt_pk_bf16_f32 %0, %1, %2" : "=v"(r) : "v"(lo), "v"(hi)); return r; }
typedef float f32x2 __attribute__((ext_vector_type(2)));

struct PanelOrder {
    static constexpr bool GATHER = false;
    int nM, nN, G, c;
    __host__ __device__ void init(int M, int N, int G_, int c_) { nM = M / BM; nN = N / BM; G = G_; c = c_; }
    __device__ __forceinline__ bool next(int i, Unit& u) const { const int p = c + (i / nN) * G; if (p >= nM) return false; u.pm = p; u.pn = i % nN; u.r0 = 0; u.cnt = 0; u.ord = i; return true; }
    __device__ __forceinline__ unsigned a_off(const Unit&, int) const { return 0u; }
    __device__ __forceinline__ size_t koff(const Unit&) const { return 0; }
    __device__ __forceinline__ bool is_mid(const Unit&) const { return false; }
    __device__ __forceinline__ void a_ready(const Unit&) const {}
    __device__ __forceinline__ void done(const Unit&) const {}
};
template <class Base> struct PairOrder {
    static constexpr bool GATHER = false;
    Base base; size_t koff_bytes;
    __device__ __forceinline__ bool next(int i, Unit& u) const { if (!base.next(i >> 1, u)) return false; u.r0 = i & 1; u.cnt = 0; u.ord = i; return true; }
    __device__ __forceinline__ unsigned a_off(const Unit&, int) const { return 0u; }
    __device__ __forceinline__ size_t koff(const Unit& u) const { return u.r0 ? koff_bytes : (size_t)0; }
    __device__ __forceinline__ bool is_mid(const Unit& u) const { return u.r0 == 0; }
    __device__ __forceinline__ void a_ready(const Unit&) const {}
    __device__ __forceinline__ void done(const Unit&) const {}
};
template <class Epi, class Sched, bool ALIGN_EPI = false, bool SP2 = false>
__device__ __forceinline__ void gemm_phase(PG8_LAS unsigned char* lds, const Gemm g, const Sched& S, const Epi& E) {
    const int tid = threadIdx.x, wid = __builtin_amdgcn_readfirstlane(tid >> 6), lane = tid & 63, wr = wid >> 2, wc = wid & 3, fr = lane & 15, fq = lane >> 4;
    const int K = g.K, nt = (g.kext ? g.kext : K) / BK;
    unsigned voffA[2], voffB[2];
#pragma unroll
    for (int i = 0; i < 2; ++i) { int R, C; stage_rc(tid * 16 + i * 8192, R, C); const int Rb = Epi::PERM ? ((R & ~31) + perm32(R & 31)) : R;
        voffA[i] = (unsigned)(R * K + C) * 2u; voffB[i] = (unsigned)(Rb * K + C) * 2u; }
    unsigned gAc[2][2], gAn[2][2]; int gR[2], gC[2];
#pragma unroll
    for (int i = 0; i < 2; ++i) { int R, C; stage_rc(tid * 16 + i * 8192, R, C); gR[i] = R; gC[i] = C * 2; gAc[0][i] = gAc[1][i] = gAn[0][i] = gAn[1][i] = 0u; }
    const size_t kstep = (size_t)(BK * 2);
    const size_t hstep = (size_t)HALF * K * 2;
    const size_t hstepA = Sched::GATHER ? (size_t)0 : hstep;
    const size_t tstep = 2 * hstep;
    const unsigned ldsw = (unsigned)wid * 1024u;
    const int aoff = lds_byte(wr * 64 + fr, fq * 8), boff = lds_byte(wc * 32 + fr, fq * 8);
#define PG8_SA(b, h) (((b) * 2 + (h)) * HTB)
#define PG8_SB(b, h) ((4 + (b) * 2 + (h)) * HTB)
#define PG8_STAGE(bufoff, gbase, voff) do { _Pragma("unroll") for (int _i = 0; _i < 2; ++_i) \
        __builtin_amdgcn_global_load_lds((const unsigned*)((const char*)(gbase) + (voff)[_i]), (PG8_LAS unsigned*)(lds + (bufoff) + ldsw + _i * 8192), 16, 0, 0); } while (0)
#define PG8_LDA(dst, b, h) do { _Pragma("unroll") for (int m = 0; m < 4; ++m) _Pragma("unroll") for (int k = 0; k < 2; ++k) dst[m][k] = *(const PG8_LAS bf16x8*)(lds + PG8_SA(b, h) + aoff + m * 2048 + k * 1024); } while (0)
#define PG8_LDB(dst, b, h) do { _Pragma("unroll") for (int n = 0; n < 2; ++n) _Pragma("unroll") for (int k = 0; k < 2; ++k) dst[n][k] = *(const PG8_LAS bf16x8*)(lds + PG8_SB(b, h) + boff + n * 2048 + k * 1024); } while (0)
#define PG8_MMA(ai, bj, At, Bt) do { __builtin_amdgcn_s_setprio(1); _Pragma("unroll") for (int m = 0; m < 4; ++m) _Pragma("unroll") for (int n = 0; n < 2; ++n) _Pragma("unroll") for (int k = 0; k < 2; ++k) \
        acc[ai][bj][m][n] = __builtin_amdgcn_mfma_f32_16x16x32_bf16(Bt[n][k], At[m][k], acc[ai][bj][m][n], 0, 0, 0); __builtin_amdgcn_s_setprio(0); } while (0)
#define PG8_WAIT_V(n) asm volatile("s_waitcnt vmcnt(" #n ")" ::: "memory")
#define PG8_WAIT_L(n) asm volatile("s_waitcnt lgkmcnt(" #n ")" ::: "memory")
#define PG8_BAR __builtin_amdgcn_s_barrier()
#define PG8_SCHED __builtin_amdgcn_sched_barrier(0)
    Unit cur, nxt; int ui = 0;
    if (!S.next(0, cur)) return;
    f32x4 acc[2][2][4][2];
#pragma unroll
    for (int a = 0; a < 2; ++a)
#pragma unroll
        for (int b = 0; b < 2; ++b)
#pragma unroll
            for (int m = 0; m < 4; ++m)
#pragma unroll
                for (int n = 0; n < 2; ++n) acc[a][b][m][n] = (f32x4){0.f, 0.f, 0.f, 0.f};
    bf16x8 At[4][2], B0[2][2], B1[2][2];
    const char* cA = (const char*)g.A + (Sched::GATHER ? (size_t)0 : (size_t)cur.pm * tstep) + S.koff(cur); const char* cB = (const char*)g.Bt + (size_t)cur.pn * tstep + S.koff(cur);
    if constexpr (Sched::GATHER) {
#pragma unroll
        for (int h = 0; h < 2; ++h)
#pragma unroll
            for (int i = 0; i < 2; ++i) gAc[h][i] = S.a_off(cur, h * HALF + gR[i]) + (unsigned)gC[i]; }
#define PG8_VA(sel, h) (Sched::GATHER ? (sel)[h] : voffA)
    S.a_ready(cur);
    if constexpr (SP2) {
        PG8_STAGE(PG8_SB(0, 0), cB, voffB); PG8_STAGE(PG8_SB(0, 1), cB + hstep, voffB); PG8_STAGE(PG8_SA(0, 0), cA, PG8_VA(gAc, 0)); PG8_STAGE(PG8_SA(0, 1), cA + hstepA, PG8_VA(gAc, 1));
        if (wr == 1) PG8_BAR;
        PG8_WAIT_V(2); PG8_BAR;
        PG8_STAGE(PG8_SB(1, 0), cB + kstep, voffB); PG8_STAGE(PG8_SA(1, 0), cA + kstep, PG8_VA(gAc, 0)); PG8_STAGE(PG8_SB(1, 1), cB + hstep + kstep, voffB);
        PG8_WAIT_V(6); PG8_BAR;
    } else {
        PG8_STAGE(PG8_SB(0, 0), cB, voffB); PG8_STAGE(PG8_SA(0, 0), cA, voffA); PG8_STAGE(PG8_SB(0, 1), cB + hstep, voffB); PG8_STAGE(PG8_SA(0, 1), cA + hstep, voffA);
        if (wr == 1) PG8_BAR;
        PG8_WAIT_V(4); PG8_BAR;
        PG8_STAGE(PG8_SB(1, 0), cB + kstep, voffB); PG8_STAGE(PG8_SA(1, 0), cA + kstep, voffA); PG8_STAGE(PG8_SB(1, 1), cB + hstep + kstep, voffB);
        PG8_WAIT_V(6); PG8_BAR;
    }
    for (;;) {
        const bool has_next = S.next(ui + 1, nxt);
        const char* nA = (has_next && !Sched::GATHER) ? (const char*)g.A + (size_t)nxt.pm * tstep + S.koff(nxt) : cA; const char* nB = has_next ? (const char*)g.Bt + (size_t)nxt.pn * tstep + S.koff(nxt) : cB;
        if constexpr (Sched::GATHER) {
#pragma unroll
            for (int h = 0; h < 2; ++h)
#pragma unroll
                for (int i = 0; i < 2; ++i) gAn[h][i] = has_next ? S.a_off(nxt, h * HALF + gR[i]) + (unsigned)gC[i] : gAc[h][i]; }
#pragma unroll 1
        for (int t = 0; t < nt; t += 2) {
            const bool last = (t == nt - 2);
            const char* a1 = cA + (size_t)(t + 1) * kstep;
            const char* a2 = last ? nA : cA + (size_t)(t + 2) * kstep; const char* b2 = last ? nB : cB + (size_t)(t + 2) * kstep;
            const char* a3 = a2 + kstep; const char* b3 = b2 + kstep;
            if (last && has_next) S.a_ready(nxt);
            unsigned g2[2][2];
#pragma unroll
            for (int h = 0; h < 2; ++h)
#pragma unroll
                for (int i = 0; i < 2; ++i) g2[h][i] = last ? gAn[h][i] : gAc[h][i];
            if constexpr (SP2) {
            PG8_LDB(B0, 0, 0); PG8_LDB(B1, 0, 1); PG8_SCHED; PG8_LDA(At, 0, 0); PG8_STAGE(PG8_SA(1, 1), a1 + hstepA, PG8_VA(gAc, 1));
            PG8_WAIT_V(8); PG8_WAIT_L(0); PG8_BAR; PG8_MMA(0, 0, At, B0); PG8_MMA(0, 1, At, B1); PG8_BAR; PG8_SCHED;
            PG8_LDA(At, 0, 1); PG8_STAGE(PG8_SB(0, 0), b2, voffB); PG8_STAGE(PG8_SB(0, 1), b2 + hstep, voffB); PG8_STAGE(PG8_SA(0, 0), a2, PG8_VA(g2, 0));
            PG8_WAIT_V(8); PG8_WAIT_L(0); PG8_BAR; PG8_MMA(1, 0, At, B0); PG8_MMA(1, 1, At, B1); PG8_BAR; PG8_SCHED;
            PG8_LDB(B0, 1, 0); PG8_LDB(B1, 1, 1); PG8_SCHED; PG8_LDA(At, 1, 0); PG8_STAGE(PG8_SA(0, 1), a2 + hstepA, PG8_VA(g2, 1));
            PG8_WAIT_V(8); PG8_WAIT_L(0); PG8_BAR; PG8_MMA(0, 0, At, B0); PG8_MMA(0, 1, At, B1); PG8_BAR; PG8_SCHED;
            PG8_LDA(At, 1, 1); PG8_STAGE(PG8_SB(1, 0), b3, voffB); PG8_STAGE(PG8_SB(1, 1), b3 + hstep, voffB); PG8_STAGE(PG8_SA(1, 0), a3, PG8_VA(g2, 0));
            PG8_WAIT_V(8); PG8_WAIT_L(0); PG8_BAR; PG8_MMA(1, 0, At, B0); PG8_MMA(1, 1, At, B1); PG8_BAR; PG8_SCHED;
            } else {
            PG8_LDB(B0, 0, 0); PG8_SCHED; PG8_LDA(At, 0, 0); PG8_STAGE(PG8_SA(1, 1), a1 + hstep, voffA);
            PG8_WAIT_L(8); PG8_BAR; PG8_WAIT_L(0); PG8_MMA(0, 0, At, B0); PG8_BAR; PG8_SCHED;
            PG8_LDB(B1, 0, 1); PG8_STAGE(PG8_SB(0, 0), b2, voffB);
            PG8_BAR; PG8_WAIT_L(0); PG8_MMA(0, 1, At, B1); PG8_BAR;
            PG8_LDA(At, 0, 1); PG8_STAGE(PG8_SA(0, 0), a2, voffA);
            PG8_BAR; PG8_WAIT_L(0); PG8_MMA(1, 0, At, B0); PG8_BAR; PG8_SCHED;
            PG8_STAGE(PG8_SB(0, 1), b2 + hstep, voffB);
            PG8_WAIT_V(6); PG8_BAR; PG8_MMA(1, 1, At, B1); PG8_BAR;
            PG8_LDB(B0, 1, 0); PG8_SCHED; PG8_LDA(At, 1, 0); PG8_STAGE(PG8_SA(0, 1), a2 + hstep, voffA);
            PG8_WAIT_L(8); PG8_BAR; PG8_WAIT_L(0); PG8_MMA(0, 0, At, B0); PG8_BAR; PG8_SCHED;
            PG8_LDB(B1, 1, 1); PG8_STAGE(PG8_SB(1, 0), b3, voffB);
            PG8_BAR; PG8_WAIT_L(0); PG8_MMA(0, 1, At, B1); PG8_BAR;
            PG8_LDA(At, 1, 1); PG8_STAGE(PG8_SA(1, 0), a3, voffA);
            PG8_BAR; PG8_WAIT_L(0); PG8_MMA(1, 0, At, B0); PG8_BAR; PG8_SCHED;
            PG8_STAGE(PG8_SB(1, 1), b3 + hstep, voffB);
            PG8_WAIT_V(6); PG8_BAR; PG8_MMA(1, 1, At, B1); PG8_BAR;
            }
        }
        if constexpr (ALIGN_EPI) { if (wr == 0) PG8_BAR; }
        bool keep_acc = false;
        if constexpr (Epi::MIDK) { if (S.is_mid(cur)) { E.mid(acc, cur, wr, wc, fr, fq); keep_acc = true; } else E(acc, cur, wr, wc, fr, fq); }
        else if constexpr (!Epi::AFTER_DRAIN) { E(acc, cur, wr, wc, fr, fq);
#ifdef PROBE_EPI2
            if constexpr (Epi::PROBE2) { asm volatile("" ::: "memory"); E(acc, cur, wr, wc, fr, fq); }
#endif
            S.done(cur); }
        if (!has_next) break;
        if (!keep_acc)
#pragma unroll
        for (int a = 0; a < 2; ++a)
#pragma unroll
            for (int b = 0; b < 2; ++b)
#pragma unroll
                for (int m = 0; m < 4; ++m)
#pragma unroll
                    for (int n = 0; n < 2; ++n) acc[a][b][m][n] = (f32x4){0.f, 0.f, 0.f, 0.f};
        cur = nxt; cA = nA; cB = nB; ++ui;
        if constexpr (Sched::GATHER) {
#pragma unroll
            for (int h = 0; h < 2; ++h)
#pragma unroll
                for (int i = 0; i < 2; ++i) gAc[h][i] = gAn[h][i]; }
        if constexpr (ALIGN_EPI) { if (wr == 1) PG8_BAR; }
    }
    PG8_WAIT_V(0);
    if constexpr (!ALIGN_EPI) { if (wr == 0) PG8_BAR; }
    PG8_BAR;
    if constexpr (Epi::AFTER_DRAIN) { E.fused(acc, cur, wr, wc, fr, fq, lds, wid, lane); S.done(cur); }
#undef PG8_SA
#undef PG8_VA
#undef PG8_SB
#undef PG8_STAGE
#undef PG8_LDA
#undef PG8_LDB
#undef PG8_MMA
#undef PG8_WAIT_V
#undef PG8_WAIT_L
#undef PG8_BAR
#undef PG8_SCHED
}

__device__ __forceinline__ float sigm(float x) { return __builtin_amdgcn_rcpf(1.0f + __builtin_amdgcn_exp2f(-1.44269504089f * x)); }
__device__ __forceinline__ f32x4 up_lo(u32x4 w) { f32x4 r; r[0] = __uint_as_float(w[0] << 16); r[1] = __uint_as_float(w[0] & 0xffff0000u); r[2] = __uint_as_float(w[1] << 16); r[3] = __uint_as_float(w[1] & 0xffff0000u); return r; }
__device__ __forceinline__ f32x4 up_hi(u32x4 w) { f32x4 r; r[0] = __uint_as_float(w[2] << 16); r[1] = __uint_as_float(w[2] & 0xffff0000u); r[2] = __uint_as_float(w[3] << 16); r[3] = __uint_as_float(w[3] & 0xffff0000u); return r; }
__device__ __forceinline__ u32x4 pack8(f32x4 v0, f32x4 v1) { u32x4 w; w.x = cvt_pk_bf16(v0[0], v0[1]); w.y = cvt_pk_bf16(v0[2], v0[3]); w.z = cvt_pk_bf16(v1[0], v1[1]); w.w = cvt_pk_bf16(v1[2], v1[3]); return w; }

struct EpiIn {
    static constexpr bool PERM = true, AFTER_DRAIN = false, MIDK = false, PROBE2 = true;
    bf16_t *Q, *Kb, *Vb, *RC, *G;
    __device__ __forceinline__ void operator()(const f32x4 (&acc)[2][2][4][2], const Unit& u, int wr, int wc, int fr, int fq) const {
        const int row0 = u.pm * BM + wr * 64 + fr, cl = wc * 32 + 8 * fq;
        bf16_t* b0; bf16_t* b1; int ld; const int pn = u.pn;
        if (pn < 2) { ld = 512; b0 = Q + pn * 256 + cl; b1 = b0 + 128; }
        else if (pn == 2) { ld = 128; b0 = Kb + cl; b1 = Vb + cl; }
        else if (pn < 10) { ld = 1792; b0 = RC + (pn - 3) * 256 + cl; b1 = b0 + 128; }
        else { ld = 2048; b0 = G + (pn - 10) * 128 + cl; b1 = b0 + 1024; }
        const bool sg = pn >= 10;
#pragma unroll
        for (int ai = 0; ai < 2; ++ai)
#pragma unroll
            for (int m = 0; m < 4; ++m) { const int row = row0 + ai * HALF + m * 16;
                f32x4 a0 = acc[ai][0][m][0], a1 = acc[ai][0][m][1], c0 = acc[ai][1][m][0], c1 = acc[ai][1][m][1];
                if (sg) {
#pragma unroll
                    for (int j = 0; j < 4; ++j) { const float ea0 = __builtin_amdgcn_exp2f(-1.44269504089f * a0[j]), ea1 = __builtin_amdgcn_exp2f(-1.44269504089f * a1[j]), eb0 = __builtin_amdgcn_exp2f(-1.44269504089f * c0[j]), eb1 = __builtin_amdgcn_exp2f(-1.44269504089f * c1[j]);
                        a0[j] = (1.0f + eb0) * __builtin_amdgcn_rcpf(1.0f + ea0); a1[j] = (1.0f + eb1) * __builtin_amdgcn_rcpf(1.0f + ea1); c0[j] = __builtin_amdgcn_rcpf(1.0f + eb0); c1[j] = __builtin_amdgcn_rcpf(1.0f + eb1); } }
                *(u32x4*)(b0 + (size_t)row * ld) = pack8(a0, a1); *(u32x4*)(b1 + (size_t)row * ld) = pack8(c0, c1); }
    }
};
struct EpiGate2 {
    static constexpr bool PERM = true, AFTER_DRAIN = false, MIDK = true;
    const bf16_t* G; bf16_t* O;
    __device__ __forceinline__ void mid(f32x4 (&acc)[2][2][4][2], const Unit& u, int wr, int wc, int fr, int fq) const {
        const int row0 = u.pm * BM + wr * 64 + fr, col0 = u.pn * BM + wc * 32 + 8 * fq;
        u32x4 g0w[2][4][2];
#pragma unroll
        for (int ai = 0; ai < 2; ++ai)
#pragma unroll
            for (int m = 0; m < 4; ++m)
#pragma unroll
                for (int bj = 0; bj < 2; ++bj) g0w[ai][m][bj] = *(const u32x4*)(G + (size_t)(row0 + ai * HALF + m * 16) * 2048 + col0 + bj * HALF);
#pragma unroll
        for (int ai = 0; ai < 2; ++ai)
#pragma unroll
            for (int m = 0; m < 4; ++m)
#pragma unroll
                for (int bj = 0; bj < 2; ++bj)
#pragma unroll
                    for (int j = 0; j < 4; ++j) { const unsigned gn = g0w[ai][m][bj][j];
                        acc[ai][bj][m][j >> 1][2 * (j & 1)] *= __uint_as_float(gn << 16); acc[ai][bj][m][j >> 1][2 * (j & 1) + 1] *= __uint_as_float(gn & 0xffff0000u); }
    }
    __device__ __forceinline__ void operator()(const f32x4 (&acc)[2][2][4][2], const Unit& u, int wr, int wc, int fr, int fq) const {
        const int row0 = u.pm * BM + wr * 64 + fr, col0 = u.pn * BM + wc * 32 + 8 * fq;
        u32x4 gw[2][4][2];
#pragma unroll
        for (int ai = 0; ai < 2; ++ai)
#pragma unroll
            for (int m = 0; m < 4; ++m)
#pragma unroll
                for (int bj = 0; bj < 2; ++bj) gw[ai][m][bj] = *(const u32x4*)(G + (size_t)(row0 + ai * HALF + m * 16) * 2048 + 1024 + col0 + bj * HALF);
#pragma unroll
        for (int ai = 0; ai < 2; ++ai)
#pragma unroll
            for (int m = 0; m < 4; ++m)
#pragma unroll
                for (int bj = 0; bj < 2; ++bj) *(u32x4*)(O + (size_t)(row0 + ai * HALF + m * 16) * 1024 + col0 + bj * HALF) = pack8(acc[ai][bj][m][0] * up_lo(gw[ai][m][bj]), acc[ai][bj][m][1] * up_hi(gw[ai][m][bj]));
    }
};
struct EpiRes {
    static constexpr bool PERM = true, AFTER_DRAIN = false, MIDK = false, PROBE2 = false;
    const float* X; bf16_t* O;
    __device__ __forceinline__ void operator()(const f32x4 (&acc)[2][2][4][2], const Unit& u, int wr, int wc, int fr, int fq) const {
        const int row0 = u.pm * BM + wr * 64 + fr, col0 = u.pn * BM + wc * 32 + 8 * fq;
#pragma unroll
        for (int ai = 0; ai < 2; ++ai) { f32x4 xv[4][2][2];
#pragma unroll
            for (int m = 0; m < 4; ++m)
#pragma unroll
                for (int bj = 0; bj < 2; ++bj)
#pragma unroll
                    for (int n = 0; n < 2; ++n) xv[m][bj][n] = *(const f32x4*)(X + (size_t)(row0 + ai * HALF + m * 16) * 1024 + col0 + bj * HALF + 4 * n);
#pragma unroll
            for (int m = 0; m < 4; ++m)
#pragma unroll
                for (int bj = 0; bj < 2; ++bj) *(u32x4*)(O + (size_t)(row0 + ai * HALF + m * 16) * 1024 + col0 + bj * HALF) = pack8(xv[m][bj][0] + acc[ai][bj][m][0], xv[m][bj][1] + acc[ai][bj][m][1]);
            asm volatile("" ::: "memory"); }
    }
};
template <bool GATHER_> struct GroupedOrder {
    static constexpr bool GATHER = GATHER_;
    const PG8_LAS int* tile_e; const PG8_LAS int* tb; int ntiles, ntn, G, c; const PG8_LAS int* lds_d; unsigned rowbytes;
    __device__ __forceinline__ bool next(int i, Unit& u) const {
        const int L = i * G + c; if (L >= ntiles * ntn) return false;
        const int mt = L / ntn, nl = L - mt * ntn; const int e = __builtin_amdgcn_readfirstlane(tile_e[mt]);
        u.pm = mt; u.pn = e * ntn + nl; u.r0 = __builtin_amdgcn_readfirstlane((mt - tb[e]) * BM); u.cnt = __builtin_amdgcn_readfirstlane(tb[33 + e]); u.ord = i; return true;
    }
    __device__ __forceinline__ unsigned a_off(const Unit& u, int r) const {
        const int d = lds_d[u.ord * BM + r]; const int tok = d >= 0 ? (d >> 1) : 0;
        return (unsigned)tok * rowbytes;
    }
    __device__ __forceinline__ size_t koff(const Unit&) const { return 0; }
    __device__ __forceinline__ bool is_mid(const Unit&) const { return false; }
    __device__ __forceinline__ void a_ready(const Unit&) const {}
    __device__ __forceinline__ void done(const Unit&) const {}
};
struct EpiSwiglu {
    static constexpr bool PERM = true, AFTER_DRAIN = false, MIDK = false, PROBE2 = false;
    bf16_t* H; const PG8_LAS int* lds_d; const PG8_LAS float* lds_w; const PG8_LAS float* lds_r; int* slot_dst;
    __device__ __forceinline__ void operator()(const f32x4 (&acc)[2][2][4][2], const Unit& u, int wr, int wc, int fr, int fq) const {
        const int rl0 = wr * 64 + fr, row0 = u.pm * BM + rl0, col0 = (u.pn & 1) * 128 + wc * 32 + 8 * fq;
        const bool slots = (u.pn & 1) == 0 && wc == 0 && fq == 0;
        int ld8[2][4]; float lw8[2][4], lr8[2][4];
#pragma unroll
        for (int ai = 0; ai < 2; ++ai)
#pragma unroll
            for (int m = 0; m < 4; ++m) { const int rl = u.ord * BM + rl0 + ai * HALF + m * 16; ld8[ai][m] = lds_d[rl]; lw8[ai][m] = lds_w[rl]; lr8[ai][m] = lds_r[rl]; }
        if (slots) {
#pragma unroll
            for (int ai = 0; ai < 2; ++ai)
#pragma unroll
                for (int m = 0; m < 4; ++m) slot_dst[row0 + ai * HALF + m * 16] = ld8[ai][m]; }
#pragma unroll
        for (int ai = 0; ai < 2; ++ai)
#pragma unroll
            for (int m = 0; m < 4; ++m) { const int row = row0 + ai * HALF + m * 16;
                if (ld8[ai][m] >= 0) { f32x4 v0, v1; const float w = lw8[ai][m], rs = lr8[ai][m];
#pragma unroll
                    for (int j = 0; j < 4; ++j) { const float g0 = acc[ai][0][m][0][j], g1 = acc[ai][0][m][1][j]; v0[j] = w * g0 * sigm(rs * g0) * acc[ai][1][m][0][j]; v1[j] = w * g1 * sigm(rs * g1) * acc[ai][1][m][1][j]; }
                    *(u32x4*)(H + (size_t)row * 256 + col0) = pack8(v0, v1); } }
    }
};
struct EpiDown {
    static constexpr bool PERM = true, AFTER_DRAIN = false, MIDK = false, PROBE2 = false;
    unsigned char* Y; const PG8_LAS int* lds_slot;
    __device__ __forceinline__ static unsigned pk4(float a, float b, float c, float d) { int w = 0; w = __builtin_amdgcn_cvt_pk_fp8_f32(a * 16.f, b * 16.f, w, false); w = __builtin_amdgcn_cvt_pk_fp8_f32(c * 16.f, d * 16.f, w, true); return (unsigned)w; }
    __device__ __forceinline__ void operator()(const f32x4 (&acc)[2][2][4][2], const Unit& u, int wr, int wc, int fr, int fq) const {
        const int row0 = u.pm * BM + wr * 64 + fr, col0 = (u.pn & 3) * 256 + wc * 32 + 8 * fq;
        int dsts[2][4];
#pragma unroll
        for (int ai = 0; ai < 2; ++ai)
#pragma unroll
            for (int m = 0; m < 4; ++m) dsts[ai][m] = lds_slot[u.ord * BM + wr * 64 + fr + ai * HALF + m * 16];
        typedef unsigned u32x2 __attribute__((ext_vector_type(2)));
#pragma unroll
        for (int ai = 0; ai < 2; ++ai)
#pragma unroll
            for (int m = 0; m < 4; ++m) { const int dst = dsts[ai][m];
                if (dst >= 0) {
#pragma unroll
                    for (int bj = 0; bj < 2; ++bj) { const f32x4 v0 = acc[ai][bj][m][0], v1 = acc[ai][bj][m][1]; u32x2 w; w.x = pk4(v0[0], v0[1], v0[2], v0[3]); w.y = pk4(v1[0], v1[1], v1[2], v1[3]);
                        *(u32x2*)(Y + (size_t)dst * 1024 + col0 + bj * HALF) = w; } } }
    }
};
}

constexpr int NWAVES = 8;
constexpr int D = 1024, NB = 8, SEQ = 8192, M = NB * SEQ, NMETA = 16, MV = M + NMETA;
constexpr int IN_COLS = 4608, RCW = 1792;
constexpr int NE = 32, TT_MAX = 544, CAP = TT_MAX * 256, LCAP = 65536;
constexpr int N_PHASES = 12;
#ifndef MK_ONE_LAUNCH
#define MK_ONE_LAUNCH 1
#endif

constexpr size_t MiB = 1u << 20;
constexpr size_t WS_CTL = 0, CTL_ZERO_BYTES = 96 * 1024;
constexpr size_t WS_RSTD = 1 * MiB, WS_METAP = 1 * MiB + 512 * 1024, WS_SLOTD = 3 * MiB, WS_SLOTW = 4 * MiB;
constexpr size_t WS_WIN = 6 * MiB, WS_WOA = 15 * MiB, WS_WOR = 16 * MiB, WS_WOUT = 17 * MiB, WS_WGU = 19 * MiB, WS_WDN = 51 * MiB;
constexpr size_t WS_LISTD = 68 * MiB, WS_LISTW = 76 * MiB, WS_LISTR = 84 * MiB;
constexpr size_t WS_XB = 96 * MiB, WS_Q = 224 * MiB, WS_K = 288 * MiB, WS_V = 305 * MiB, WS_RC = 352 * MiB, WS_AR = 96 * MiB;
constexpr size_t WS_GB = 224 * MiB, WS_POST = 288 * MiB, WS_MG = 416 * MiB;
constexpr size_t WS_XN2 = 96 * MiB, WS_XG = 224 * MiB, WS_HMID = 496 * MiB, WS_Y = 611 * MiB, WS_END = 1024 * MiB;
static_assert(WS_Y + (size_t)2 * M * D * 2 <= WS_END && WS_HMID + (size_t)CAP * 256 * 2 <= 611 * MiB && WS_RC + (size_t)MV * RCW * 2 <= 611 * MiB, "ws map");
constexpr int CW_BAR = 4096;
constexpr int CW_GCNT = 16384;

constexpr int LDS_BYTES = 163840;
constexpr int LDS_RT = 147456, LDS_TBL = 159744, LDS_MISC = 163328;

#define LAS __attribute__((address_space(3)))
typedef unsigned short bf16;
typedef unsigned v4u __attribute__((ext_vector_type(4)));
typedef unsigned v2u __attribute__((ext_vector_type(2)));
typedef float f32x4 __attribute__((ext_vector_type(4)));
#define DI __device__ __forceinline__
#define LDS_WAIT() asm volatile("s_waitcnt lgkmcnt(0)" ::: "memory")
#define LDS_BARRIER() asm volatile("s_waitcnt lgkmcnt(0)\n\ts_barrier" ::: "memory")
typedef float f32x2_t __attribute__((ext_vector_type(2)));
typedef __bf16 bf16x2_t __attribute__((ext_vector_type(2)));
DI unsigned pk2(float lo, float hi) { const f32x2_t v = {lo, hi}; const bf16x2_t b = __builtin_convertvector(v, bf16x2_t); return __builtin_bit_cast(unsigned, b); }
DI unsigned f2bf(float f) { return pk2(f, 0.f) & 0xffffu; }
DI float bf2f(bf16 b) { return __uint_as_float((unsigned)b << 16); }
DI float xsum32(float v) { const auto r = __builtin_amdgcn_permlane32_swap(__float_as_uint(v), __float_as_uint(v), false, false); return __uint_as_float(r[0]) + __uint_as_float(r[1]); }
DI float xmax32(float v) { const auto r = __builtin_amdgcn_permlane32_swap(__float_as_uint(v), __float_as_uint(v), false, false); return fmaxf(__uint_as_float(r[0]), __uint_as_float(r[1])); }
DI float xsum16(float v) { const auto r = __builtin_amdgcn_permlane16_swap(__float_as_uint(v), __float_as_uint(v), false, false); return __uint_as_float(r[0]) + __uint_as_float(r[1]); }
DI float wave_sum(float v) {
    v += __int_as_float(__builtin_amdgcn_update_dpp(0, __float_as_int(v), 0xB1, 0xF, 0xF, true));
    v += __int_as_float(__builtin_amdgcn_update_dpp(0, __float_as_int(v), 0x4E, 0xF, 0xF, true));
    v += __int_as_float(__builtin_amdgcn_update_dpp(0, __float_as_int(v), 0x141, 0xF, 0xF, true));
    v += __int_as_float(__builtin_amdgcn_update_dpp(0, __float_as_int(v), 0x140, 0xF, 0xF, true));
    return xsum32(xsum16(v));
}
DI float wave_max(float v) {
#pragma unroll
    for (int o = 1; o < 64; o <<= 1) v = fmaxf(v, __shfl_xor(v, o));
    return v;
}
DI float sigmoid_f(float x) { return __builtin_amdgcn_rcpf(1.0f + __builtin_amdgcn_exp2f(-1.44269504089f * x)); }

#define XB_TMO      128
#define XB_XCNT(j)  (256  + 64 * (j))
#define XB_XSUB(j)  (1280 + 64 * (j))
#define XB_XGEN(j)  (2304 + 64 * (j))
#define XB_TOP      3328
#define XB_TOPGEN   3392
#define XCD_BAR_WORDS 3456
#define XB_SPIN_CAP (1u << 20)
DI unsigned xb_ld(unsigned* p)              { return __hip_atomic_load(p, __ATOMIC_RELAXED, __HIP_MEMORY_SCOPE_AGENT); }
DI unsigned xb_add(unsigned* p, unsigned v) { return __hip_atomic_fetch_add(p, v, __ATOMIC_RELAXED, __HIP_MEMORY_SCOPE_AGENT); }
DI unsigned xb_xcc_id() { return (unsigned)__builtin_amdgcn_s_getreg((3 << 11) | 20) & 0xFu; }
#define XB_SPIN(cond, bar) do { unsigned _sp = 0; while (cond) { __builtin_amdgcn_s_sleep(1); \
    if ((++_sp & 255u) == 0u) { if (xb_ld(&(bar)[XB_TMO])) break; if (_sp > XB_SPIN_CAP) { atomicAdd(&(bar)[XB_TMO], 1u); break; } } } } while (0)
struct XcdBarrier { unsigned* bar; unsigned x; volatile LAS unsigned* st; };
DI XcdBarrier xcd_barrier_post(unsigned* bar, volatile LAS unsigned* st) {
    XcdBarrier b; b.bar = bar; b.x = xb_xcc_id(); b.st = st;
    if (threadIdx.x == 0) (void)xb_add(&bar[XB_XCNT(b.x)], 1u);
    return b;
}
DI void xcd_barrier_complete(unsigned* bar, unsigned x, unsigned& nloc, unsigned& nx) {
    const unsigned G = gridDim.x * gridDim.y * gridDim.z;
    unsigned sum, cnt, mine, sp = 0u;
    for (;;) {
        sum = 0u; cnt = 0u; mine = 0u;
#pragma unroll
        for (unsigned j = 0; j < 16; ++j) { const unsigned c = xb_ld(&bar[XB_XCNT(j)]); sum += c; cnt += (c > 0u) ? 1u : 0u; mine = (j == x) ? c : mine; }
        if (sum == G) break;
        __builtin_amdgcn_s_sleep(1);
        if ((++sp & 255u) == 0u) { if (xb_ld(&bar[XB_TMO])) break; if (sp > XB_SPIN_CAP) { atomicAdd(&bar[XB_TMO], 1u); break; } }
    }
    nloc = mine > 0u ? mine : 1u; nx = cnt > 0u ? cnt : 1u;
}
DI void xcd_barrier(const XcdBarrier& b) {
    asm volatile("s_waitcnt vmcnt(0)" ::: "memory");
    __syncthreads();
    if (threadIdx.x == 0) {
        unsigned* bar = b.bar;
        __builtin_amdgcn_s_waitcnt(0);
        unsigned nloc = b.st[0], nx = b.st[1];
        if (nloc == 0u) { xcd_barrier_complete(bar, b.x, nloc, nx); b.st[0] = nloc; b.st[1] = nx; }
        const unsigned old = xb_add(&bar[XB_XSUB(b.x)], 1u);
        const unsigned gen = old / nloc;
        if (old + 1u == (gen + 1u) * nloc) {
            __builtin_amdgcn_fence(__ATOMIC_RELEASE, "agent");
            asm volatile("s_waitcnt vmcnt(0)" ::: "memory");
            const unsigned og = xb_add(&bar[XB_TOP], 1u);
            const unsigned tg = og / nx;
            if (og + 1u == (tg + 1u) * nx) xb_add(&bar[XB_TOPGEN], 1u);
            else XB_SPIN(xb_ld(&bar[XB_TOPGEN]) == tg, bar);
            __builtin_amdgcn_fence(__ATOMIC_ACQUIRE, "agent");
            xb_add(&bar[XB_XGEN(b.x)], 1u);
            asm volatile("s_waitcnt vmcnt(0)" ::: "memory");
        } else {
            XB_SPIN(xb_ld(&bar[XB_XGEN(b.x)]) == gen, bar);
            __builtin_amdgcn_fence(__ATOMIC_ACQUIRE, "agent");
            asm volatile("s_waitcnt vmcnt(0)" ::: "memory");
        }
    }
    __syncthreads();
}

struct Args { const float* in[28]; float* out; unsigned char* ws; int ph_lo, ph_hi, li, pad; };
struct Frame {
    LAS unsigned char* lds;
    unsigned* ctl;
    int tid, lane, wave, G;
    float* out; unsigned char* ws;
};
enum { I_X = 0, I_META, I_NMG, I_WIN, I_MU, I_W0, I_WD, I_A0, I_WA, I_WG, I_KK, I_KA, I_RK, I_LNG, I_LNB, I_SINK, I_WOA, I_WOR, I_WOUT, I_NFG, I_WGRP, I_BGRP, I_WEXP, I_BEXP, I_EG, I_EU, I_ED, I_NFIN };

DI void transpose_item(const float* W, int ldw, int K, bf16* WT, int k0, int n0, int drow0, const float* kscale, float nscale, LAS float* scr, int lane) {
    float wv[32];
#pragma unroll
    for (int i = 0; i < 32; ++i) { const int kk = 2 * i + (lane >> 5); wv[i] = W[(size_t)(k0 + kk) * ldw + n0 + (lane & 31)]; }
#pragma unroll
    for (int i = 0; i < 32; ++i) { const int kk = 2 * i + (lane >> 5); float v = wv[i]; if (kscale) v *= kscale[k0 + kk]; scr[kk * 33 + (lane & 31)] = v * nscale; }
    LDS_WAIT(); asm volatile("" ::: "memory");
    const int c = lane & 7;
#pragma unroll
    for (int j = 0; j < 4; ++j) { const int n = (lane >> 3) + 8 * j; const LAS float* s = scr + (8 * c) * 33 + n;
        v4u o; o.x = pk2(s[0 * 33], s[1 * 33]); o.y = pk2(s[2 * 33], s[3 * 33]); o.z = pk2(s[4 * 33], s[5 * 33]); o.w = pk2(s[6 * 33], s[7 * 33]);
        *(v4u*)(WT + (size_t)(drow0 + n) * K + k0 + 8 * c) = o; }
    LDS_WAIT(); asm volatile("" ::: "memory");
}
DI void expert_weights(Frame& F, const Args& A, int wg0) {
    if ((int)blockIdx.x < wg0) return;
    LAS float* scr = (LAS float*)(F.lds + F.wave * 16384);
    unsigned char* ws = F.ws;
    constexpr int I_G = 32 * 16 * 8, I_U = I_G, I_DN = 32 * 4 * 32;
    const int gw = ((int)blockIdx.x - wg0) * NWAVES + F.wave, NGW = (F.G - wg0) * NWAVES;
    for (int it = gw; it < I_G + I_U + I_DN; it += NGW) {
        int r = it;
        if (r < I_G + I_U) { const int up = r >= I_G; if (up) r -= I_G; const int e = r / 128, q = r % 128, kb = q / 8, nb = q % 8, n0 = 32 * nb;
            transpose_item(A.in[up ? I_EU : I_EG] + (size_t)e * 1024 * 256, 256, 1024, (bf16*)(ws + WS_WGU), 64 * kb, n0, e * 512 + (n0 >> 7) * 256 + up * 128 + (n0 & 127), A.in[I_NFG], 1.0f, scr, F.lane); continue; } r -= I_G + I_U;
        { const int e = r / 128, q = r % 128, kb = q / 32, nb = q % 32; transpose_item(A.in[I_ED] + (size_t)e * 256 * 1024, 1024, 256, (bf16*)(ws + WS_WDN), 64 * kb, 32 * nb, e * 1024 + 32 * nb, nullptr, 1.0f, scr, F.lane); }
    }
}
DI void p0_prologue(Frame& F, const Args& A) {
    LAS float* scr = (LAS float*)(F.lds + F.wave * 16384);
    const int gw = blockIdx.x * NWAVES + F.wave, NGW = F.G * NWAVES;
    unsigned char* ws = F.ws;
    constexpr int I_IN = 16 * 144, I_OA = 8 * 32, I_OR = 8 * 32, I_OUT = 16 * 32, I_LD = 16, I_LA = 16, I_LG = 32;
    constexpr int NITEMS = I_IN + I_OA + I_OR + I_OUT + I_LD + I_LA + I_LG;
    for (int it = gw; it < NITEMS; it += NGW) {
        int r = it;
        if (r < I_IN) { const int kb = r / 144, nb = r % 144, n0 = 32 * nb; int dr = n0;
            if (n0 >= 2560) { const int ng = n0 - 2560, which = ng >> 10, c = ng & 1023; dr = 2560 + (c >> 7) * 256 + which * 128 + (c & 127); }
            transpose_item(A.in[I_WIN], IN_COLS, 1024, (bf16*)(ws + WS_WIN), 64 * kb, n0, dr, A.in[I_NMG], nb < 16 ? 0.125f : 1.0f, scr, F.lane); continue; } r -= I_IN;
        if (r < I_OA) { const int kb = r / 32, nb = r % 32; transpose_item(A.in[I_WOA], 1024, 1024, (bf16*)(ws + WS_WOA), 64 * kb, 32 * nb, 32 * nb, nullptr, 1.0f, scr, F.lane); continue; } r -= I_OA;
        if (r < I_OR) { const int kb = r / 32, nb = r % 32; transpose_item(A.in[I_WOR], 1024, 1024, (bf16*)(ws + WS_WOA) + 512, 64 * kb, 32 * nb, 32 * nb, nullptr, 1.0f, scr, F.lane); continue; } r -= I_OR;
        if (r < I_OUT) { const int kb = r / 32, nb = r % 32; transpose_item(A.in[I_WOUT], 1024, 1024, (bf16*)(ws + WS_WOUT), 64 * kb, 32 * nb, 32 * nb, nullptr, 1.0f, scr, F.lane); continue; } r -= I_OUT;
        if (r < I_LD) { transpose_item(A.in[I_WD], 512, 64, (bf16*)(ws + 5 * MiB), 0, 32 * r, 32 * r, nullptr, 1.0f, scr, F.lane); continue; } r -= I_LD;
        if (r < I_LA) { transpose_item(A.in[I_WA], 512, 64, (bf16*)(ws + 5 * MiB) + 512 * 64, 0, 32 * r, 32 * r, nullptr, 1.0f, scr, F.lane); continue; } r -= I_LA;
        { const int kb = r / 16, nb = r % 16; transpose_item(A.in[I_WG], 512, 128, (bf16*)(ws + 5 * MiB) + 2 * 512 * 64, 64 * kb, 32 * nb, 32 * nb, nullptr, 1.0f, scr, F.lane); }
    }
    {
        bf16* XB = (bf16*)(ws + WS_XB);
        for (int m0 = gw; m0 < M; m0 += 4 * NGW) {
            f32x4 v[4][4];
#pragma unroll
            for (int q = 0; q < 4; ++q) { const int m = m0 + q * NGW < M ? m0 + q * NGW : m0; const f32x4* xr = (const f32x4*)(A.in[I_X] + (size_t)m * D) + F.lane;
#pragma unroll
                for (int j = 0; j < 4; ++j) v[q][j] = xr[64 * j]; }
#pragma unroll
            for (int q = 0; q < 4; ++q) { const int m = m0 + q * NGW; if (m < M) { float s = 0.f;
#pragma unroll
                for (int j = 0; j < 4; ++j) s += (v[q][j].x * v[q][j].x + v[q][j].y * v[q][j].y) + (v[q][j].z * v[q][j].z + v[q][j].w * v[q][j].w);
                const float rs = 1.0f / sqrtf(wave_sum(s) * (1.0f / D) + 1e-6f);
                v2u* o8 = (v2u*)(XB + (size_t)m * D) + F.lane;
#pragma unroll
                for (int j = 0; j < 4; ++j) { v2u o; o.x = pk2(v[q][j].x * rs, v[q][j].y * rs); o.y = pk2(v[q][j].z * rs, v[q][j].w * rs); o8[64 * j] = o; } } }
        }
    }
    __syncthreads();
    {
        LAS float* xnm = (LAS float*)F.lds;
        LAS float* red = (LAS float*)(F.lds + 65536);
        bool have = false;
        for (int it = blockIdx.x; it < 256; it += F.G) {
            if (!have) {
                for (int rr = 0; rr < 2; ++rr) { const int row = 2 * F.wave + rr; const f32x4* xr = (const f32x4*)(A.in[I_META] + row * D) + F.lane; const f32x4* gr = (const f32x4*)(A.in[I_NMG]) + F.lane;
                    f32x4 v[4]; float s = 0.f;
#pragma unroll
                    for (int j = 0; j < 4; ++j) { v[j] = xr[64 * j]; s += (v[j].x * v[j].x + v[j].y * v[j].y) + (v[j].z * v[j].z + v[j].w * v[j].w); }
                    const float rs = 1.0f / sqrtf(wave_sum(s) * (1.0f / D) + 1e-6f);
#pragma unroll
                    for (int j = 0; j < 4; ++j) { const f32x4 g = gr[64 * j]; *(LAS f32x4*)(xnm + row * D + 256 * j + 4 * F.lane) = v[j] * rs * g; } }
                __syncthreads(); have = true;
            }
            const int cg = it >> 3, ks = it & 7, col = 512 + cg * 64 + F.lane, kbase = ks * 128 + F.wave * 16;
            float acc[16];
#pragma unroll
            for (int r = 0; r < 16; ++r) acc[r] = 0.f;
#pragma unroll 4
            for (int k = 0; k < 16; ++k) { const float w = A.in[I_WIN][(size_t)(kbase + k) * IN_COLS + col];
#pragma unroll
                for (int r = 0; r < 16; ++r) acc[r] += xnm[r * D + kbase + k] * w; }
#pragma unroll
            for (int r = 0; r < 16; ++r) red[(F.wave * 16 + r) * 64 + F.lane] = acc[r];
            __syncthreads();
            float* MP = (float*)(ws + WS_METAP);
            for (int e = F.tid; e < 16 * 64; e += NWAVES * 64) { const int r = e >> 6, c = e & 63; float s = 0.f;
#pragma unroll
                for (int w = 0; w < 8; ++w) s += red[(w * 16 + r) * 64 + c];
                MP[(size_t)(ks * 16 + r) * 2048 + cg * 64 + c] = s; }
            __syncthreads();
        }
    }
}
DI void p1_meta_finish(Frame& F, const Args& A) {
    const float* MP = (const float*)(F.ws + WS_METAP);
    bf16* Kb = (bf16*)(F.ws + WS_K); bf16* Vb = (bf16*)(F.ws + WS_V); bf16* RC = (bf16*)(F.ws + WS_RC);
    for (int e = blockIdx.x * 512 + F.tid; e < 16 * 2048; e += F.G * 512) { const int r = e >> 11, c = e & 2047; float s = 0.f;
#pragma unroll
        for (int k = 0; k < 8; ++k) s += MP[(size_t)(k * 16 + r) * 2048 + c];
        const bf16 v = (bf16)f2bf(s);
        if (c < 128) Kb[(size_t)(M + r) * 128 + c] = v; else if (c < 256) Vb[(size_t)(M + r) * 128 + c - 128] = v; else RC[(size_t)(M + r) * RCW + c - 256] = v; }
}

DI int moe_table(Frame& F) {
    LAS int* tile_e = (LAS int*)(F.lds + LDS_TBL); LAS int* tb = tile_e + TT_MAX;
    if (F.wave == 0) {
        const int e = F.lane & 31; const int c = (int)__hip_atomic_load(F.ctl + CW_GCNT + 64 * e, __ATOMIC_RELAXED, __HIP_MEMORY_SCOPE_AGENT); const int nt = (c + 255) >> 8;
        int incl = nt;
#pragma unroll
        for (int d = 1; d < 32; d <<= 1) { const int y = __shfl_up(incl, d); if ((F.lane & 31) >= d) incl += y; }
        const int first = incl - nt;
        if (F.lane < 32) { tb[e] = first; tb[33 + e] = c; for (int t = 0; t < nt; ++t) tile_e[first + t] = e; if (e == 31) { tb[32] = incl; tb[65] = incl; } }
    }
    __syncthreads();
    return tb[65];
}
DI void p12_final(Frame& F, const Args& A) {
    const unsigned char* Y = (const unsigned char*)(F.ws + WS_Y); const bf16* H1 = (const bf16*)(F.ws + WS_AR);
    const int gw = blockIdx.x * NWAVES + F.wave, NGW = F.G * NWAVES, lane = F.lane;
    f32x4 gf[4];
#pragma unroll
    for (int j = 0; j < 4; ++j) gf[j] = ((const f32x4*)A.in[I_NFIN])[64 * j + lane];
    for (int m0 = gw; m0 < M; m0 += 2 * NGW) {
        v2u xh[2][4]; unsigned ya[2][4], yb[2][4];
#pragma unroll
        for (int q = 0; q < 2; ++q) { const int m = m0 + q * NGW < M ? m0 + q * NGW : m0; const v2u* hr = (const v2u*)(H1 + (size_t)m * D) + lane; const unsigned* y0 = (const unsigned*)(Y + (size_t)(2 * m) * D) + lane; const unsigned* y1 = (const unsigned*)(Y + (size_t)(2 * m + 1) * D) + lane;
#pragma unroll
            for (int j = 0; j < 4; ++j) { xh[q][j] = hr[64 * j]; ya[q][j] = y0[64 * j]; yb[q][j] = y1[64 * j]; } }
#pragma unroll
        for (int q = 0; q < 2; ++q) { const int m = m0 + q * NGW; if (m < M) { float s = 0.f; f32x4 v[4];
#pragma unroll
            for (int j = 0; j < 4; ++j) { const v2u h = xh[q][j]; const int a = (int)ya[q][j], c = (int)yb[q][j];
                v[j].x = __uint_as_float(h.x << 16) + 0.0625f * (__builtin_amdgcn_cvt_f32_fp8(a, 0) + __builtin_amdgcn_cvt_f32_fp8(c, 0)); v[j].y = __uint_as_float(h.x & 0xffff0000u) + 0.0625f * (__builtin_amdgcn_cvt_f32_fp8(a, 1) + __builtin_amdgcn_cvt_f32_fp8(c, 1));
                v[j].z = __uint_as_float(h.y << 16) + 0.0625f * (__builtin_amdgcn_cvt_f32_fp8(a, 2) + __builtin_amdgcn_cvt_f32_fp8(c, 2)); v[j].w = __uint_as_float(h.y & 0xffff0000u) + 0.0625f * (__builtin_amdgcn_cvt_f32_fp8(a, 3) + __builtin_amdgcn_cvt_f32_fp8(c, 3));
                s += (v[j].x * v[j].x + v[j].y * v[j].y) + (v[j].z * v[j].z + v[j].w * v[j].w); }
            const float rs = 1.0f / sqrtf(wave_sum(s) * (1.0f / D) + 1e-6f);
            f32x4* ho = (f32x4*)(F.out + (size_t)m * D) + lane;
#pragma unroll
            for (int j = 0; j < 4; ++j) ho[64 * j] = v[j] * rs * gf[j]; } }
    }
}

typedef short bf16x8 __attribute__((ext_vector_type(8)));
typedef float f32x16 __attribute__((ext_vector_type(16)));
#define MFMA32(a, b, c) __builtin_amdgcn_mfma_f32_32x32x16_bf16((a), (b), (c), 0, 0, 0)
constexpr int LDB = 72;
constexpr int LDF = 68;
constexpr int NCH = SEQ / 64, NITEM = NB * 8 * NCH, NITEM_ALL = NITEM + 8;
constexpr size_t CH_STRIDE = 65 * MiB;
constexpr size_t WS_CH = 611 * MiB;
constexpr size_t WS_LORA = 5 * MiB;
static_assert(WS_CH + 5 * CH_STRIDE <= WS_END && (size_t)NITEM_ALL * 8192 <= CH_STRIDE, "chunk map");

template <int KK> DI void mma_lds(f32x16& acc, const LAS bf16* Y, int ldy, int n0, const LAS bf16* X, int ldx, int m0, int lane) {
    const int r = lane & 31, hh = lane >> 5;
    const LAS bf16* yp = Y + (n0 + r) * ldy + 8 * hh; const LAS bf16* xp = X + (m0 + r) * ldx + 8 * hh;
#pragma unroll
    for (int k0 = 0; k0 < KK; k0 += 16) { const bf16x8 a = *(const LAS bf16x8*)(xp + k0), b = *(const LAS bf16x8*)(yp + k0); acc = MFMA32(a, b, acc); }
}
DI bf16x8 col_frag(const LAS bf16* Mx, int ld, int row0, int col) {
    const LAS bf16* p = Mx + row0 * ld + col; v4u t4;
#pragma unroll
    for (int i = 0; i < 4; ++i) t4[i] = (unsigned)p[(2 * i) * ld] | ((unsigned)p[(2 * i + 1) * ld] << 16);
    return __builtin_bit_cast(bf16x8, t4);
}
template <int KK, bool YT, bool XT> DI void mma_lds_t(f32x16& acc, const LAS bf16* Y, int ldy, int n0, const LAS bf16* X, int ldx, int m0, int lane) {
    const int r = lane & 31, hh = lane >> 5;
#pragma unroll
    for (int k0 = 0; k0 < KK; k0 += 16) {
        const bf16x8 a = XT ? col_frag(X, ldx, k0 + 8 * hh, m0 + r) : *(const LAS bf16x8*)(X + (m0 + r) * ldx + 8 * hh + k0);
        const bf16x8 b = YT ? col_frag(Y, ldy, k0 + 8 * hh, n0 + r) : *(const LAS bf16x8*)(Y + (n0 + r) * ldy + 8 * hh + k0);
        acc = MFMA32(a, b, acc); }
}
DI void add_tile_lds_t(f32x16& acc, const LAS bf16* Rm, int ld, int n0, int m0, int lane) {
    const int r = lane & 31, hh = lane >> 5;
#pragma unroll
    for (int i = 0; i < 16; ++i) acc[i] += __uint_as_float((unsigned)Rm[(m0 + 8 * (i >> 2) + 4 * hh + (i & 3)) * ld + n0 + r] << 16);
}
DI f32x16 zero16() { f32x16 z;
#pragma unroll
    for (int i = 0; i < 16; ++i) z[i] = 0.f; return z; }
DI void st_tile_lds(LAS bf16* Dm, int ld, int n0, int m0, const f32x16& acc, int lane) {
    const int r = lane & 31, hh = lane >> 5;
#pragma unroll
    for (int g = 0; g < 4; ++g) { v2u o; o.x = pk2(acc[4 * g], acc[4 * g + 1]); o.y = pk2(acc[4 * g + 2], acc[4 * g + 3]); *(LAS v2u*)(Dm + (n0 + r) * ld + m0 + 8 * g + 4 * hh) = o; }
}
DI void st_tile_glb(bf16* Dm, int ld, int n0, int m0, const f32x16& acc, int lane) {
    const int r = lane & 31, hh = lane >> 5;
#pragma unroll
    for (int g = 0; g < 4; ++g) { v2u o; o.x = pk2(acc[4 * g], acc[4 * g + 1]); o.y = pk2(acc[4 * g + 2], acc[4 * g + 3]); *(v2u*)(Dm + (size_t)(n0 + r) * ld + m0 + 8 * g + 4 * hh) = o; }
}
DI void st_tile_glb_frag(bf16* Dm, int n0, int m0, const f32x16& acc, int lane) {
    const int r = lane & 31, hh = lane >> 5;
#pragma unroll
    for (int g = 0; g < 4; ++g) { v2u o; o.x = pk2(acc[4 * g], acc[4 * g + 1]); o.y = pk2(acc[4 * g + 2], acc[4 * g + 3]);
        *(v2u*)(Dm + ((n0 >> 5) * 4 + (m0 >> 4) + (g >> 1)) * 512 + ((g & 1) * 32 + r) * 8 + 4 * hh) = o; }
}
DI void st_tile_glb_cl(bf16* Dm, int n0, int m0, const f32x16& acc, int lane) {
#pragma unroll
    for (int g = 0; g < 4; ++g) { v2u o; o.x = pk2(acc[4 * g], acc[4 * g + 1]); o.y = pk2(acc[4 * g + 2], acc[4 * g + 3]); *(v2u*)(Dm + ((n0 >> 5) * 2 + (m0 >> 5)) * 1024 + g * 256 + lane * 4) = o; }
}
DI void add_tile_lds(f32x16& acc, const LAS bf16* R, int ld, int n0, int m0, int lane) {
    const int r = lane & 31, hh = lane >> 5;
#pragma unroll
    for (int g = 0; g < 4; ++g) { const v2u w = *(const LAS v2u*)(R + (n0 + r) * ld + m0 + 8 * g + 4 * hh);
        acc[4 * g] += __uint_as_float(w.x << 16); acc[4 * g + 1] += __uint_as_float(w.x & 0xffff0000u); acc[4 * g + 2] += __uint_as_float(w.y << 16); acc[4 * g + 3] += __uint_as_float(w.y & 0xffff0000u); }
}
DI void up8(const v4u w, float* f) {
#pragma unroll
    for (int i = 0; i < 4; ++i) { f[2 * i] = __uint_as_float(w[i] << 16); f[2 * i + 1] = __uint_as_float(w[i] & 0xffff0000u); }
}
DI v4u pk8(const float* f) { v4u o; o.x = pk2(f[0], f[1]); o.y = pk2(f[2], f[3]); o.z = pk2(f[4], f[5]); o.w = pk2(f[6], f[7]); return o; }


constexpr size_t WS_XA = 936 * MiB;
DI int prev_row_of(int vt) { if (vt < M) return (vt % SEQ) > 0 ? vt - 1 : M + 15; return vt > M ? vt - 1 : -1; }
DI void p2a_lora_inputs(Frame& F, const Args& A) {
    const bf16* RC = (const bf16*)(F.ws + WS_RC); const float* mu = A.in[I_MU]; bf16* XA = (bf16*)(F.ws + WS_XA);
    const int stride = F.G * NWAVES * 64;
    for (int e0 = blockIdx.x * (NWAVES * 64) + F.tid; e0 < MV * 32; e0 += 4 * stride) {
        v4u cur[4], prv[4]; bool hp[4];
#pragma unroll
        for (int u = 0; u < 4; ++u) { const int e = e0 + u * stride < MV * 32 ? e0 + u * stride : e0; const int vt = e >> 5, col = 1536 + (e & 31) * 8, prow = prev_row_of(vt);
            hp[u] = prow >= 0; cur[u] = *(const v4u*)(RC + (size_t)vt * RCW + col); prv[u] = *(const v4u*)(RC + (size_t)(prow >= 0 ? prow : vt) * RCW + col); }
#pragma unroll
        for (int u = 0; u < 4; ++u) { const int e = e0 + u * stride; if (e < MV * 32) { const int vt = e >> 5, cg = e & 31, cl = cg * 8, col = 1536 + cl;
            float cu[8], pv[8], o[8]; up8(cur[u], cu); up8(prv[u], pv);
            if (!hp[u]) {
#pragma unroll
                for (int i = 0; i < 8; ++i) pv[i] = 0.f; }
            const f32x4 m0 = *(const f32x4*)(mu + col), m1 = *(const f32x4*)(mu + col + 4);
#pragma unroll
            for (int i = 0; i < 8; ++i) { const float mm = i < 4 ? m0[i] : m1[i - 4]; const float v = cu[i] + mm * (pv[i] - cu[i]);
                const float ex = __expf(-2.0f * fabsf(v)), th = copysignf((1.0f - ex) * __builtin_amdgcn_rcpf(1.0f + ex), v);
                o[i] = cg < 8 ? th : (cg < 16 ? v : sigmoid_f(v)); }
            *(v4u*)(XA + (size_t)vt * 256 + cl) = pk8(o); } }
    }
}

DI float sum8_dpp(float v) {
    v += __int_as_float(__builtin_amdgcn_update_dpp(0, __float_as_int(v), 0xB1, 0xF, 0xF, true));
    v += __int_as_float(__builtin_amdgcn_update_dpp(0, __float_as_int(v), 0x4E, 0xF, 0xF, true));
    v += __int_as_float(__builtin_amdgcn_update_dpp(0, __float_as_int(v), 0x141, 0xF, 0xF, true));
    return v;
}
constexpr int L_AT = 0, L_ATT = 9216, L_RT = 18432, L_BT = 27648, L_BTT = 36864, L_KT = 46080, L_KTT = 55296, L_VT = 64512;
constexpr int L_AF = 73728, L_AP = 91136, L_AAK = 100352, L_ABR = 109568, L_AKR = 118784, L_TP = 128000, L_D1T = 137216, L_XT = 142336, L_PC = 146432;
constexpr int L_W1 = L_AF, L_AKT = L_AF + 9216, L_GT = L_AT, L_NKT = L_ATT;
constexpr int L_XL = 73728, L_LW = 73728, L_SEG = 91136, L_WL = 107520, L_AL = 124928;
constexpr int LDX = 264;

constexpr int L_WLN = 146688, L_ALN = L_WLN + 8192, L_TOT = L_LW;
struct ChunkItem { int h, row0, nvalid, prow0; bool meta; size_t oidx; };
DI ChunkItem chunk_item(int it, int npairs, int G) {
    ChunkItem I; I.meta = it >= npairs * 8;
    const int pair = I.meta ? 0 : (int)blockIdx.x + (it >> 3) * G; I.h = I.meta ? (int)blockIdx.x : (it & 7);
    const int b = I.meta ? 0 : pair / NCH, c = I.meta ? 0 : pair % NCH;
    I.row0 = I.meta ? M : b * SEQ + 64 * c; I.nvalid = I.meta ? 16 : 64; I.prow0 = I.meta ? -1 : (c > 0 ? I.row0 - 1 : M + 15);
    I.oidx = I.meta ? (size_t)(NITEM + I.h) : (size_t)((b * 8 + I.h) * NCH + c);
    return I;
}
DI void lora_tile(LAS unsigned char* L, const ChunkItem& I, int kind, int tq, const bf16* XA, const bf16* WdT, const bf16* WaT, const bf16* WgT, bf16* GB, int lane) {
    const int r32 = lane & 31, hh = lane >> 5, n0 = 32 * (tq >> 1), m0 = 32 * (tq & 1);
    const int tvx = (n0 + r32) < I.nvalid ? (n0 + r32) : I.nvalid - 1; const bf16* XLr = XA + (size_t)(I.row0 + tvx) * 256 + 8 * hh;
    f32x16 acc = zero16();
    if (kind < 2) { const bf16* Wt = (kind ? WaT : WdT) + (size_t)(I.h * 64 + m0 + r32) * 64 + 8 * hh;
#pragma unroll
        for (int k0 = 0; k0 < 64; k0 += 16) { const bf16x8 a = *(const bf16x8*)(Wt + k0), bb = *(const bf16x8*)(XLr + kind * 64 + k0); acc = MFMA32(a, bb, acc); }
        st_tile_lds((LAS bf16*)(L + (kind ? L_ALN : L_WLN)), 64, n0, m0, acc, lane);
    } else { const bf16* Wt = WgT + (size_t)(I.h * 64 + m0 + r32) * 128 + 8 * hh;
#pragma unroll
        for (int k0 = 0; k0 < 128; k0 += 16) { const bf16x8 a = *(const bf16x8*)(Wt + k0), bb = *(const bf16x8*)(XLr + 128 + k0); acc = MFMA32(a, bb, acc); }
        if (!I.meta) st_tile_glb_cl(GB + I.oidx * 4096, n0, m0, acc, lane); }
}
DI void stage1_tile(LAS unsigned char* L, int p, int n0, int m0, int lane) {
    const int r32 = lane & 31, hh = lane >> 5, n = n0 + r32;
    const LAS bf16* Y = (const LAS bf16*)(L + (p == 0 ? L_AT : p == 1 ? L_KT : L_RT));
    const LAS bf16* X = (const LAS bf16*)(L + (p == 0 ? L_BT : p == 1 ? L_AT : p == 2 ? L_BT : L_KT));
    f32x16 acc = zero16(); mma_lds<64>(acc, Y, LDB, n0, X, LDB, m0, lane);
#pragma unroll
    for (int i = 0; i < 16; ++i) { const int m = m0 + 8 * (i >> 2) + 4 * hh + (i & 3); const bool keep = p == 0 ? (m < n) : p == 1 ? (n < m) : (m <= n); if (!keep) acc[i] = 0.f; }
    if (p == 0) { LAS float* AFm = (LAS float*)(L + L_AF);
#pragma unroll
        for (int g = 0; g < 4; ++g) *(LAS f32x4*)(AFm + n * LDF + m0 + 8 * g + 4 * hh) = (f32x4){acc[4 * g], acc[4 * g + 1], acc[4 * g + 2], acc[4 * g + 3]};
        st_tile_lds((LAS bf16*)(L + L_AP), LDB, n0, m0, acc, lane); }
    else st_tile_lds((LAS bf16*)(L + (p == 1 ? L_AAK : p == 2 ? L_ABR : L_AKR)), LDB, n0, m0, acc, lane);
}
#ifndef P3I_REPS
#define P3I_REPS 1
#endif
DI void p3_rwkv_chunk(Frame& F, const Args& A) {
    LAS unsigned char* L = F.lds;
    const bf16* RC = (const bf16*)(F.ws + WS_RC); const float* mu = A.in[I_MU];
    bf16* GB = (bf16*)(F.ws + WS_GB); bf16* PO = (bf16*)(F.ws + WS_POST);
    const bf16* WdT = (const bf16*)(F.ws + WS_LORA); const bf16* WaT = WdT + 512 * 64; const bf16* WgT = WaT + 512 * 64;
    bf16* W2T = (bf16*)(F.ws + WS_CH); bf16* MTg = (bf16*)(F.ws + WS_CH + CH_STRIDE); bf16* YLT = (bf16*)(F.ws + WS_CH + 2 * CH_STRIDE); bf16* NBg = (bf16*)(F.ws + WS_CH + 3 * CH_STRIDE);
    const int tid = F.tid, lane = F.lane, w = F.wave, r32 = lane & 31, hh = lane >> 5;
    const bf16* XA = (const bf16*)(F.ws + WS_XA);
    const int npairs = (NB * NCH - (int)blockIdx.x + F.G - 1) / F.G, nmine = npairs * 8 + (blockIdx.x < 8 ? 1 : 0);
    if (nmine == 0) return;
    { LAS float* P1 = (LAS float*)(L + L_BTT); LAS float* P2 = (LAS float*)(L + L_KTT); const int i = tid;
        P1[i] = A.in[I_W0][i]; P1[512 + i] = A.in[I_A0][i]; P1[1024 + i] = A.in[I_KK][i]; P1[1536 + i] = A.in[I_KA][i]; ((LAS bf16*)(P1 + 2048))[i] = (bf16)f2bf(A.in[I_RK][i]);
        P2[i] = mu[i]; P2[512 + i] = mu[512 + i]; P2[1024 + i] = mu[1024 + i]; ((LAS bf16*)(P2 + 1536))[i] = (bf16)f2bf(A.in[I_LNB][i]); }
    const int t = tid >> 3, jg = tid & 7, j0 = 8 * jg;
    v4u rcu[3], rpv[3];
#define P3_REQ_ROWS(I_) do { const int tv_ = t < (I_).nvalid ? t : (I_).nvalid - 1, row_ = (I_).row0 + tv_, prow_ = tv_ > 0 ? row_ - 1 : (I_).prow0, ch_ = (I_).h * 64 + j0; \
        _Pragma("unroll") for (int which = 0; which < 3; ++which) { rcu[which] = *(const v4u*)(RC + (size_t)row_ * RCW + which * 512 + ch_); rpv[which] = *(const v4u*)(RC + (size_t)(prow_ >= 0 ? prow_ : row_) * RCW + which * 512 + ch_); } } while (0)
    {
        const ChunkItem I0 = chunk_item(0, npairs, F.G);
        P3_REQ_ROWS(I0);
        if (w < 4) { lora_tile(L, I0, 0, w, XA, WdT, WaT, WgT, GB, lane); lora_tile(L, I0, 1, w, XA, WdT, WaT, WgT, GB, lane); } else lora_tile(L, I0, 2, w - 4, XA, WdT, WaT, WgT, GB, lane);
    }
    LDS_BARRIER();
    for (int it = 0; it < nmine; ++it) {
        const ChunkItem I = chunk_item(it, npairs, F.G);
        const bool has_next = it + 1 < nmine; const ChunkItem IN = chunk_item(has_next ? it + 1 : it, npairs, F.G);
        const int h = I.h, row0 = I.row0, nvalid = I.nvalid, prow0 = I.prow0; const bool meta = I.meta; const size_t oidx = I.oidx;
        const int ch = h * 64 + j0;
        float rr[8], kp[8], vv[8], lw[8], aa[8], bb8[8], cum[8];
        {
            const bool valid = t < nvalid; const int tv = valid ? t : nvalid - 1;
            const int row = row0 + tv, prow = tv > 0 ? row - 1 : prow0;
            float cu[8], pv[8], kr[8];
#pragma unroll
            for (int which = 0; which < 3; ++which) { const int col = which * 512 + ch;
                up8(rcu[which], cu); up8(rpv[which], pv);
                if (prow < 0) {
#pragma unroll
                    for (int e = 0; e < 8; ++e) pv[e] = 0.f; }
                const f32x4 m0 = *(const LAS f32x4*)(L + L_KTT + (which * 512 + ch) * 4), m1 = *(const LAS f32x4*)(L + L_KTT + (which * 512 + ch + 4) * 4);
#pragma unroll
                for (int e = 0; e < 8; ++e) { const float mm = e < 4 ? m0[e] : m1[e - 4]; const float v = cu[e] + mm * (pv[e] - cu[e]); if (which == 0) rr[e] = v; else if (which == 1) kr[e] = v; else vv[e] = v; } }
            float wl8[8], al8[8]; up8(*(const LAS v4u*)(L + L_WLN + (t * 64 + j0) * 2), wl8); up8(*(const LAS v4u*)(L + L_ALN + (t * 64 + j0) * 2), al8);
            float s1 = 0.f, asg[8], pw0[8], pa0[8], pkk[8], pka[8], prk[8], plb[8];
#pragma unroll
            for (int q = 0; q < 2; ++q) { const LAS float* P1 = (const LAS float*)(L + L_BTT) + ch + 4 * q; const f32x4 v0 = *(const LAS f32x4*)P1, v1 = *(const LAS f32x4*)(P1 + 512), v2 = *(const LAS f32x4*)(P1 + 1024), v3 = *(const LAS f32x4*)(P1 + 1536);
#pragma unroll
                for (int i = 0; i < 4; ++i) { pw0[4 * q + i] = v0[i]; pa0[4 * q + i] = v1[i]; pkk[4 * q + i] = v2[i]; pka[4 * q + i] = v3[i]; } }
            up8(*(const LAS v4u*)(L + L_BTT + 8192 + ch * 2), prk); up8(*(const LAS v4u*)(L + L_KTT + 6144 + ch * 2), plb);
#pragma unroll
            for (int e = 0; e < 8; ++e) { lw[e] = -0.60653065971f * sigmoid_f(pw0[e] + wl8[e]);
                asg[e] = sigmoid_f(pa0[e] + al8[e]); aa[e] = kr[e] * pkk[e]; s1 += aa[e] * aa[e];
                kp[e] = kr[e] * (1.0f + (asg[e] - 1.0f) * pka[e]); }
            s1 = sum8_dpp(s1);
            const float inv = __builtin_amdgcn_rcpf(fmaxf(__builtin_amdgcn_sqrtf(s1), 1e-12f));
            float s2 = 0.f;
#pragma unroll
            for (int e = 0; e < 8; ++e) { const float kkv = aa[e] * inv; aa[e] = -kkv; bb8[e] = kkv * asg[e]; s2 += rr[e] * kp[e] * prk[e]; }
            s2 = sum8_dpp(s2);
            if (!meta) { float po[8];
#pragma unroll
                for (int e = 0; e < 8; ++e) po[e] = plb[e] + s2 * vv[e];
                const v4u pp = pk8(po); bf16* pd = PO + oidx * 4096 + ((t >> 5) * 2 + (jg >> 2)) * 1024 + (jg & 3) * 256 + (t & 31) * 4;
                v2u lo; lo.x = pp.x; lo.y = pp.y; v2u hi; hi.x = pp.z; hi.y = pp.w; *(v2u*)pd = lo; *(v2u*)(pd + 128) = hi; }
            if (!valid) {
#pragma unroll
                for (int e = 0; e < 8; ++e) { rr[e] = 0.f; kp[e] = 0.f; vv[e] = 0.f; lw[e] = 0.f; aa[e] = 0.f; bb8[e] = 0.f; } }
#pragma unroll
            for (int e = 0; e < 8; ++e) { float x = lw[e];
#pragma unroll
                for (int dlt = 8; dlt < 64; dlt <<= 1) { const float y = __shfl_up(x, dlt); if (lane >= dlt) x += y; }
                cum[e] = x; }
            if ((lane >> 3) == 7) { LAS float* TOT = (LAS float*)(L + L_TOT) + w * 64 + j0; *(LAS f32x4*)TOT = (f32x4){cum[0], cum[1], cum[2], cum[3]}; *(LAS f32x4*)(TOT + 4) = (f32x4){cum[4], cum[5], cum[6], cum[7]}; }
        }
        LDS_BARRIER();
        {
            const LAS float* TOT = (const LAS float*)(L + L_TOT) + j0;
            for (int q = 0; q < w; ++q) { const f32x4 a4 = *(const LAS f32x4*)(TOT + q * 64), b4 = *(const LAS f32x4*)(TOT + q * 64 + 4);
                cum[0] += a4.x; cum[1] += a4.y; cum[2] += a4.z; cum[3] += a4.w; cum[4] += b4.x; cum[5] += b4.y; cum[6] += b4.z; cum[7] += b4.w; }
            float at[8], rt[8], bt[8], kt[8];
#pragma unroll
            for (int e = 0; e < 8; ++e) { const float p = __builtin_amdgcn_exp2f(1.44269504089f * cum[e]), pprev = __builtin_amdgcn_exp2f(1.44269504089f * (cum[e] - lw[e])), pinv = __builtin_amdgcn_rcpf(p);
                at[e] = aa[e] * pprev; rt[e] = rr[e] * p; bt[e] = bb8[e] * pinv; kt[e] = kp[e] * pinv;
                if (t == 63) ((LAS float*)(L + L_PC))[j0 + e] = p; }
            *(LAS v4u*)(L + L_RT + (t * LDB + j0) * 2) = pk8(rt);
            const v4u pat = pk8(at), pbt = pk8(bt), pkt = pk8(kt), pvt = pk8(vv);
            *(LAS v4u*)(L + L_AT + (t * LDB + j0) * 2) = pat; *(LAS v4u*)(L + L_BT + (t * LDB + j0) * 2) = pbt; *(LAS v4u*)(L + L_KT + (t * LDB + j0) * 2) = pkt;
            *(LAS v4u*)(L + L_VT + (t * LDB + j0) * 2) = pvt;
        }
        LDS_BARRIER();
        stage1_tile(L, w >> 2, 32 * ((w >> 1) & 1), 32 * (w & 1), lane);
        LDS_BARRIER();
        _Pragma("unroll 1") for (int repi_ = 0; repi_ < P3I_REPS; ++repi_)
        if (w == 0) {
            LAS bf16* TP = (LAS bf16*)(L + L_TP); const LAS bf16* AP = (const LAS bf16*)(L + L_AP); LAS bf16* XT1 = (LAS bf16*)(L + L_D1T); LAS bf16* XT2 = (LAS bf16*)(L + L_XT);
            const int d4 = lane >> 4, cc = lane & 15; const LAS float* AFm = (const LAS float*)(L + L_AF) + (16 * d4) * LDF + 16 * d4;
#pragma unroll
            for (int i = 0; i < 9; ++i) *(LAS v4u*)(L + L_TP + (lane + 64 * i) * 16) = (v4u){0u, 0u, 0u, 0u};
            float x[16];
#pragma unroll
            for (int tt = 0; tt < 16; ++tt) x[tt] = 0.f;
            x[0] = cc == 0 ? 1.f : 0.f;
            {
                f32x4 ar[7][2];
#pragma unroll
                for (int tt = 1; tt < 8; ++tt)
#pragma unroll
                    for (int q = 0; q < 2; ++q) if (4 * q < tt) ar[tt - 1][q] = *(const LAS f32x4*)(AFm + tt * LDF + 4 * q);
#pragma unroll
                for (int tt = 1; tt < 8; ++tt) { float acc = (tt == cc) ? 1.f : 0.f;
#pragma unroll
                    for (int q = 0; q < 2; ++q) if (4 * q < tt) acc += (ar[tt - 1][q].x * x[4 * q] + ar[tt - 1][q].y * x[4 * q + 1]) + (ar[tt - 1][q].z * x[4 * q + 2] + ar[tt - 1][q].w * x[4 * q + 3]);
                    x[tt] = acc; }
            }
            {
                f32x4 ar[8][4];
#pragma unroll
                for (int tt = 8; tt < 16; ++tt)
#pragma unroll
                    for (int q = 0; q < 4; ++q) if (4 * q < tt) ar[tt - 8][q] = *(const LAS f32x4*)(AFm + tt * LDF + 4 * q);
#pragma unroll
                for (int tt = 8; tt < 16; ++tt) { float acc = (tt == cc) ? 1.f : 0.f;
#pragma unroll
                    for (int q = 0; q < 4; ++q) if (4 * q < tt) acc += (ar[tt - 8][q].x * x[4 * q] + ar[tt - 8][q].y * x[4 * q + 1]) + (ar[tt - 8][q].z * x[4 * q + 2] + ar[tt - 8][q].w * x[4 * q + 3]);
                    x[tt] = acc; }
            }
#pragma unroll
            for (int tt = 0; tt < 16; ++tt) TP[(16 * d4 + tt) * LDB + 16 * d4 + cc] = (bf16)f2bf(x[tt]);
            LDS_WAIT();
            f32x16 f0 = zero16(), f1 = zero16();
            mma_lds_t<32, true, false>(f0, TP, LDB, 0, AP, LDB, 0, lane); mma_lds_t<32, true, false>(f1, TP + 32 * LDB + 32, LDB, 0, AP + 32 * LDB + 32, LDB, 0, lane);
            st_tile_lds(XT1, 40, 0, 0, f0, lane); st_tile_lds(XT1 + 1280, 40, 0, 0, f1, lane);
            LDS_WAIT();
            f0 = zero16(); f1 = zero16();
            mma_lds<32>(f0, TP, LDB, 0, XT1, 40, 0, lane); mma_lds<32>(f1, TP + 32 * LDB + 32, LDB, 0, XT1 + 1280, 40, 0, lane);
            if (r32 >= 16) {
#pragma unroll
                for (int g = 0; g < 2; ++g) { v2u o0, o1; o0.x = pk2(f0[4 * g], f0[4 * g + 1]); o0.y = pk2(f0[4 * g + 2], f0[4 * g + 3]); o1.x = pk2(f1[4 * g], f1[4 * g + 1]); o1.y = pk2(f1[4 * g + 2], f1[4 * g + 3]);
                    *(LAS v2u*)(TP + r32 * LDB + 8 * g + 4 * hh) = o0; *(LAS v2u*)(TP + (32 + r32) * LDB + 32 + 8 * g + 4 * hh) = o1; } }
            LDS_WAIT();
            {
                f32x16 acc = zero16(); mma_lds_t<32, true, false>(acc, TP, LDB, 0, AP + 32 * LDB, LDB, 0, lane);
                st_tile_lds(XT2, 40, 0, 0, acc, lane);
            }
            LDS_WAIT();
            {
                f32x16 acc = zero16(); mma_lds<32>(acc, TP + 32 * LDB + 32, LDB, 0, XT2, 40, 0, lane);
                st_tile_lds(TP + 32 * LDB, LDB, 0, 0, acc, lane);
            }
        } else {
            if (w <= 4) { const int p = 2 + ((w - 1) >> 1), n0 = 32 * ((w - 1) & 1); stage1_tile(L, p, n0, 0, lane); stage1_tile(L, p, n0, 32, lane); }
            if (has_next) {
                if (w <= 4) { lora_tile(L, IN, 0, w - 1, XA, WdT, WaT, WgT, GB, lane); lora_tile(L, IN, 1, w - 1, XA, WdT, WaT, WgT, GB, lane); }
                else if (w == 5) { lora_tile(L, IN, 2, 0, XA, WdT, WaT, WgT, GB, lane); lora_tile(L, IN, 2, 1, XA, WdT, WaT, WgT, GB, lane); }
                else lora_tile(L, IN, 2, w - 4, XA, WdT, WaT, WgT, GB, lane);
            }
        }
        LDS_BARRIER();
        {
            const int p = w >> 2, n0 = 32 * ((w >> 1) & 1), m0 = 32 * (w & 1);
            f32x16 acc = zero16();
            if (p) mma_lds<64>(acc, (const LAS bf16*)(L + L_AAK), LDB, n0, (const LAS bf16*)(L + L_TP), LDB, m0, lane);
            else mma_lds_t<64, true, false>(acc, (const LAS bf16*)(L + L_AT), LDB, n0, (const LAS bf16*)(L + L_TP), LDB, m0, lane);
            st_tile_lds((LAS bf16*)(L + (p ? L_AKT : L_W1)), LDB, n0, m0, acc, lane);
        }
        LDS_BARRIER();
        {
            const int p = w >> 1, n0 = 32 * (w & 1), n = n0 + r32;
            const LAS bf16* Y = (const LAS bf16*)(L + (p < 2 ? L_ABR : L_BT)); const LAS bf16* X = (const LAS bf16*)(L + ((p & 1) ? L_AKT : L_W1));
            const float pc = ((const LAS float*)(L + L_PC))[n];
#pragma unroll 1
            for (int mt = 0; mt < 2; ++mt) { const int m0 = 32 * mt; f32x16 acc = zero16();
                if (p < 2) mma_lds<64>(acc, Y, LDB, n0, X, LDB, m0, lane); else mma_lds_t<64, true, false>(acc, Y, LDB, n0, X, LDB, m0, lane);
                if (p == 0) { add_tile_lds(acc, (const LAS bf16*)(L + L_RT), LDB, n0, m0, lane); st_tile_glb_frag(W2T + oidx * 4096, n0, m0, acc, lane); }
                else if (p == 1) { add_tile_lds(acc, (const LAS bf16*)(L + L_AKR), LDB, n0, m0, lane); st_tile_lds((LAS bf16*)(L + L_GT), LDB, n0, m0, acc, lane); }
                else if (p == 2) {
#pragma unroll
                    for (int i = 0; i < 16; ++i) { const int m = m0 + 8 * (i >> 2) + 4 * hh + (i & 3); acc[i] = (acc[i] + (m == n ? 1.f : 0.f)) * pc; }
                    st_tile_glb(MTg + oidx * 4096, 64, n0, m0, acc, lane); }
                else { add_tile_lds_t(acc, (const LAS bf16*)(L + L_KT), LDB, n0, m0, lane);
#pragma unroll
                    for (int i = 0; i < 16; ++i) acc[i] *= pc;
                    st_tile_lds((LAS bf16*)(L + L_NKT), LDB, n0, m0, acc, lane); } }
        }
        LDS_BARRIER();
        if (has_next) P3_REQ_ROWS(IN);
        {
            const int p = w >> 2, n0 = 32 * ((w >> 1) & 1), m0 = 32 * (w & 1);
            f32x16 acc = zero16();
            if (p) mma_lds_t<64, true, false>(acc, (const LAS bf16*)(L + L_VT), LDB, n0, (const LAS bf16*)(L + L_NKT), LDB, m0, lane);
            else mma_lds_t<64, false, true>(acc, (const LAS bf16*)(L + L_GT), LDB, n0, (const LAS bf16*)(L + L_VT), LDB, m0, lane);
            if (p) st_tile_glb(NBg + oidx * 4096, 64, n0, m0, acc, lane); else st_tile_glb_cl(YLT + oidx * 4096, n0, m0, acc, lane);
        }
    }
#undef P3_REQ_ROWS
}

constexpr int CH_GC = 4, CH_SLOT = (64 + 32) * LDB * 2, CH_NOFF = 64 * LDB * 2;
DI void p4_rwkv_chain(Frame& F, const Args& A) {
    const bf16* MTg = (const bf16*)(F.ws + WS_CH + CH_STRIDE); const bf16* NBg = (const bf16*)(F.ws + WS_CH + 3 * CH_STRIDE); bf16* S0g = (bf16*)(F.ws + WS_CH + 4 * CH_STRIDE);
    const int lane = F.lane, r32 = lane & 31, hh = lane >> 5, w = F.wave;
    for (int task = blockIdx.x; task < NB * 8 * 2; task += F.G) {
        const int bh = task >> 1, n0 = 32 * (task & 1), hd = bh & 7;
        f32x16 s[2];
        if (w == 0) { const bf16* Nm = NBg + (size_t)(NITEM + hd) * 4096 + (size_t)(n0 + r32) * 64 + 4 * hh;
#pragma unroll
            for (int mt = 0; mt < 2; ++mt)
#pragma unroll
                for (int g = 0; g < 4; ++g) { const v2u wv = *(const v2u*)(Nm + 32 * mt + 8 * g);
                    s[mt][4 * g] = __uint_as_float(wv.x << 16); s[mt][4 * g + 1] = __uint_as_float(wv.x & 0xffff0000u); s[mt][4 * g + 2] = __uint_as_float(wv.y << 16); s[mt][4 * g + 3] = __uint_as_float(wv.y & 0xffff0000u); } }
#define CH_STAGE(gi) do { if (w > 0) { v4u rg_[7]; \
            _Pragma("unroll") for (int u_ = 0; u_ < 7; ++u_) { const int pc_ = F.tid - 64 + u_ * 448; if (pc_ < CH_GC * 768) { const int sl_ = pc_ / 768, q_ = pc_ - sl_ * 768; const size_t o_ = (size_t)(bh * NCH + CH_GC * (gi) + sl_) * 4096; \
                rg_[u_] = q_ < 512 ? *(const v4u*)(MTg + o_ + (size_t)q_ * 8) : *(const v4u*)(NBg + o_ + (size_t)(n0 + ((q_ - 512) >> 3)) * 64 + ((q_ - 512) & 7) * 8); } } \
            _Pragma("unroll") for (int u_ = 0; u_ < 7; ++u_) { const int pc_ = F.tid - 64 + u_ * 448; if (pc_ < CH_GC * 768) { const int sl_ = pc_ / 768, q_ = pc_ - sl_ * 768; \
                LAS unsigned char* dst_ = F.lds + (((gi) & 1) * CH_GC + sl_) * CH_SLOT; \
                if (q_ < 512) *(LAS v4u*)(dst_ + (q_ >> 3) * (LDB * 2) + (q_ & 7) * 16) = rg_[u_]; \
                else { const int q2_ = q_ - 512; *(LAS v4u*)(dst_ + CH_NOFF + (q2_ >> 3) * (LDB * 2) + (q2_ & 7) * 16) = rg_[u_]; } } } } } while (0)
        CH_STAGE(0);
        LDS_BARRIER();
        for (int gi = 0; gi < NCH / CH_GC; ++gi) {
            if (gi + 1 < NCH / CH_GC) CH_STAGE(gi + 1);
            if (w == 0) {
#pragma unroll 1
                for (int sl = 0; sl < CH_GC; ++sl) { const int c = CH_GC * gi + sl;
                    const LAS bf16* Ms = (const LAS bf16*)(F.lds + ((gi & 1) * CH_GC + sl) * CH_SLOT); const LAS bf16* Ns = Ms + 64 * LDB;
                    bf16x8 am[2][4]; f32x16 acc[2];
#pragma unroll
                    for (int mt = 0; mt < 2; ++mt)
#pragma unroll
                        for (int q = 0; q < 4; ++q) { const LAS bf16* mr = Ms + (32 * mt + r32) * LDB + 16 * q + 4 * hh; const v2u lo = *(const LAS v2u*)mr, hi = *(const LAS v2u*)(mr + 8); const v2u nv = *(const LAS v2u*)(Ns + r32 * LDB + 32 * mt + 8 * q + 4 * hh);
                            v4u t4; t4.x = lo.x; t4.y = lo.y; t4.z = hi.x; t4.w = hi.y; am[mt][q] = __builtin_bit_cast(bf16x8, t4);
                            acc[mt][4 * q] = __uint_as_float(nv.x << 16); acc[mt][4 * q + 1] = __uint_as_float(nv.x & 0xffff0000u); acc[mt][4 * q + 2] = __uint_as_float(nv.y << 16); acc[mt][4 * q + 3] = __uint_as_float(nv.y & 0xffff0000u); }
                    bf16x8 sb[4];
                    { bf16* So = S0g + (size_t)(bh * NCH + c) * 4096 + (n0 >> 5) * 2048 + r32 * 8 + 4 * hh;
#pragma unroll
                        for (int q = 0; q < 4; ++q) { const int mt = q >> 1, i0 = 8 * (q & 1); v4u t4; t4.x = pk2(s[mt][i0], s[mt][i0 + 1]); t4.y = pk2(s[mt][i0 + 2], s[mt][i0 + 3]); t4.z = pk2(s[mt][i0 + 4], s[mt][i0 + 5]); t4.w = pk2(s[mt][i0 + 6], s[mt][i0 + 7]);
                            sb[q] = __builtin_bit_cast(bf16x8, t4);
                            v2u lo; lo.x = t4.x; lo.y = t4.y; v2u hi; hi.x = t4.z; hi.y = t4.w; *(v2u*)(So + 512 * q) = lo; *(v2u*)(So + 512 * q + 256) = hi; } }
#pragma unroll
                    for (int mt = 0; mt < 2; ++mt)
#pragma unroll
                        for (int q = 0; q < 4; ++q) acc[mt] = MFMA32(am[mt][q], sb[q], acc[mt]);
                    s[0] = acc[0]; s[1] = acc[1];
                }
            }
            LDS_BARRIER();
        }
#undef CH_STAGE
    }
}

DI void p5_rwkv_out(Frame& F, const Args& A) {
    const bf16* W2T = (const bf16*)(F.ws + WS_CH); const bf16* YLT = (const bf16*)(F.ws + WS_CH + 2 * CH_STRIDE); const bf16* S0g = (const bf16*)(F.ws + WS_CH + 4 * CH_STRIDE);
    const bf16* GB = (const bf16*)(F.ws + WS_GB); const bf16* PO = (const bf16*)(F.ws + WS_POST); bf16* RY = (bf16*)(F.ws + WS_AR) + 512;
    const int lane = F.lane, r32 = lane & 31, hh = lane >> 5;
    LAS bf16* stg = (LAS bf16*)(F.lds + F.wave * 8192);
    for (int pm = blockIdx.x; pm < M / 256; pm += F.G)
    for (int q = F.wave; q < 64; q += NWAVES) {
        const int b = pm >> 5, c = 4 * (pm & 31) + (q >> 4), h = (q >> 1) & 7, n0 = 32 * (q & 1), idx = (b * 8 + h) * NCH + c;
        const size_t o = (size_t)idx * 4096; const int row = b * SEQ + 64 * c + n0 + r32;
        const bf16* Yr = W2T + o + (n0 >> 5) * 2048 + lane * 8;
        v2u pwr[2][4], gvr[2][4]; f32x4 lgr[2][4];
#pragma unroll
        for (int mt = 0; mt < 2; ++mt)
#pragma unroll
            for (int g = 0; g < 4; ++g) { const int i0 = h * 64 + 32 * mt + 8 * g + 4 * hh; const size_t go = o + ((n0 >> 5) * 2 + mt) * 1024 + g * 256 + lane * 4; lgr[mt][g] = *(const f32x4*)(A.in[I_LNG] + i0); pwr[mt][g] = *(const v2u*)(PO + go); gvr[mt][g] = *(const v2u*)(GB + go); }
        f32x16 acc[2];
#pragma unroll
        for (int mt = 0; mt < 2; ++mt) { const bf16* Lr = YLT + o + ((n0 >> 5) * 2 + mt) * 1024 + lane * 4;
#pragma unroll
            for (int g = 0; g < 4; ++g) { const v2u wv = *(const v2u*)(Lr + 256 * g);
                acc[mt][4 * g] = __uint_as_float(wv.x << 16); acc[mt][4 * g + 1] = __uint_as_float(wv.x & 0xffff0000u); acc[mt][4 * g + 2] = __uint_as_float(wv.y << 16); acc[mt][4 * g + 3] = __uint_as_float(wv.y & 0xffff0000u); } }
#pragma unroll
        for (int k0 = 0; k0 < 64; k0 += 16) { const bf16x8 yb = *(const bf16x8*)(Yr + (k0 >> 4) * 512);
#pragma unroll
            for (int mt = 0; mt < 2; ++mt) { const bf16x8 xa = *(const bf16x8*)(S0g + o + (mt * 4 + (k0 >> 4)) * 512 + lane * 8); acc[mt] = MFMA32(xa, yb, acc[mt]); } }
        float sum = 0.f;
#pragma unroll
        for (int mt = 0; mt < 2; ++mt)
#pragma unroll
            for (int i = 0; i < 16; ++i) sum += acc[mt][i];
        sum = xsum32(sum); const float mean = sum * (1.0f / 64.0f);
        float sq = 0.f;
#pragma unroll
        for (int mt = 0; mt < 2; ++mt)
#pragma unroll
            for (int i = 0; i < 16; ++i) { acc[mt][i] -= mean; sq += acc[mt][i] * acc[mt][i]; }
        sq = xsum32(sq); const float rstd = 1.0f / sqrtf(sq * (1.0f / 64.0f) + 64e-5f);
#pragma unroll
        for (int mt = 0; mt < 2; ++mt)
#pragma unroll
            for (int g = 0; g < 4; ++g) { const int i0 = h * 64 + 32 * mt + 8 * g + 4 * hh; const size_t go = (size_t)row * 512 + i0;
                const f32x4 lg = lgr[mt][g]; const v2u pw = pwr[mt][g], gv = gvr[mt][g];
                const float o0 = (acc[mt][4 * g] * rstd * lg.x + __uint_as_float(pw.x << 16)) * __uint_as_float(gv.x << 16), o1 = (acc[mt][4 * g + 1] * rstd * lg.y + __uint_as_float(pw.x & 0xffff0000u)) * __uint_as_float(gv.x & 0xffff0000u);
                const float o2 = (acc[mt][4 * g + 2] * rstd * lg.z + __uint_as_float(pw.y << 16)) * __uint_as_float(gv.y << 16), o3 = (acc[mt][4 * g + 3] * rstd * lg.w + __uint_as_float(pw.y & 0xffff0000u)) * __uint_as_float(gv.y & 0xffff0000u);
                v2u ov; ov.x = pk2(o0, o1); ov.y = pk2(o2, o3); *(LAS v2u*)(stg + r32 * 72 + 32 * mt + 8 * g + 4 * hh) = ov; }
        LDS_WAIT();
        {
            const size_t rb = (size_t)(b * SEQ + 64 * c + n0) * 1024 + h * 64;
#pragma unroll
            for (int k = 0; k < 4; ++k) { const int p = lane + 64 * k, tk = p >> 3, c16 = p & 7; *(v4u*)(RY + rb + (size_t)tk * 1024 + c16 * 8) = *(const LAS v4u*)(stg + tk * 72 + c16 * 8); }
        }
        LDS_WAIT();
    }
}

constexpr int AT_LDK = 72, AT_LDV = 300, AT_VT = 288 * AT_LDK * 2;
DI void p2_attention_mfma(Frame& F, const Args& A) {
    LAS bf16* ostg = (LAS bf16*)(F.lds + 81920 + F.wave * 8192);
    LAS bf16* Ks = (LAS bf16*)F.lds; LAS bf16* Vt = (LAS bf16*)(F.lds + AT_VT);
    const bf16* Q = (const bf16*)(F.ws + WS_Q); const bf16* Kb = (const bf16*)(F.ws + WS_K); const bf16* Vb = (const bf16*)(F.ws + WS_V); bf16* AO = (bf16*)(F.ws + WS_AR);
    const int tid = F.tid, lane = F.lane, w = F.wave, r32 = lane & 31, hh = lane >> 5;
    for (int item = blockIdx.x; item < NB * 2 * (SEQ / 128); item += F.G) {
        const int b = item >> 7, kvh = (item >> 6) & 1, jb = item & 63, tok0 = 128 * (jb - 1);
        {
            v4u kvr[5], vvr[5];
#pragma unroll
            for (int u = 0; u < 5; ++u) { const int ch = tid + u * (NWAVES * 64), key = ch >> 3, c = ch & 7;
                const int tk = tok0 + key; int row = key < 256 ? (tk >= 0 ? b * SEQ + tk : -1) : (key < 272 ? M + key - 256 : -1);
                const unsigned msk = (unsigned)~(row >> 31); row = row < 0 ? 0 : row;
                kvr[u] = *(const v4u*)(Kb + (size_t)row * 128 + kvh * 64 + 8 * c); vvr[u] = *(const v4u*)(Vb + (size_t)row * 128 + kvh * 64 + 8 * c);
#pragma unroll
                for (int i = 0; i < 4; ++i) { kvr[u][i] &= msk; vvr[u][i] &= msk; } }
#pragma unroll
            for (int u = 0; u < 5; ++u) { const int ch = tid + u * (NWAVES * 64), key = ch >> 3, c = ch & 7;
                if (u < 4 || ch < 288 * 8) { *(LAS v4u*)(Ks + key * AT_LDK + 8 * c) = kvr[u];
#pragma unroll
                    for (int e2 = 0; e2 < 8; ++e2) Vt[(8 * c + e2) * AT_LDV + key] = (bf16)((e2 & 1) ? (vvr[u][e2 >> 1] >> 16) : (vvr[u][e2 >> 1] & 0xffffu)); } }
        }
        LDS_BARRIER();
        const int g = w & 3, qh = w >> 2, h = kvh * 4 + g;
        const float slope = exp2f(-(float)(h + 1)), sink = A.in[I_SINK][h];
#pragma unroll 1
        for (int qq = 0; qq < 2; ++qq) {
            const int qt = 2 * qh + qq, ql = 32 * qt + r32, t = 128 * jb + ql; const size_t row = (size_t)b * SEQ + t;
            bf16x8 qf[4];
#pragma unroll
            for (int ks = 0; ks < 4; ++ks) qf[ks] = *(const bf16x8*)(Q + row * 512 + h * 64 + 16 * ks + 8 * hh);
            f32x16 sc[6]; float mx = -INFINITY;
            const LAS bf16* kbase = Ks + (32 * qt + r32) * AT_LDK + 8 * hh; const LAS bf16* kmeta = Ks + (256 + r32) * AT_LDK + 8 * hh;
            const LAS bf16* vbase = Vt + r32 * AT_LDV + 32 * qt + 4 * hh; const LAS bf16* vmeta = Vt + r32 * AT_LDV + 256 + 4 * hh;
            float sum = 0.f;
            if (jb > 0) {
                const int z = r32 - 4 * hh; const float el = -slope * (float)z;
                float mt[6];
#pragma unroll
                for (int k6 = 0; k6 < 6; ++k6) { f32x16 acc = zero16(); const LAS bf16* kp = k6 < 5 ? kbase + 32 * k6 * AT_LDK : kmeta;
#pragma unroll
                    for (int ks = 0; ks < 4; ++ks) { const bf16x8 a = *(const LAS bf16x8*)(kp + 16 * ks); acc = MFMA32(a, qf[ks], acc); }
                    float m = -INFINITY;
#pragma unroll
                    for (int i = 0; i < 16; ++i) { const int ci = 8 * (i >> 2) + (i & 3); float y;
                        if (k6 == 5) y = i < 8 ? acc[i] : -INFINITY;
                        else { y = fmaf(slope, (float)ci, acc[i] + el); if (k6 == 0) y = ci > z ? y : -INFINITY; if (k6 == 4) y = ci <= z ? y : -INFINITY; }
                        sc[k6][i] = y; m = fmaxf(m, y); }
                    mt[k6] = m + (k6 < 5 ? -slope * (float)(128 - 32 * k6) : -128.0f * slope); }
#pragma unroll
                for (int k6 = 0; k6 < 6; ++k6) mx = fmaxf(mx, mt[k6]);
                mx = xmax32(mx); mx = fmaxf(mx, sink);
#pragma unroll
                for (int k6 = 0; k6 < 6; ++k6) { const float gk = ((k6 < 5 ? -slope * (float)(128 - 32 * k6) : -128.0f * slope) - mx) * 1.44269504089f;
#pragma unroll
                    for (int i = 0; i < 16; ++i) { const float p = __builtin_amdgcn_exp2f(fmaf(sc[k6][i], 1.44269504089f, gk)); sc[k6][i] = p; sum += p; } }
            } else {
#pragma unroll
            for (int k6 = 0; k6 < 6; ++k6) { const int kta = k6 < 5 ? qt + k6 : 8; f32x16 acc = zero16(); const LAS bf16* kp = k6 < 5 ? kbase + 32 * k6 * AT_LDK : kmeta;
#pragma unroll
                for (int ks = 0; ks < 4; ++ks) { const bf16x8 a = *(const LAS bf16x8*)(kp + 16 * ks); acc = MFMA32(a, qf[ks], acc); }
#pragma unroll
                for (int i = 0; i < 16; ++i) { const int kr = 8 * (i >> 2) + 4 * hh + (i & 3); bool ok; float dist;
                    if (k6 < 5) { const int kb = 32 * kta + kr, diff = 128 + ql - kb; dist = (float)diff;
                        if (k6 >= 1 && k6 <= 3) ok = jb > 0 || tok0 + kb >= 0;
                        else ok = diff >= 0 && diff < 128 && tok0 + kb >= 0; }
                    else { const int dm = t + 16 - kr; ok = kr < 16; dist = (float)(dm < 128 ? dm : 128); }
                    const float v = ok ? acc[i] - slope * dist : -INFINITY; sc[k6][i] = v; mx = fmaxf(mx, v); } }
            mx = xmax32(mx); mx = fmaxf(mx, sink);
#pragma unroll
            for (int k6 = 0; k6 < 6; ++k6)
#pragma unroll
                for (int i = 0; i < 16; ++i) { const float p = __expf(sc[k6][i] - mx); sc[k6][i] = p; sum += p; }
            }
            sum = xsum32(sum); sum += __expf(sink - mx);
            const float inv = 1.0f / sum;
            f32x16 o[2]; o[0] = zero16(); o[1] = zero16();
#pragma unroll
            for (int k6 = 0; k6 < 6; ++k6) { const int kta = k6 < 5 ? qt + k6 : 8;
#pragma unroll
                for (int s = 0; s < 2; ++s) { v4u t4; t4.x = pk2(sc[k6][8 * s], sc[k6][8 * s + 1]); t4.y = pk2(sc[k6][8 * s + 2], sc[k6][8 * s + 3]); t4.z = pk2(sc[k6][8 * s + 4], sc[k6][8 * s + 5]); t4.w = pk2(sc[k6][8 * s + 6], sc[k6][8 * s + 7]);
                    const bf16x8 pb = __builtin_bit_cast(bf16x8, t4);
#pragma unroll
                    for (int dt = 0; dt < 2; ++dt) { const LAS bf16* vp = (k6 < 5 ? vbase + 32 * k6 : vmeta) + 32 * dt * AT_LDV + 16 * s; const v2u lo = *(const LAS v2u*)vp, hi = *(const LAS v2u*)(vp + 8);
                        v4u a4; a4.x = lo.x; a4.y = lo.y; a4.z = hi.x; a4.w = hi.y; o[dt] = MFMA32(__builtin_bit_cast(bf16x8, a4), pb, o[dt]); } } }
#pragma unroll
            for (int dt = 0; dt < 2; ++dt)
#pragma unroll
                for (int g4 = 0; g4 < 4; ++g4) { v2u ov; ov.x = pk2(o[dt][4 * g4] * inv, o[dt][4 * g4 + 1] * inv); ov.y = pk2(o[dt][4 * g4 + 2] * inv, o[dt][4 * g4 + 3] * inv);
                    *(LAS v2u*)(ostg + r32 * 72 + 32 * dt + 8 * g4 + 4 * hh) = ov; }
            LDS_WAIT();
            {
                const size_t rb = ((size_t)b * SEQ + 128 * jb + 32 * qt) * 1024 + h * 64;
#pragma unroll
                for (int k = 0; k < 4; ++k) { const int p = lane + 64 * k, tk = p >> 3, c16 = p & 7; *(v4u*)(AO + rb + (size_t)tk * 1024 + c16 * 8) = *(const LAS v4u*)(ostg + tk * 72 + c16 * 8); }
            }
            LDS_WAIT();
        }
        LDS_BARRIER();
    }
}

constexpr int R_EHI = 0, R_ELO = 65536, R_GHI = 131072, R_GLO = 139264;
DI float sq8(const v4u h) { float s = 0.f;
#pragma unroll
    for (int i = 0; i < 4; ++i) { const unsigned u = i == 0 ? h.x : i == 1 ? h.y : i == 2 ? h.z : h.w; const float a = __uint_as_float(u << 16), b = __uint_as_float(u & 0xffff0000u); s += a * a + b * b; }
    return s; }
DI void split8(const float (&wv)[8], v4u& hi, v4u& lo) {
    unsigned hw[4], lw[4];
#pragma unroll
    for (int i = 0; i < 4; ++i) { hw[i] = pk2(wv[2 * i], wv[2 * i + 1]); lw[i] = pk2(wv[2 * i] - __uint_as_float(hw[i] << 16), wv[2 * i + 1] - __uint_as_float(hw[i] & 0xffff0000u)); }
    hi.x = hw[0]; hi.y = hw[1]; hi.z = hw[2]; hi.w = hw[3]; lo.x = lw[0]; lo.y = lw[1]; lo.z = lw[2]; lo.w = lw[3]; }
DI void p8_router(Frame& F, const Args& A) {
    LAS unsigned char* L = F.lds;
    LAS int* lcnt = (LAS int*)(L + LDS_RT); LAS int* lbase = lcnt + 32; LAS int* ent_e = lcnt + 64; LAS int* ent_p = ent_e + 512; LAS int* ent_d = ent_p + 512; LAS float* ent_w = (LAS float*)(ent_d + 512); LAS float* ent_r = ent_w + 512;
    LAS float* bias = ent_r + 512;
    const bf16* H1 = (const bf16*)(F.ws + WS_AR);
    int* LD = (int*)(F.ws + WS_LISTD); float* LW = (float*)(F.ws + WS_LISTW); float* LR = (float*)(F.ws + WS_LISTR);
    const int lane = F.lane, r32 = lane & 31, hh = lane >> 5;
    if ((int)blockIdx.x >= M / 256) return;
    {
        const float* g2 = A.in[I_NFG];
        for (int it = F.tid; it < 128 * 32; it += NWAVES * 64) { const int e = it & 31, c = it >> 5; float wv[8];
#pragma unroll
            for (int j = 0; j < 8; ++j) wv[j] = A.in[I_WEXP][(8 * c + j) * 32 + e] * g2[8 * c + j];
            v4u hi, lo; split8(wv, hi, lo); const int o = e * 2048 + ((c ^ (e & 15)) << 4);
            *(LAS v4u*)(L + R_EHI + o) = hi; *(LAS v4u*)(L + R_ELO + o) = lo; }
        for (int it = F.tid; it < 128 * 4; it += NWAVES * 64) { const int g = it & 3, c = it >> 2; float wv[8];
#pragma unroll
            for (int j = 0; j < 8; ++j) wv[j] = A.in[I_WGRP][(8 * c + j) * 4 + g] * g2[8 * c + j];
            v4u hi, lo; split8(wv, hi, lo); const int o = g * 2048 + ((c ^ g) << 4);
            *(LAS v4u*)(L + R_GHI + o) = hi; *(LAS v4u*)(L + R_GLO + o) = lo; }
        if (F.tid < 36) bias[F.tid] = F.tid < 4 ? A.in[I_BGRP][F.tid] : A.in[I_BEXP][F.tid - 4];
    }
    for (int ch = blockIdx.x; ch < M / 256; ch += F.G) {
        if (F.tid < 32) lcnt[F.tid] = 0;
        __syncthreads();
        const int tok = ch * 256 + F.wave * 32 + r32;
        const bf16* hp = H1 + (size_t)tok * D + 32 * hh;
        v4u hb[4][4];
#pragma unroll
        for (int u = 0; u < 4; ++u)
#pragma unroll
            for (int s = 0; s < 4; ++s) hb[u][s] = *(const v4u*)(hp + 64 * u + 8 * s);
        f32x16 accE = zero16(), accG = zero16(); float ss = 0.f;
        const LAS unsigned char* eh = L + R_EHI + r32 * 2048; const LAS unsigned char* gh = L + R_GHI + (r32 & 3) * 2048;
        const int sw = r32 & 15, swg = r32 & 3;
#pragma unroll 1
        for (int q0 = 0; q0 < 16; q0 += 4) {
#pragma unroll
            for (int u = 0; u < 4; ++u) { const int q = q0 + u;
#pragma unroll
                for (int s = 0; s < 4; ++s) { const v4u hv = hb[u][s]; const int c = 8 * q + 4 * hh + s;
                    const bf16x8 b = __builtin_bit_cast(bf16x8, hv);
                    const bf16x8 a0 = *(const LAS bf16x8*)(eh + ((c ^ sw) << 4)), a1 = *(const LAS bf16x8*)(eh + (R_ELO - R_EHI) + ((c ^ sw) << 4));
                    const bf16x8 a2 = *(const LAS bf16x8*)(gh + ((c ^ swg) << 4)), a3 = *(const LAS bf16x8*)(gh + (R_GLO - R_GHI) + ((c ^ swg) << 4));
                    accE = MFMA32(a0, b, accE); accG = MFMA32(a2, b, accG); accE = MFMA32(a1, b, accE); accG = MFMA32(a3, b, accG);
                    ss += sq8(hv); }
                if (q + 4 < 16) {
#pragma unroll
                    for (int s = 0; s < 4; ++s) hb[u][s] = *(const v4u*)(hp + 64 * (q + 4) + 8 * s); } }
        }
        ss = xsum32(ss);
        const float rs = 1.0f / sqrtf(ss * (1.0f / D) + 1e-6f);
        float gl[4];
#pragma unroll
        for (int g = 0; g < 4; ++g) gl[g] = __shfl(accG[g], r32) * rs + bias[g];
        int gs = 0; float gm = gl[0];
#pragma unroll
        for (int g = 1; g < 4; ++g) if (gl[g] > gm) { gm = gl[g]; gs = g; }
        float den = 0.f;
#pragma unroll
        for (int g = 0; g < 4; ++g) den += __expf(gl[g] - gm);
        const float pg = 1.0f / den;
        float a1 = -INFINITY, a2 = -INFINITY; int ai1 = 0, ai2 = 0;
#pragma unroll
        for (int j = 0; j < 4; ++j) { const float cd = gs == 0 ? accE[j] : gs == 1 ? accE[4 + j] : gs == 2 ? accE[8 + j] : accE[12 + j];
            const int idx = 4 * hh + j; const float l = cd * rs + bias[4 + gs * 8 + idx];
            if (l > a1) { a2 = a1; ai2 = ai1; a1 = l; ai1 = idx; } else if (l > a2) { a2 = l; ai2 = idx; } }
        const float b1 = __shfl_xor(a1, 32), b2 = __shfl_xor(a2, 32); const int bi1 = __shfl_xor(ai1, 32), bi2 = __shfl_xor(ai2, 32);
        const float p1 = hh ? b1 : a1, p2 = hh ? b2 : a2, q1 = hh ? a1 : b1, q2 = hh ? a2 : b2;
        const int pi1 = hh ? bi1 : ai1, pi2 = hh ? bi2 : ai2, qi1 = hh ? ai1 : bi1, qi2 = hh ? ai2 : bi2;
        float v1, v2; int i1, i2;
        if (p1 >= q1) { v1 = p1; i1 = pi1; if (p2 >= q1) { v2 = p2; i2 = pi2; } else { v2 = q1; i2 = qi1; } }
        else { v1 = q1; i1 = qi1; if (p1 >= q2) { v2 = p1; i2 = pi1; } else { v2 = q2; i2 = qi2; } }
        const float e2 = __expf(v2 - v1), w1 = pg / (1.0f + e2), w2 = pg * e2 / (1.0f + e2);
        { const int ex = gs * 8 + (hh == 0 ? i1 : i2); const int pos = atomicAdd((int*)&lcnt[ex], 1); const int slot = (F.wave * 32 + r32) * 2 + hh;
            ent_e[slot] = ex; ent_p[slot] = pos; ent_d[slot] = tok * 2 + hh; ent_w[slot] = hh == 0 ? w1 : w2; ent_r[slot] = rs; }
        __syncthreads();
        if (F.tid < 32) lbase[F.tid] = (int)__hip_atomic_fetch_add(F.ctl + CW_GCNT + 64 * F.tid, (unsigned)lcnt[F.tid], __ATOMIC_RELAXED, __HIP_MEMORY_SCOPE_AGENT);
        __syncthreads();
        { const int sl = F.tid; const int ex = ent_e[sl]; const size_t o = (size_t)ex * LCAP + lbase[ex] + ent_p[sl]; LD[o] = ent_d[sl]; LW[o] = ent_w[sl]; LR[o] = ent_r[sl]; }
        __syncthreads();
    }
}
__global__ void __launch_bounds__(NWAVES * 64, 2) mk_fwd(Args args) {
    extern __shared__ __attribute__((aligned(16))) unsigned char lds[];
    Frame F;
    F.lds = (LAS unsigned char*)lds;
    F.tid = threadIdx.x; F.lane = F.tid & 63; F.wave = __builtin_amdgcn_readfirstlane(F.tid >> 6); F.G = gridDim.x;
    F.out = args.out; F.ws = args.ws; F.ctl = (unsigned*)(args.ws + WS_CTL);
    volatile LAS unsigned* MISC = (volatile LAS unsigned*)(F.lds + LDS_MISC);
    if (F.tid < 64) MISC[F.tid] = 0u;
    __syncthreads();
    const int lo = args.ph_lo, hi = args.ph_hi;
    XcdBarrier bar; bar.bar = (unsigned*)(F.ctl + CW_BAR); bar.x = 0; bar.st = nullptr;
    if (hi - lo > 1) bar = xcd_barrier_post((unsigned*)(F.ctl + CW_BAR), MISC + 8);
#ifdef ONLY_PHASE
#define IN(k) ((k) == ONLY_PHASE && lo <= (k) && (k) < hi)
#elif defined(SKIP_PHASE)
#define IN(k) ((k) != SKIP_PHASE && lo <= (k) && (k) < hi)
#else
#define IN(k) (lo <= (k) && (k) < hi)
#endif
#ifndef PROBE_MASK
#define PROBE_MASK 0
#endif
#define REPS(k) (1 + ((PROBE_MASK >> (k)) & 1))
#define SEAM(k) do { if (IN(k) && IN((k) + 1)) xcd_barrier(bar); } while (0)
#define LOCAL_SEAM(k) do { if (IN(k) && IN((k) + 1)) { asm volatile("s_waitcnt vmcnt(0)" ::: "memory"); __syncthreads(); __builtin_amdgcn_fence(__ATOMIC_ACQUIRE, "agent"); asm volatile("s_waitcnt vmcnt(0)" ::: "memory"); __syncthreads(); } } while (0)
    unsigned char* ws = args.ws;
    if (IN(0)) { _Pragma("unroll") for (int rep = 0; rep < REPS(0); ++rep) { p0_prologue(F, args); } SEAM(0); }
    if (IN(1)) {
        p1_meta_finish(F, args);
        pg8::Gemm g{(const pg8::bf16_t*)(ws + WS_XB), (const pg8::bf16_t*)(ws + WS_WIN), M, IN_COLS, D, 0}; pg8::StaticOrder S; S.init(M, IN_COLS, F.G, (int)blockIdx.x);
        pg8::EpiIn E{(bf16*)(ws + WS_Q), (bf16*)(ws + WS_K), (bf16*)(ws + WS_V), (bf16*)(ws + WS_RC), (bf16*)F.out};
        _Pragma("unroll") for (int rep = 0; rep < REPS(1); ++rep) { pg8::gemm_phase<pg8::EpiIn, pg8::StaticOrder, true, true>(F.lds, g, S, E); }
        SEAM(1);
    }
    if (IN(2)) { _Pragma("unroll") for (int rep = 0; rep < REPS(2); ++rep) { p2a_lora_inputs(F, args); p2_attention_mfma(F, args); } SEAM(2); }
    if (IN(3)) { _Pragma("unroll") for (int rep = 0; rep < REPS(3); ++rep) { p3_rwkv_chunk(F, args); } SEAM(3); }
    if (IN(4)) { _Pragma("unroll") for (int rep = 0; rep < REPS(4); ++rep) { if (F.G >= 2 * NB * 8 * 2) expert_weights(F, args, NB * 8 * 2); else { expert_weights(F, args, 0); LDS_BARRIER(); } p4_rwkv_chain(F, args); } SEAM(4); }
    if (IN(5)) { _Pragma("unroll") for (int rep = 0; rep < REPS(5); ++rep) { p5_rwkv_out(F, args); } LOCAL_SEAM(5); }
    if (IN(6)) {
        pg8::Gemm g{(const pg8::bf16_t*)(ws + WS_AR), (const pg8::bf16_t*)(ws + WS_WOA), M, D, D, 512}; pg8::PairOrder<pg8::PanelOrder> S; S.base.init(M, D, F.G, (int)blockIdx.x); S.koff_bytes = 1024;
        pg8::EpiGate2 E{(const bf16*)F.out, (bf16*)(ws + WS_MG)};
        _Pragma("unroll") for (int rep = 0; rep < REPS(6); ++rep) { pg8::gemm_phase<pg8::EpiGate2, pg8::PairOrder<pg8::PanelOrder>, true, true>(F.lds, g, S, E); }
        LOCAL_SEAM(6);
    }
    if (IN(7)) {
        pg8::Gemm g{(const pg8::bf16_t*)(ws + WS_MG), (const pg8::bf16_t*)(ws + WS_WOUT), M, D, D, 0}; pg8::PanelOrder S; S.init(M, D, F.G, (int)blockIdx.x);
        pg8::EpiRes E{args.in[I_X], (bf16*)(ws + WS_AR)};
        _Pragma("unroll") for (int rep = 0; rep < REPS(7); ++rep) { pg8::gemm_phase<pg8::EpiRes, pg8::PanelOrder, true, true>(F.lds, g, S, E); }
        LOCAL_SEAM(7);
    }
    if (IN(8)) { _Pragma("unroll") for (int rep = 0; rep < REPS(8); ++rep) { p8_router(F, args); } SEAM(8); }
    if (IN(9)) {
        const int TT = moe_table(F);
        const LAS int* tile_e = (const LAS int*)(F.lds + LDS_TBL); const LAS int* tb = tile_e + TT_MAX;
        LAS int* ldd = (LAS int*)(F.lds + 131072); LAS float* ldw = (LAS float*)(F.lds + 131072 + 8 * 1024); LAS float* ldr = (LAS float*)(F.lds + 131072 + 16 * 1024);
        pg8::Gemm g{(const pg8::bf16_t*)(ws + WS_XN2), (const pg8::bf16_t*)(ws + WS_WGU), CAP, NE * 512, D, 0};
        pg8::GroupedOrder<true> S{tile_e, tb, TT, 2, F.G, (int)blockIdx.x, ldd, (unsigned)(D * 2)};
        { const int* LD = (const int*)(ws + WS_LISTD); const float* LW = (const float*)(ws + WS_LISTW); const float* LR = (const float*)(ws + WS_LISTR);
          for (int idx = F.tid; idx < 8 * 256; idx += NWAVES * 64) { pg8::Unit u; const int i = idx >> 8, r = idx & 255;
              if (S.next(i, u)) { const int li = u.r0 + r; const bool ok = li < u.cnt; const int e = u.pn >> 1; const float rs = ok ? LR[e * LCAP + li] : 0.f; ldd[idx] = ok ? LD[e * LCAP + li] : -1; ldw[idx] = ok ? LW[e * LCAP + li] * rs * rs : 0.f; ldr[idx] = rs; } }
          __syncthreads(); }
        pg8::EpiSwiglu E{(bf16*)(ws + WS_HMID), ldd, ldw, ldr, (int*)(ws + WS_SLOTD)};
        _Pragma("unroll") for (int rep = 0; rep < REPS(9); ++rep) { pg8::gemm_phase<pg8::EpiSwiglu, pg8::GroupedOrder<true>, true, true>(F.lds, g, S, E); }
        SEAM(9);
    }
    if (IN(10)) {
        const int TT = moe_table(F);
        const LAS int* tile_e = (const LAS int*)(F.lds + LDS_TBL); const LAS int* tb = tile_e + TT_MAX;
        LAS int* lsl = (LAS int*)(F.lds + 131072);
        pg8::Gemm g{(const pg8::bf16_t*)(ws + WS_HMID), (const pg8::bf16_t*)(ws + WS_WDN), CAP, NE * 1024, 256, 0};
        pg8::GroupedOrder<false> S{tile_e, tb, TT, 4, F.G, (int)blockIdx.x, nullptr, 0u};
        { const int* SD = (const int*)(ws + WS_SLOTD);
          for (int idx = F.tid; idx < 12 * 256; idx += NWAVES * 64) { pg8::Unit u; const int i = idx >> 8, r = idx & 255; if (S.next(i, u)) lsl[idx] = SD[u.pm * 256 + r]; }
          __syncthreads(); }
        pg8::EpiDown E{(unsigned char*)(ws + WS_Y), lsl};
        _Pragma("unroll") for (int rep = 0; rep < REPS(10); ++rep) { pg8::gemm_phase<pg8::EpiDown, pg8::GroupedOrder<false>, true, true>(F.lds, g, S, E); }
        SEAM(10);
    }
    if (IN(11)) { _Pragma("unroll") for (int rep = 0; rep < REPS(11); ++rep) { p12_final(F, args); } }
#undef IN
#undef SEAM
}

extern "C" void kernel_launch(void* const* d_in, const int* in_sizes, int n_in, void* d_out, int out_size, void* d_ws, size_t ws_size, hipStream_t stream) {
    static int grid = 0;
    if (grid == 0) {
        if (n_in != 28 || in_sizes[0] != M * D || out_size != M * D || ws_size < WS_END) { fprintf(stderr, "kernel_launch: unexpected shapes (n_in %d, in0 %d, out %d, ws %zu)\n", n_in, n_in > 0 ? in_sizes[0] : -1, out_size, ws_size); grid = -1; return; }
        int dev = 0, cus = 0, per_cu = 0;
        if (hipGetDevice(&dev) != hipSuccess || hipDeviceGetAttribute(&cus, hipDeviceAttributeMultiprocessorCount, dev) != hipSuccess) { grid = -1; return; }
        if (hipFuncSetAttribute((const void*)mk_fwd, hipFuncAttributeMaxDynamicSharedMemorySize, LDS_BYTES) != hipSuccess) { fprintf(stderr, "kernel_launch: hipFuncSetAttribute failed\n"); grid = -1; return; }
        if (hipOccupancyMaxActiveBlocksPerMultiprocessor(&per_cu, (const void*)mk_fwd, NWAVES * 64, LDS_BYTES) != hipSuccess || per_cu < 1) fprintf(stderr, "kernel_launch: occupancy query reports %d\n", per_cu);
        (void)hipGetLastError();
        grid = cus;
    }
    if (grid < 0) return;
    if (hipMemsetAsync((char*)d_ws + WS_CTL, 0, CTL_ZERO_BYTES, stream) != hipSuccess) return;
    Args a{};
    for (int i = 0; i < 28; ++i) a.in[i] = (const float*)d_in[i];
    a.out = (float*)d_out; a.ws = (unsigned char*)d_ws;
#if MK_ONE_LAUNCH
    a.ph_lo = 0; a.ph_hi = N_PHASES; a.li = 0;
    hipLaunchKernelGGL(mk_fwd, dim3(grid), dim3(NWAVES * 64), LDS_BYTES, stream, a);
#else
    for (int p = 0; p < N_PHASES; ++p) { a.ph_lo = p; a.ph_hi = p + 1; a.li = p; hipLaunchKernelGGL(mk_fwd, dim3(grid), dim3(NWAVES * 64), LDS_BYTES, stream, a); }
#endif
}
```
